# Optimizing an MI355X kernel written in HIP

```python
import math
import jax
import jax.numpy as jnp
from jax import lax
import numpy as np

D_MODEL = 1024
BATCH = 16
SEQ = 2048
DEPTH = 2

CTX_LEN = 256
GRID_W = 64

HG_HEADS = 4
HG_DK = 128
HG_DV = 128
HG_CHUNK = 64
LB_FLOOR = 1e-30

DA_HEADS = 4
DA_DH = 64
DA_DV = 2 * DA_DH
Q_BLOCK = 128
ROPE_THETA = 10000.0

FR_GROUPS = 4
FR_DG = 128

N_EXPERTS = 64
TOP_K = 8
EXPERT_DIM = 256
SHARED_DIM = 256
N_GROUPS = 8
TOPK_GROUPS = 4
ROUTED_SCALE = 2.5
ROW_BLOCK = 256
MASK_VALUE = -1e9

N_BRANCHES = 3
HG_W = HG_HEADS * HG_DK
HG_VW = HG_HEADS * HG_DV
DA_QKW = DA_HEADS * 2 * DA_DH
DA_VW = DA_HEADS * DA_DV
FR_W = FR_GROUPS * FR_DG
GATE_W = N_BRANCHES * D_MODEL
IN_SPLITS = (HG_W, HG_W, HG_W, HG_VW, HG_VW, DA_QKW, DA_QKW, DA_VW, FR_W, GATE_W)
IN_WIDTH = sum(IN_SPLITS)

DEEPNORM_ALPHA = (2 * DEPTH) ** 0.25
DEEPNORM_BETA = (8 * DEPTH) ** -0.25
ADA_INIT = 0.5
LN_EPS = 1e-5

kernel_name = 'hybrid_hgrn2_diffattn_fnet_moe_dit'


def layer_norm(x, g=None, b=None):
    xf = x.astype(jnp.float32)
    mu = jnp.mean(xf, axis=-1, keepdims=True)
    var = jnp.mean(jnp.square(xf - mu), axis=-1, keepdims=True)
    y = (xf - mu) * lax.rsqrt(var + LN_EPS)
    if g is not None:
        y = y * g.astype(jnp.float32) + b.astype(jnp.float32)
    return y.astype(x.dtype)


def rms_norm(x, g):
    xf = x.astype(jnp.float32)
    y = xf * lax.rsqrt(jnp.mean(jnp.square(xf), axis=-1, keepdims=True) + LN_EPS) * g.astype(jnp.float32)
    return y.astype(x.dtype)


def modulate(x, shift, scale):
    return layer_norm(x) * (1 + scale) + shift


def axial_rope(seq_len, dtype):
    rows = seq_len // GRID_W
    row = jnp.repeat(jnp.arange(rows, dtype=jnp.float32), GRID_W)
    col = (jnp.arange(seq_len) % GRID_W).astype(jnp.float32)
    n_freq = DA_DH // 4
    inv = ROPE_THETA ** (-jnp.arange(n_freq, dtype=jnp.float32) / n_freq)
    ang = jnp.concatenate([row[:, None] * inv, col[:, None] * inv], axis=-1)
    ang = jnp.concatenate([ang, ang], axis=-1)
    return jnp.cos(ang).astype(dtype), jnp.sin(ang).astype(dtype)


def apply_rope(x, cos, sin):
    half = DA_DH // 2
    rot = jnp.concatenate([-x[..., half:], x[..., :half]], axis=-1)
    return x * cos[:, None, None, :] + rot * sin[:, None, None, :]


def hgrn_log_forget(f_raw, lb):
    lbf = lb.astype(jnp.float32)
    return jnp.logaddexp(jnp.log(jnp.maximum(lbf, LB_FLOOR)),
                         jnp.log1p(-lbf) + jax.nn.log_sigmoid(f_raw.astype(jnp.float32)))


def to_chunks(a):
    B, L, H, d = a.shape
    return a.reshape(B, L // HG_CHUNK, HG_CHUNK, H, d).transpose(1, 0, 3, 2, 4)


def from_chunks(a):
    n, B, H, C, d = a.shape
    return a.transpose(1, 0, 3, 2, 4).reshape(B, n * C, H, d)


def hgrn_chunk_scan(q, k, v, log_f, s0):
    causal = jnp.tril(jnp.ones((HG_CHUNK, HG_CHUNK), dtype=bool))

    def step(s, inp):
        qc, kc, vc, gc = inp
        b = jnp.cumsum(gc, axis=2)
        diff = b[:, :, :, None, :] - b[:, :, None, :, :]
        decay = jnp.where(causal[:, :, None], jnp.exp(jnp.minimum(diff, 0.0)), 0.0)
        scores = jnp.einsum('bhtd,bhsd,bhtsd->bhts', qc, kc, decay)
        o = jnp.einsum('bhts,bhse->bhte', scores, vc) + jnp.einsum('bhtd,bhde->bhte', qc * jnp.exp(b), s)
        b_end = b[:, :, -1:, :]
        s_new = jnp.exp(b_end[:, :, 0, :, None]) * s + jnp.einsum('bhsd,bhse->bhde', kc * jnp.exp(b_end - b), vc)
        return s_new, o

    xs = tuple(to_chunks(a.astype(jnp.float32)) for a in (q, k, v, log_f))
    s_fin, o = lax.scan(step, s0, xs)
    return from_chunks(o), s_fin


def hgrn_direction(q_c, v_c, f_c, q_l, v_l, f_l, lb, reverse):
    flip = (lambda a: jnp.flip(a, axis=1)) if reverse else (lambda a: a)

    def run(q, v, f, s0):
        B, L = q.shape[:2]
        log_f = hgrn_log_forget(f, lb).reshape(B, L, HG_HEADS, HG_DK)
        k = -jnp.expm1(log_f)
        o, s = hgrn_chunk_scan(flip(q), flip(k), flip(v), flip(log_f), s0)
        return flip(o), s

    s0 = jnp.zeros((q_c.shape[0], HG_HEADS, HG_DK, HG_DV), jnp.float32)
    o_c, s_c = run(q_c, v_c, f_c, s0)
    o_l, _ = run(q_l, v_l, f_l, s_c)
    return o_c, o_l


def hgrn_readout(o_f, o_b, gate, norm_g):
    B, L = gate.shape[:2]
    o = rms_norm(o_f + o_b, norm_g)
    g = jax.nn.silu(gate.astype(jnp.float32)).reshape(B, L, HG_HEADS, HG_DV)
    return (o * g).reshape(B, L, HG_VW).astype(gate.dtype)


def diff_heads(qr, kr, vr):
    B, L = qr.shape[:2]
    return (qr.reshape(B, L, DA_HEADS, 2, DA_DH), kr.reshape(B, L, DA_HEADS, 2, DA_DH),
            vr.reshape(B, L, DA_HEADS, DA_DV))


def diff_softmax_attend(q, k, v, lam):
    s = jnp.einsum('bqhcd,bkhcd->bhcqk', q, k, preferred_element_type=jnp.float32) * (DA_DH ** -0.5)
    p = jax.nn.softmax(s, axis=-1)
    pd = p[:, :, 0] - lam * p[:, :, 1]
    return jnp.einsum('bhqk,bkhe->bqhe', pd.astype(v.dtype), v)


def diff_attention_latent(q, k_all, v_all, lam):
    B, L = q.shape[:2]
    nb = L // Q_BLOCK
    qb = q.reshape(B, nb, Q_BLOCK, DA_HEADS, 2, DA_DH).swapaxes(0, 1)
    o = lax.map(lambda qq: diff_softmax_attend(qq, k_all, v_all, lam), qb)
    return o.swapaxes(0, 1).reshape(B, L, DA_HEADS, DA_DV)


def diff_readout(o, norm_g, lam_init):
    B, L = o.shape[:2]
    return (rms_norm(o, norm_g) * (1 - lam_init)).reshape(B, L, DA_VW)


def fourier_mix(u):
    B, L, _ = u.shape
    ug = u.reshape(B, L, FR_GROUPS, FR_DG).astype(jnp.float32)
    y = jnp.fft.fft2(ug, axes=(1, 3), norm='ortho').real
    return y.reshape(B, L, FR_W).astype(u.dtype)


def gated_merge(a, b, cf, gates, w_pa, w_pb, w_pc, w_o):
    g = jax.nn.sigmoid(gates.astype(jnp.float32)).astype(a.dtype)
    ga, gb, gc = jnp.split(g, N_BRANCHES, axis=-1)
    m = ga * (a @ w_pa) + gb * (b @ w_pb) + gc * (cf @ w_pc)
    return m @ w_o


def mixer_block(parts_c, parts_l, cos, sin, lb, hg_g, lam, lam_init, da_g, w_pa, w_pb, w_pc, w_o, need_ctx):
    qh_c, ff_c, fb_c, i_c, og_c, qa_c, ka_c, va_c, u_c, gt_c = parts_c
    qh_l, ff_l, fb_l, i_l, og_l, qa_l, ka_l, va_l, u_l, gt_l = parts_l

    def hg_qv(qh, i):
        B, L = qh.shape[:2]
        return jax.nn.silu(qh).reshape(B, L, HG_HEADS, HG_DK), i.reshape(B, L, HG_HEADS, HG_DV)

    q_c, v_c = hg_qv(qh_c, i_c)
    q_l, v_l = hg_qv(qh_l, i_l)
    of_c, of_l = hgrn_direction(q_c, v_c, ff_c, q_l, v_l, ff_l, lb[0], False)
    ob_c, ob_l = hgrn_direction(q_c, v_c, fb_c, q_l, v_l, fb_l, lb[1], True)
    a_l = hgrn_readout(of_l, ob_l, og_l, hg_g)

    qd_c, kd_c, vd_c = diff_heads(qa_c, ka_c, va_c)
    qd_l, kd_l, vd_l = diff_heads(qa_l, ka_l, va_l)
    qd_l = apply_rope(qd_l, cos, sin)
    kd_l = apply_rope(kd_l, cos, sin)
    k_all = jnp.concatenate([kd_c, kd_l], axis=1)
    v_all = jnp.concatenate([vd_c, vd_l], axis=1)
    b_l = diff_readout(diff_attention_latent(qd_l, k_all, v_all, lam), da_g, lam_init)

    c_l = fourier_mix(u_l)
    mix_l = gated_merge(a_l, b_l, c_l, gt_l, w_pa, w_pb, w_pc, w_o)
    if not need_ctx:
        return None, mix_l

    a_c = hgrn_readout(of_c, ob_c, og_c, hg_g)
    b_c = diff_readout(diff_softmax_attend(qd_c, kd_c, vd_c, lam), da_g, lam_init)
    c_c = fourier_mix(u_c)
    mix_c = gated_merge(a_c, b_c, c_c, gt_c, w_pa, w_pb, w_pc, w_o)
    return mix_c, mix_l


def swiglu(t, w_g, w_u, w_d):
    return (jax.nn.silu(t @ w_g) * (t @ w_u)) @ w_d


def grouped_experts(t, eidx, w, w_g, w_u, w_d):
    N, D = t.shape
    nk = eidx.size
    flat_e = eidx.reshape(-1)
    order = jnp.argsort(flat_e)
    e_sorted = flat_e[order]
    tok_sorted = (order // TOP_K).astype(jnp.int32)
    w_sorted = w.reshape(-1)[order]
    counts = jnp.bincount(flat_e, length=N_EXPERTS)
    padded = (counts + ROW_BLOCK - 1) // ROW_BLOCK * ROW_BLOCK
    pad_end = jnp.cumsum(padded)
    pad_start = pad_end - padded
    grp_start = jnp.cumsum(counts) - counts
    dest = pad_start[e_sorted] + jnp.arange(nk, dtype=jnp.int32) - grp_start[e_sorted]
    n_blocks = -(-nk // ROW_BLOCK) + N_EXPERTS
    n_rows = n_blocks * ROW_BLOCK
    row_tok = jnp.full((n_rows,), N, jnp.int32).at[dest].set(tok_sorted)
    row_w = jnp.zeros((n_rows,), t.dtype).at[dest].set(w_sorted)
    block_e = jnp.minimum(jnp.searchsorted(pad_end, jnp.arange(n_blocks, dtype=jnp.int32) * ROW_BLOCK, side='right'), N_EXPERTS - 1)
    t_ext = jnp.concatenate([t, jnp.zeros((1, D), t.dtype)], axis=0)

    def step(acc, blk):
        tok, wt, e = blk
        xb = t_ext[tok]
        hb = jax.nn.silu(xb @ w_g[e]) * (xb @ w_u[e])
        return acc.at[tok].add((hb @ w_d[e]) * wt[:, None]), None

    acc, _ = lax.scan(step, jnp.zeros((N + 1, D), t.dtype),
                      (row_tok.reshape(n_blocks, ROW_BLOCK), row_w.reshape(n_blocks, ROW_BLOCK), block_e))
    return acc[:N]


def moe_ffn(t, w_router, router_bias, w_eg, w_eu, w_ed, w_sg, w_su, w_sd):
    N = t.shape[0]
    per = N_EXPERTS // N_GROUPS
    scores = jax.nn.sigmoid(jnp.matmul(t.astype(jnp.float32), w_router.astype(jnp.float32)))
    sel = scores + router_bias.astype(jnp.float32)
    gscore = lax.top_k(sel.reshape(N, N_GROUPS, per), 2)[0].sum(-1)
    _, gidx = lax.top_k(gscore, TOPK_GROUPS)
    gmask = jnp.any(gidx[:, :, None] == jnp.arange(N_GROUPS)[None, None, :], axis=1)
    sel = jnp.where(jnp.repeat(gmask, per, axis=1), sel, MASK_VALUE)
    _, eidx = lax.top_k(sel, TOP_K)
    w = jnp.take_along_axis(scores, eidx, axis=1)
    w = (w / jnp.sum(w, axis=-1, keepdims=True) * ROUTED_SCALE).astype(t.dtype)
    return grouped_experts(t, eidx, w, w_eg, w_eu, w_ed) + swiglu(t, w_sg, w_su, w_sd)


def setup_inputs(seed: int = 0) -> dict:
    key = jax.random.key(seed)
    ks = jax.random.split(key, 27)
    D = D_MODEL
    beta = DEEPNORM_BETA

    def nrm(k, shape, s):
        return jax.random.normal(k, shape, jnp.float32) * s

    return {
        'x': nrm(ks[0], (BATCH, SEQ, D), 1.0),
        'c': nrm(ks[1], (BATCH, D), 1.0),
        'ctx': nrm(ks[2], (BATCH, CTX_LEN, D), 1.0),
        'c_ctx': nrm(ks[3], (D,), 1.0),
        'w_ada': nrm(ks[4], (DEPTH, D, 6 * D), ADA_INIT * D ** -0.5),
        'b_ada': nrm(ks[5], (DEPTH, 6 * D), 0.02),
        'w_in': nrm(ks[6], (DEPTH, D, IN_WIDTH), D ** -0.5),
        'lb_logits': nrm(ks[7], (DEPTH, 2, HG_W), 0.5),
        'hg_norm_g': 1.0 + nrm(ks[8], (DEPTH, HG_DV), 0.02),
        'lam_params': nrm(ks[9], (DEPTH, 4, DA_DH), 0.1),
        'da_norm_g': 1.0 + nrm(ks[10], (DEPTH, DA_DV), 0.02),
        'w_branch_a': nrm(ks[11], (DEPTH, HG_VW, D), HG_VW ** -0.5),
        'w_branch_b': nrm(ks[12], (DEPTH, DA_VW, D), DA_VW ** -0.5),
        'w_branch_c': nrm(ks[13], (DEPTH, FR_W, D), FR_W ** -0.5),
        'w_out': nrm(ks[14], (DEPTH, D, D), beta * D ** -0.5),
        'ln1_g': 1.0 + nrm(ks[15], (DEPTH, D), 0.02),
        'ln1_b': nrm(ks[16], (DEPTH, D), 0.02),
        'ln2_g': 1.0 + nrm(ks[17], (DEPTH, D), 0.02),
        'ln2_b': nrm(ks[18], (DEPTH, D), 0.02),
        'w_router': nrm(ks[19], (DEPTH, D, N_EXPERTS), D ** -0.5),
        'router_bias': nrm(ks[20], (DEPTH, N_EXPERTS), 0.01),
        'w_exp_gate': nrm(ks[21], (DEPTH, N_EXPERTS, D, EXPERT_DIM), D ** -0.5),
        'w_exp_up': nrm(ks[22], (DEPTH, N_EXPERTS, D, EXPERT_DIM), D ** -0.5),
        'w_exp_down': nrm(ks[23], (DEPTH, N_EXPERTS, EXPERT_DIM, D), beta * EXPERT_DIM ** -0.5),
        'w_sh_gate': nrm(ks[24], (DEPTH, D, SHARED_DIM), D ** -0.5),
        'w_sh_up': nrm(ks[25], (DEPTH, D, SHARED_DIM), D ** -0.5),
        'w_sh_down': nrm(ks[26], (DEPTH, SHARED_DIM, D), beta * SHARED_DIM ** -0.5),
    }


def reference(x, c, ctx, c_ctx, w_ada, b_ada, w_in, lb_logits, hg_norm_g, lam_params, da_norm_g,
              w_branch_a, w_branch_b, w_branch_c, w_out, ln1_g, ln1_b, ln2_g, ln2_b,
              w_router, router_bias, w_exp_gate, w_exp_up, w_exp_down, w_sh_gate, w_sh_up, w_sh_down):
    B, L, D = x.shape
    Lc = ctx.shape[1]
    cos, sin = axial_rope(L, x.dtype)
    split_pts = [sum(IN_SPLITS[:i + 1]) for i in range(len(IN_SPLITS) - 1)]
    sm = jax.nn.softmax(lb_logits.astype(jnp.float32), axis=0)
    lower = jnp.cumsum(sm, axis=0) - sm[0:1]
    silu_c = jax.nn.silu(c)
    silu_cc = jax.nn.silu(c_ctx)
    xc = ctx
    for l in range(DEPTH):
        need_ctx = l < DEPTH - 1
        mod_l = jnp.split((silu_c @ w_ada[l] + b_ada[l])[:, None, :], 6, axis=-1)
        mod_c = jnp.split(silu_cc @ w_ada[l] + b_ada[l], 6, axis=-1)
        h_l = modulate(x, mod_l[0], mod_l[1])
        h_c = modulate(xc, mod_c[0], mod_c[1])
        parts_l = jnp.split(h_l @ w_in[l], split_pts, axis=-1)
        parts_c = jnp.split(h_c @ w_in[l], split_pts, axis=-1)
        lam_init = 0.8 - 0.6 * math.exp(-0.3 * l)
        lp = lam_params[l].astype(jnp.float32)
        lam = jnp.exp(jnp.sum(lp[0] * lp[1])) - jnp.exp(jnp.sum(lp[2] * lp[3])) + lam_init
        mix_c, mix_l = mixer_block(parts_c, parts_l, cos, sin, lower[l], hg_norm_g[l], lam, lam_init,
                                   da_norm_g[l], w_branch_a[l], w_branch_b[l], w_branch_c[l], w_out[l],
                                   need_ctx)
        x = layer_norm(DEEPNORM_ALPHA * x + mod_l[2] * mix_l, ln1_g[l], ln1_b[l])
        h2_l = modulate(x, mod_l[3], mod_l[4])
        if need_ctx:
            xc = layer_norm(DEEPNORM_ALPHA * xc + mod_c[2] * mix_c, ln1_g[l], ln1_b[l])
            h2_c = modulate(xc, mod_c[3], mod_c[4])
            tokens = jnp.concatenate([h2_c.reshape(-1, D), h2_l.reshape(-1, D)], axis=0)
        else:
            tokens = h2_l.reshape(-1, D)
        y = moe_ffn(tokens, w_router[l], router_bias[l], w_exp_gate[l], w_exp_up[l], w_exp_down[l],
                    w_sh_gate[l], w_sh_up[l], w_sh_down[l])
        x = layer_norm(DEEPNORM_ALPHA * x + mod_l[5] * y[-B * L:].reshape(B, L, D), ln2_g[l], ln2_b[l])
        if need_ctx:
            xc = layer_norm(DEEPNORM_ALPHA * xc + mod_c[5] * y[:B * Lc].reshape(B, Lc, D), ln2_g[l], ln2_b[l])
    return x
```

```cpp
#include <hip/hip_runtime.h>
#include <cstdio>
#include <cstdint>

#define LAS __attribute__((address_space(3)))
typedef unsigned short u16;
typedef short bf16x8 __attribute__((ext_vector_type(8)));
typedef short s16x4 __attribute__((ext_vector_type(4)));
typedef float f32x4 __attribute__((ext_vector_type(4)));
typedef float f32x16 __attribute__((ext_vector_type(16)));
typedef unsigned u32x4 __attribute__((ext_vector_type(4)));
typedef unsigned u32x2 __attribute__((ext_vector_type(2)));

#ifndef MK_ONE_LAUNCH
#define MK_ONE_LAUNCH 1
#endif
#ifndef PH_MASK
#define PH_MASK 0xFFFFFFFFu
#endif
constexpr bool EN(int k) { return ((PH_MASK) >> k) & 1u; }
#ifndef NT_GATES
#define NT_GATES 0
#endif
#if NT_GATES == 2
#define ST8G st8bf_wt
#elif NT_GATES
#define ST8G st8bf_nt
#else
#define ST8G st8bf
#endif
#ifndef DRY_MODE
#define DRY_MODE 0
#endif
#ifndef AT_DRY
#define AT_DRY 0
#endif
#ifndef HG_DRY
#define HG_DRY 0
#endif
#ifndef REP_MASK
#define REP_MASK 0u
#endif
constexpr int NREP(int k) { return (((REP_MASK) >> k) & 1u) ? 2 : 1; }

constexpr int DM = 1024, NB = 16, SEQ = 2048, DEPTH = 2, LC = 256;
constexpr int TC = NB * LC;
constexpr int TL = NB * SEQ;
constexpr int TT = TC + TL;
constexpr int INW = 7680;
constexpr int NEXP = 64, NEXP1 = 65;
constexpr int NSLOT = 9;
constexpr int NPASS = 3;
__host__ __device__ constexpr int npass_of(int l) { return l == 0 ? 3 : 2; }
constexpr int MAXTILES = 641;
constexpr int MAXROWS = MAXTILES * 256;
constexpr float LN_EPS = 1e-5f;
constexpr float ALPHA = 1.4142135623730951f;

constexpr size_t MiB = 1048576;
constexpr size_t WS_CTL = 0;
constexpr size_t WS_MOD = 65536;
constexpr size_t WS_LBT = WS_MOD + 1 * MiB;
constexpr size_t WS_ROPE = WS_LBT + 16384;
constexpr size_t WS_W2T = WS_ROPE + 524288;
constexpr size_t WS_W2TL = WS_W2T + 131072;
constexpr size_t WS_DFTC = WS_W2TL + 131072;
constexpr size_t WS_DFT = WS_DFTC + 1 * MiB;
constexpr size_t WS_XC = WS_DFT + 8 * MiB;
constexpr size_t WS_UCM = WS_MOD + 851968;
constexpr size_t WS_WL = WS_XC + 16 * MiB;
constexpr size_t WL_WIN = 0;
constexpr size_t WL_WPA = WL_WIN + (size_t)INW * DM * 2;
constexpr size_t WL_WPB = WL_WPA + 1 * MiB;
constexpr size_t WL_WPC = WL_WPB + 1 * MiB;
constexpr size_t WL_WO = WL_WPC + 1 * MiB;
constexpr size_t WL_WR = WL_WO + 2 * MiB;
constexpr size_t WL_SIZE = WL_WR + 524288;
constexpr size_t WS_DYN = (WS_WL + WL_SIZE + 255) / 256 * 256;
constexpr size_t PU = 36 * MiB;
constexpr size_t WS_H = WS_DYN;
constexpr size_t WS_P0 = WS_H + 72 * MiB;
constexpr size_t WS_P1 = WS_P0 + PU;
constexpr size_t WS_P2 = WS_P1 + PU;
constexpr size_t WS_P3 = WS_P2 + PU;
constexpr size_t WS_P4 = WS_P3 + PU;
constexpr size_t WS_P5 = WS_P4 + PU;
constexpr size_t WS_P6 = WS_P5 + PU;
constexpr size_t WS_P7 = WS_P6 + PU;
constexpr size_t WS_P8 = WS_P7 + PU;
constexpr size_t WS_OF = WS_P8 + PU;
constexpr size_t WS_OB = WS_OF + PU;
constexpr size_t WS_ON1 = WS_OB + PU;
constexpr size_t WS_ON2 = WS_ON1 + PU;
constexpr size_t WS_TT = WS_ON2 + PU;
constexpr size_t WS_END = WS_TT + 64 * MiB;
constexpr size_t WS_XB = WS_ON1;
constexpr size_t WS_GATES = WS_P6;
constexpr size_t WS_WGU = WS_P0;
constexpr size_t WS_WD = WS_WGU + (size_t)NEXP1 * 512 * 1024 * 2;
constexpr size_t WS_HB = WS_P3;
constexpr size_t WS_SO = WS_P3 + 84 * MiB;
constexpr size_t WS_LOGIT = WS_TT;
constexpr size_t WS_EIDX = WS_LOGIT + (size_t)TT * 64 * 4;
constexpr size_t WS_WGT = WS_EIDX + (size_t)TT * 8 * 4;
constexpr size_t WS_SROW = WS_WGT + (size_t)TT * 8 * 4;
constexpr size_t WS_RTOK = WS_SROW + (size_t)TT * 9 * 4;
constexpr size_t WS_TILEE = WS_RTOK + (size_t)NPASS * MAXROWS * 4;
constexpr size_t WS_BLKB = WS_TILEE + 16384;
static_assert(WS_WD + (size_t)NEXP1 * 1024 * 256 * 2 <= WS_P3, "expert weights vs hb");
static_assert(WS_HB + (size_t)MAXROWS * 512 <= WS_SO, "hb vs slotout");
static_assert(WS_BLKB + 1024 * 192 * 4 <= WS_END, "tables");
static_assert(WS_SO + (size_t)MAXROWS * 1024 <= WS_XB, "fp8 slot buffer vs the bf16 pre-norm residual (ON1+ON2)");
static_assert(WS_END <= 694845952ull, "workspace budget");
constexpr int CW_BAR = 0;
constexpr int CW_GCNT = 4096;
constexpr int CW_NTILES = 4096 + 512;
__host__ __device__ constexpr int pass_tile0(int l, int p) { return l == 0 ? 48 * p : (p == 0 ? 16 : (p == 1 ? 80 : 144)); }
__device__ __forceinline__ float bf2f(unsigned b) { return __uint_as_float(b << 16); }
typedef float f32x2_ __attribute__((ext_vector_type(2)));
typedef __bf16 bf16x2_ __attribute__((ext_vector_type(2)));
__device__ __forceinline__ unsigned cvtpk(float lo, float hi) { const f32x2_ v = {lo, hi}; const bf16x2_ b = __builtin_convertvector(v, bf16x2_); return __builtin_bit_cast(unsigned, b); }
__device__ __forceinline__ u16 f2bf(float f) { return (u16)(cvtpk(f, 0.f) & 0xffffu); }
__device__ __forceinline__ float wsum(float v) {
#pragma unroll
    for (int m = 32; m >= 1; m >>= 1) v += __shfl_xor(v, m);
    return v;
}
__device__ __forceinline__ float exp2_poly(float x) {
    const float f = __builtin_amdgcn_fractf(x), n = x - f;
    const float m = fmaf(f, fmaf(f, 0.3371894f, 0.657636f), 1.00172476f);
    return __builtin_amdgcn_ldexpf(m, (int)n);
}
__device__ __forceinline__ float sigmoidf_(float x) { return __builtin_amdgcn_rcpf(1.f + __expf(-x)); }
__device__ __forceinline__ float siluf_(float x) { return x * __builtin_amdgcn_rcpf(1.f + __expf(-x)); }
__device__ __forceinline__ int crow(int r, int hi) { return (r & 3) + 8 * (r >> 2) + 4 * hi; }

#define GLD(T, p) (*(const __attribute__((address_space(1))) T*)(p))
template <class T> __device__ __forceinline__ T* as_global(T* p) { return (T*)(__attribute__((address_space(1))) T*)p; }
#define GIN(F, i) as_global((F).in[i])
#define XB_TMO      128
#define XB_XCNT(j)  (256  + 64 * (j))
#define XB_XSUB(j)  (1280 + 64 * (j))
#define XB_XGEN(j)  (2304 + 64 * (j))
#define XB_TOP      3328
#define XB_TOPGEN   3392
#define XCD_BAR_WORDS 3456
#define XB_SPIN_CAP (1u << 18)
__device__ __forceinline__ unsigned xb_ld(unsigned* p)              { return __hip_atomic_load(p, __ATOMIC_RELAXED, __HIP_MEMORY_SCOPE_AGENT); }
__device__ __forceinline__ unsigned xb_add(unsigned* p, unsigned v) { return __hip_atomic_fetch_add(p, v, __ATOMIC_RELAXED, __HIP_MEMORY_SCOPE_AGENT); }
__device__ __forceinline__ unsigned xb_xcc_id() { return (unsigned)__builtin_amdgcn_s_getreg((3 << 11) | 20) & 0xFu; }
#define XB_SPIN(cond, bar) do { unsigned _sp = 0; while (cond) { __builtin_amdgcn_s_sleep(1); \
    if ((++_sp & 255u) == 0u) { if (xb_ld(&(bar)[XB_TMO])) break; if (_sp > XB_SPIN_CAP) { atomicAdd(&(bar)[XB_TMO], 1u); break; } } } } while (0)
struct XcdBarrier { unsigned* bar; unsigned x; volatile LAS unsigned* st; };
__device__ __forceinline__ XcdBarrier xcd_barrier_post(unsigned* bar, volatile LAS unsigned* st) {
    XcdBarrier b; b.bar = bar; b.x = xb_xcc_id(); b.st = st;
    if (threadIdx.x == 0) (void)xb_add(&bar[XB_XCNT(b.x)], 1u);
    return b;
}
__device__ __forceinline__ void xcd_barrier_complete(unsigned* bar, unsigned x, unsigned& nloc, unsigned& nx) {
    const unsigned G = gridDim.x * gridDim.y * gridDim.z;
    unsigned sum, cnt, mine, sp = 0u;
    for (;;) {
        sum = 0u; cnt = 0u; mine = 0u;
#pragma unroll
        for (unsigned j = 0; j < 16; ++j) { const unsigned c = xb_ld(&bar[XB_XCNT(j)]); sum += c; cnt += (c > 0u) ? 1u : 0u; mine = (j == x) ? c : mine; }
        if (sum == G) break;
        __builtin_amdgcn_s_sleep(1);
        if ((++sp & 255u) == 0u) { if (xb_ld(&bar[XB_TMO])) break; if (sp > XB_SPIN_CAP) { atomicAdd(&bar[XB_TMO], 1u); break; } }
    }
    nloc = mine > 0u ? mine : 1u; nx = cnt > 0u ? cnt : 1u;
}
__device__ __forceinline__ void xcd_barrier(const XcdBarrier& b) {
    asm volatile("s_waitcnt vmcnt(0)" ::: "memory");
    __syncthreads();
    if (threadIdx.x == 0) {
        unsigned* bar = b.bar;
        __builtin_amdgcn_s_waitcnt(0);
        unsigned nloc = b.st[0], nx = b.st[1];
        if (nloc == 0u) { xcd_barrier_complete(bar, b.x, nloc, nx); b.st[0] = nloc; b.st[1] = nx; }
        const unsigned old = xb_add(&bar[XB_XSUB(b.x)], 1u);
        const unsigned gen = old / nloc;
        if (old + 1u == (gen + 1u) * nloc) {
            __builtin_amdgcn_fence(__ATOMIC_RELEASE, "agent");
            asm volatile("s_waitcnt vmcnt(0)" ::: "memory");
            const unsigned og = xb_add(&bar[XB_TOP], 1u);
            const unsigned tg = og / nx;
            if (og + 1u == (tg + 1u) * nx) xb_add(&bar[XB_TOPGEN], 1u);
            else XB_SPIN(xb_ld(&bar[XB_TOPGEN]) == tg, bar);
            __builtin_amdgcn_fence(__ATOMIC_ACQUIRE, "agent");
            xb_add(&bar[XB_XGEN(b.x)], 1u);
            asm volatile("s_waitcnt vmcnt(0)" ::: "memory");
        } else {
            XB_SPIN(xb_ld(&bar[XB_XGEN(b.x)]) == gen, bar);
            __builtin_amdgcn_fence(__ATOMIC_ACQUIRE, "agent");
            asm volatile("s_waitcnt vmcnt(0)" ::: "memory");
        }
    }
    __syncthreads();
}

struct Args { const float* in[27]; float* out; unsigned char* ws; int ph_lo, ph_hi; };
struct Frame {
    const float* const* in; float* out; unsigned char* ws; LAS unsigned char* lds;
    int tid, lane, wave, G, blk, vcu;
};
constexpr int LDS_BYTES = 160 * 1024 - 64;
constexpr int LDS_MISC = LDS_BYTES - 64;

namespace pg8 {
constexpr int BM = 256, BK = 64, HALF = 128, HTB = HALF * BK * 2, STAGE_BYTES = 8 * HTB, NXCD = 8, WGM = 8;
__device__ __forceinline__ int lds_byte(int r, int c) { const int st = (r >> 4) * 2 + (c >> 5), rr = r & 15, cc = c & 31, ob = rr * 64 + cc * 2; return st * 1024 + (ob ^ (((ob >> 9) & 1) << 5)); }
__device__ __forceinline__ void stage_rc(int b, int& R, int& C) { const int st = b / 1024, sb = b % 1024, swz = sb ^ (((sb >> 9) & 1) << 5); R = (st >> 1) * 16 + swz / 64; C = (st & 1) * 32 + (swz % 64) / 2; }
__device__ __forceinline__ int perm32(int rho) { const int n = rho >> 4, i = rho & 15; return 8 * (i >> 2) + 4 * n + (i & 3); }
struct Unit { int pm, pn, aux, ord; };
typedef f32x4 Acc[2][2][4][2];

__device__ __forceinline__ bool static_tile(long L, int nM, int nN, int& pm, int& pn) {
    const int nwg = nM * nN; if (L >= nwg) return false;
    int wgid = (int)L; { const int q = nwg / NXCD, r = nwg % NXCD, xcd = wgid % NXCD, off = wgid / NXCD; wgid = (xcd < r ? xcd * (q + 1) : r * (q + 1) + (xcd - r) * q) + off; }
    const int nig = WGM * nN, gid = wgid / nig, fm = gid * WGM, gsz = (nM - fm) < WGM ? (nM - fm) : WGM;
    pm = fm + ((wgid % nig) % gsz); pn = (wgid % nig) / gsz; return true;
}

template <class P>
__device__ __forceinline__ void gemm_phase(LAS unsigned char* lds, const P& p) {
    int tid_ = threadIdx.x; asm volatile("" : "+v"(tid_));
    const int tid = tid_, wid = __builtin_amdgcn_readfirstlane(tid >> 6), lane = tid & 63, wr = wid >> 2, wc = wid & 3, fr = lane & 15, fq = lane >> 4;
    int R[2], C[2], Rb[2];
    unsigned lA[2], lB[2];
#pragma unroll
    for (int i = 0; i < 2; ++i) { stage_rc(tid * 16 + i * 8192, R[i], C[i]); Rb[i] = P::PERM ? ((R[i] & ~31) + perm32(R[i] & 31)) : R[i];
        lA[i] = P::GATHER ? 0u : p.laneA(R[i], C[i]); lB[i] = p.laneB(Rb[i], C[i]); }
    const unsigned ldsw = (unsigned)wid * 1024u;
    const int aoff = lds_byte(wr * 64 + fr, fq * 8), boff = lds_byte(wc * 32 + fr, fq * 8);
#define PG8_SA(b, h) (((b) * 2 + (h)) * HTB)
#define PG8_SB(b, h) ((4 + (b) * 2 + (h)) * HTB)
#define PG8_STAGE(bufoff, gbase, voff) do { _Pragma("unroll") for (int _i = 0; _i < 2; ++_i) \
        __builtin_amdgcn_global_load_lds((const unsigned*)((const char*)(gbase) + (voff)[_i]), (LAS unsigned*)(lds + (bufoff) + ldsw + _i * 8192), 16, 0, 0); } while (0)
#define PG8_LDA(dst, b, h) do { _Pragma("unroll") for (int m = 0; m < 4; ++m) _Pragma("unroll") for (int k = 0; k < 2; ++k) dst[m][k] = *(const LAS bf16x8*)(lds + PG8_SA(b, h) + aoff + m * 2048 + k * 1024); } while (0)
#define PG8_LDB(dst, b, h) do { _Pragma("unroll") for (int n = 0; n < 2; ++n) _Pragma("unroll") for (int k = 0; k < 2; ++k) dst[n][k] = *(const LAS bf16x8*)(lds + PG8_SB(b, h) + boff + n * 2048 + k * 1024); } while (0)
#define PG8_MMA(ai, bj, At, Bt) do { __builtin_amdgcn_s_setprio(1); _Pragma("unroll") for (int m = 0; m < 4; ++m) _Pragma("unroll") for (int n = 0; n < 2; ++n) _Pragma("unroll") for (int k = 0; k < 2; ++k) \
        acc[ai][bj][m][n] = __builtin_amdgcn_mfma_f32_16x16x32_bf16(Bt[n][k], At[m][k], acc[ai][bj][m][n], 0, 0, 0); __builtin_amdgcn_s_setprio(0); } while (0)
#define PG8_WAIT_V(n) asm volatile("s_waitcnt vmcnt(" #n ")" ::: "memory")
#define PG8_WAIT_L(n) asm volatile("s_waitcnt lgkmcnt(" #n ")" ::: "memory")
#define PG8_BAR __builtin_amdgcn_s_barrier()
#define PG8_SCHED __builtin_amdgcn_sched_barrier(0)
    Unit cur, nxt; int ui = 0;
    if (!p.next(0, cur)) return;
    Acc acc;
#pragma unroll
    for (int a = 0; a < 2; ++a)
#pragma unroll
        for (int b = 0; b < 2; ++b)
#pragma unroll
            for (int m = 0; m < 4; ++m)
#pragma unroll
                for (int n = 0; n < 2; ++n) acc[a][b][m][n] = (f32x4){0.f, 0.f, 0.f, 0.f};
    bf16x8 At[4][2], B0[2][2], B1[2][2];
    const char* cA0 = p.uA(cur, 0); const char* cA1 = P::GATHER ? cA0 : p.uA(cur, 1);
    const char* cB0 = p.uB(cur, 0); const char* cB1 = p.uB(cur, 1);
    unsigned gc[2][2] = {{0u, 0u}, {0u, 0u}}, gn[2][2] = {{0u, 0u}, {0u, 0u}};
    if constexpr (P::GATHER) p.gatherA(cur, R, C, gc);
#define A_OFF(sel, h) (P::GATHER ? sel[h] : lA)
#define KA(u, base, h, kt) (P::SEGT ? p.kA(u, h, kt) : (base) + (size_t)(kt) * 128)
#define KB(u, base, h, kt) (P::SEGT ? p.kB(u, h, kt) : (base) + (size_t)(kt) * 128)
    PG8_STAGE(PG8_SB(0, 0), cB0, lB); PG8_STAGE(PG8_SA(0, 0), cA0, A_OFF(gc, 0)); PG8_STAGE(PG8_SB(0, 1), cB1, lB); PG8_STAGE(PG8_SA(0, 1), cA1, A_OFF(gc, 1));
    if (wr == 1) PG8_BAR;
    PG8_WAIT_V(4); PG8_BAR;
    PG8_STAGE(PG8_SB(1, 0), KB(cur, cB0, 0, 1), lB); PG8_STAGE(PG8_SA(1, 0), KA(cur, cA0, 0, 1), A_OFF(gc, 0)); PG8_STAGE(PG8_SB(1, 1), KB(cur, cB1, 1, 1), lB);
    PG8_WAIT_V(6); PG8_BAR;
    for (;;) {
        const int nt = p.nt_of(cur);
        const bool has_next = p.next(ui + 1, nxt);
        const char* nA0 = cA0; const char* nA1 = cA1; const char* nB0 = cB0; const char* nB1 = cB1;
        if (!has_next) nxt = cur;
        if (has_next) { nA0 = p.uA(nxt, 0); nA1 = P::GATHER ? nA0 : p.uA(nxt, 1); nB0 = p.uB(nxt, 0); nB1 = p.uB(nxt, 1); }
        if constexpr (P::GATHER) { if (has_next) p.gatherA(nxt, R, C, gn); else { gn[0][0] = gc[0][0]; gn[0][1] = gc[0][1]; gn[1][0] = gc[1][0]; gn[1][1] = gc[1][1]; } }
        for (int t = 0; t < nt; t += 2) {
            const bool last = (t == nt - 2);
            if constexpr (P::SEGT > 0) { if (t > 0 && (t % (P::SEGT > 0 ? P::SEGT : 1)) == 0) p.seg_hook(acc, cur, t / (P::SEGT > 0 ? P::SEGT : 1), wr, wc, fr, fq); }
            const int kt2 = last ? 0 : t + 2, kt3 = kt2 + 1;
            const char* a1_1 = KA(cur, cA1, 1, t + 1);
            const char* a2_0 = last ? KA(nxt, nA0, 0, kt2) : KA(cur, cA0, 0, kt2); const char* a2_1 = last ? KA(nxt, nA1, 1, kt2) : KA(cur, cA1, 1, kt2);
            const char* b2_0 = last ? KB(nxt, nB0, 0, kt2) : KB(cur, cB0, 0, kt2); const char* b2_1 = last ? KB(nxt, nB1, 1, kt2) : KB(cur, cB1, 1, kt2);
            const char* a3_0 = last ? KA(nxt, nA0, 0, kt3) : KA(cur, cA0, 0, kt3); const char* a3_1 = last ? KA(nxt, nA1, 1, kt3) : KA(cur, cA1, 1, kt3);
            const char* b3_0 = last ? KB(nxt, nB0, 0, kt3) : KB(cur, cB0, 0, kt3); const char* b3_1 = last ? KB(nxt, nB1, 1, kt3) : KB(cur, cB1, 1, kt3);
            unsigned g2[2][2];
            if constexpr (P::GATHER) { g2[0][0] = last ? gn[0][0] : gc[0][0]; g2[0][1] = last ? gn[0][1] : gc[0][1]; g2[1][0] = last ? gn[1][0] : gc[1][0]; g2[1][1] = last ? gn[1][1] : gc[1][1]; }
            PG8_LDB(B0, 0, 0); PG8_SCHED; PG8_LDA(At, 0, 0); PG8_STAGE(PG8_SA(1, 1), a1_1, A_OFF(gc, 1));
            PG8_WAIT_L(8); PG8_BAR; PG8_WAIT_L(0); PG8_MMA(0, 0, At, B0); PG8_BAR; PG8_SCHED;
            PG8_LDB(B1, 0, 1); PG8_STAGE(PG8_SB(0, 0), b2_0, lB);
            PG8_BAR; PG8_WAIT_L(0); PG8_MMA(0, 1, At, B1); PG8_BAR;
            PG8_LDA(At, 0, 1); PG8_STAGE(PG8_SA(0, 0), a2_0, A_OFF(g2, 0));
            PG8_BAR; PG8_WAIT_L(0); PG8_MMA(1, 0, At, B0); PG8_BAR; PG8_SCHED;
            PG8_STAGE(PG8_SB(0, 1), b2_1, lB);
            PG8_WAIT_V(6); PG8_BAR; PG8_MMA(1, 1, At, B1); PG8_BAR;
            PG8_LDB(B0, 1, 0); PG8_SCHED; PG8_LDA(At, 1, 0); PG8_STAGE(PG8_SA(0, 1), a2_1, A_OFF(g2, 1));
            PG8_WAIT_L(8); PG8_BAR; PG8_WAIT_L(0); PG8_MMA(0, 0, At, B0); PG8_BAR; PG8_SCHED;
            PG8_LDB(B1, 1, 1); PG8_STAGE(PG8_SB(1, 0), b3_0, lB);
            PG8_BAR; PG8_WAIT_L(0); PG8_MMA(0, 1, At, B1); PG8_BAR;
            PG8_LDA(At, 1, 1); PG8_STAGE(PG8_SA(1, 0), a3_0, A_OFF(g2, 0));
            PG8_BAR; PG8_WAIT_L(0); PG8_MMA(1, 0, At, B0); PG8_BAR; PG8_SCHED;
            PG8_STAGE(PG8_SB(1, 1), b3_1, lB);
            PG8_WAIT_V(6); PG8_BAR; PG8_MMA(1, 1, At, B1); PG8_BAR;
        }
        p.epi(acc, cur, wr, wc, fr, fq);
        if (!has_next) break;
#pragma unroll
        for (int a = 0; a < 2; ++a)
#pragma unroll
            for (int b = 0; b < 2; ++b)
#pragma unroll
                for (int m = 0; m < 4; ++m)
#pragma unroll
                    for (int n = 0; n < 2; ++n) acc[a][b][m][n] = (f32x4){0.f, 0.f, 0.f, 0.f};
        cur = nxt; cA0 = nA0; cA1 = nA1; cB0 = nB0; cB1 = nB1; ++ui;
        if constexpr (P::GATHER) { gc[0][0] = gn[0][0]; gc[0][1] = gn[0][1]; gc[1][0] = gn[1][0]; gc[1][1] = gn[1][1]; }
    }
    PG8_WAIT_V(0);
    if (wr == 0) PG8_BAR;
    PG8_BAR;
#undef A_OFF
#undef KA
#undef KB
#undef PG8_SA
#undef PG8_SB
#undef PG8_STAGE
#undef PG8_LDA
#undef PG8_LDB
#undef PG8_MMA
#undef PG8_WAIT_V
#undef PG8_WAIT_L
#undef PG8_BAR
#undef PG8_SCHED
}
}
using pg8::Unit; using pg8::Acc;

__device__ __forceinline__ void unpack8(const u32x4& w, float (&f)[8]) {
#pragma unroll
    for (int j = 0; j < 4; ++j) { f[2 * j] = bf2f(w[j] & 0xffffu); f[2 * j + 1] = bf2f(w[j] >> 16); }
}
__device__ __forceinline__ void st8bf_nt(u16* p, const f32x4& v0, const f32x4& v1) {
    u32x4 w = {cvtpk(v0[0], v0[1]), cvtpk(v0[2], v0[3]), cvtpk(v1[0], v1[1]), cvtpk(v1[2], v1[3])};
    __builtin_nontemporal_store(w, (u32x4*)p);
}
__device__ __forceinline__ void st8bf_wt(u16* p, const f32x4& v0, const f32x4& v1) {
    u32x4 w = {cvtpk(v0[0], v0[1]), cvtpk(v0[2], v0[3]), cvtpk(v1[0], v1[1]), cvtpk(v1[2], v1[3])};
    asm volatile("global_store_dwordx4 %0, %1, off sc0 sc1\n\ts_nop 2" :: "v"(p), "v"(w) : "memory");
}
__device__ __forceinline__ void st8bf(u16* p, const f32x4& v0, const f32x4& v1) {
    u32x4 w = {cvtpk(v0[0], v0[1]), cvtpk(v0[2], v0[3]), cvtpk(v1[0], v1[1]), cvtpk(v1[2], v1[3])};
    *(u32x4*)p = w;
}
__device__ __forceinline__ unsigned pkh2(float a, float b) { const _Float16 x = (_Float16)a, y = (_Float16)b; return (unsigned)__builtin_bit_cast(u16, x) | ((unsigned)__builtin_bit_cast(u16, y) << 16); }
__device__ __forceinline__ float logf_gate(float v, float lbf, float oml) {
    return __logf(fmaf(oml, __builtin_amdgcn_rcpf(1.f + __expf(-v)), lbf));
}

struct PIn {
    static constexpr int SEGT = 0; __device__ __forceinline__ const char* kA(const Unit&, int, int) const { return nullptr; } __device__ __forceinline__ const char* kB(const Unit&, int, int) const { return nullptr; }
    __device__ __forceinline__ int nt_of(const Unit&) const { return nt; }
    static constexpr bool PERM = true, GATHER = false;
    const char* A; const char* B; int nt, G, c, nM, nN, rt0, pn0, nctx;
    unsigned char* ws; const float* lbt; const float* rope; int dry = 0;
    __device__ __forceinline__ bool next(int i, Unit& u) const { int pm, pn; const long L = (long)i * G + c; u.aux = 0;
        if (pg8::static_tile(L, nM, nN, pm, pn)) { u.pm = rt0 + pm; u.pn = pn0 + pn; return true; }
        const long L2 = L - (long)nM * nN; if (L2 >= nctx) return false; const int k = (int)(L2 % 12); u.pm = (int)(L2 / 12); u.pn = k < 8 ? k : k + 4; return true; }
    __device__ __forceinline__ const char* uA(const Unit& u, int h) const { return A + (size_t)(u.pm * 256 + h * 128) * 2048; }
    __device__ __forceinline__ const char* uB(const Unit& u, int h) const { return B + (size_t)(u.pn * 256 + h * 128) * 2048; }
    __device__ __forceinline__ unsigned laneA(int R, int C) const { return (unsigned)(R * 2048 + C * 2); }
    __device__ __forceinline__ unsigned laneB(int R, int C) const { return (unsigned)(R * 2048 + C * 2); }
    template <int BJ> __device__ __forceinline__ void logf_part(const Acc& acc, const Unit& u, u16* O, const float* lb, int cs0, int wr, int fr) const {
        const int cs = cs0 + BJ * 128;
        const f32x4 t0 = GLD(f32x4, lb + cs * 2), t1 = GLD(f32x4, lb + cs * 2 + 4), t2 = GLD(f32x4, lb + cs * 2 + 8), t3 = GLD(f32x4, lb + cs * 2 + 12);
#pragma unroll
        for (int ai = 0; ai < 2; ++ai)
#pragma unroll
            for (int m = 0; m < 4; ++m) { const size_t row = (size_t)(u.pm * 256 + ai * 128 + wr * 64 + m * 16 + fr);
                const f32x4 v0 = acc[ai][BJ][m][0], v1 = acc[ai][BJ][m][1];
                u32x4 w;
                w[0] = pkh2(logf_gate(v0[0], t0[0], t0[1]), logf_gate(v0[1], t0[2], t0[3]));
                w[1] = pkh2(logf_gate(v0[2], t1[0], t1[1]), logf_gate(v0[3], t1[2], t1[3]));
                w[2] = pkh2(logf_gate(v1[0], t2[0], t2[1]), logf_gate(v1[1], t2[2], t2[3]));
                w[3] = pkh2(logf_gate(v1[2], t3[0], t3[1]), logf_gate(v1[3], t3[2], t3[3]));
                *(u32x4*)(O + row * 512 + cs) = w; __builtin_amdgcn_sched_barrier(0); }
    }
    __device__ __forceinline__ void epi(const Acc& acc, const Unit& u, int wr, int wc, int fr, int fq) const {
        const int sec = u.pn >> 1;
        if (sec >= 9) {
            u16* G_ = (u16*)(ws + WS_GATES);
            const int col0 = (u.pn - 18) * 256 + wc * 32 + 8 * fq;
            if (dry) {
                u16* D_ = (u16*)(ws + WS_TT);
#pragma unroll
                for (int ai = 0; ai < 2; ++ai)
#pragma unroll
                    for (int m = 0; m < 4; ++m) { const size_t row = (size_t)(u.pm * 256 + ai * 128 + wr * 64 + m * 16 + fr);
#pragma unroll
                        for (int bj = 0; bj < 2; ++bj) { f32x4 v0 = acc[ai][bj][m][0], v1 = acc[ai][bj][m][1];
                            if (dry == 1) {
#pragma unroll
                                for (int j = 0; j < 4; ++j) { v0[j] = sigmoidf_(v0[j]); v1[j] = sigmoidf_(v1[j]); } }
                            if (dry == 4) {
#pragma unroll
                                for (int j = 0; j < 4; ++j) { v0[j] = 1.f + __builtin_amdgcn_exp2f(v0[j] * -1.44269504f); v1[j] = 1.f + __builtin_amdgcn_exp2f(v1[j] * -1.44269504f); } }
                            if (dry == 6) {
#pragma unroll
                                for (int j = 0; j < 4; ++j) { float a = v0[j], b = v1[j];
#pragma unroll
                                    for (int k = 0; k < 4; ++k) { a = __builtin_amdgcn_exp2f(a) - 1.5f; b = __builtin_amdgcn_exp2f(b) - 1.5f; } v0[j] = a; v1[j] = b; } }
                            if (dry == 7) {
#pragma unroll
                                for (int j = 0; j < 4; ++j) { float a = v0[j], b = v1[j];
#pragma unroll
                                    for (int k = 0; k < 4; ++k) { a = __builtin_amdgcn_rcpf(a) - 1.5f; b = __builtin_amdgcn_rcpf(b) - 1.5f; } v0[j] = a; v1[j] = b; } }
                            if (dry == 8) {
#pragma unroll
                                for (int j = 0; j < 4; ++j) { float a = v0[j], b = v1[j];
#pragma unroll
                                    for (int k = 0; k < 4; ++k) { a = fmaf(a, a, -1.5f) - 1.5f; b = fmaf(b, b, -1.5f) - 1.5f; } v0[j] = a; v1[j] = b; } }
                            if (dry == 5) {
#pragma unroll
                                for (int j = 0; j < 4; ++j) { v0[j] = 1.f + exp2_poly(v0[j] * -1.44269504f); v1[j] = 1.f + exp2_poly(v1[j] * -1.44269504f); } }
                            if (dry != 3 || (ai == 0 && m == 0 && bj == 0)) st8bf(D_ + ((row * 3072 + col0 + bj * 128) & (size_t)(16 * MiB - 1)), v0, v1);
                            else asm volatile("" :: "v"(v0[0] + v1[3])); } __builtin_amdgcn_sched_barrier(0); }
                return;
            }
            { const int gt = u.pn - 18, tidf = (wr * 4 + wc) * 64 + fq * 16 + fr;
              u16* Gb = G_ + ((size_t)(u.pm * 3 + (gt >> 2)) * 4 + (gt & 3)) * 65536 + tidf * 8;
#pragma unroll
              for (int ai = 0; ai < 2; ++ai)
#pragma unroll
                for (int m = 0; m < 4; ++m) {
#pragma unroll
                    for (int bj = 0; bj < 2; ++bj) { f32x4 v0 = acc[ai][bj][m][0], v1 = acc[ai][bj][m][1];
#pragma unroll
                        for (int j = 0; j < 4; ++j) { v0[j] = 1.f + __expf(-v0[j]); v1[j] = 1.f + __expf(-v1[j]); }
                        ST8G(Gb + ((ai * 4 + m) * 2 + bj) * 4096, v0, v1); } __builtin_amdgcn_sched_barrier(0); } }
            return;
        }
        u16* O = (u16*)(ws + WS_P0 + (size_t)sec * PU);
        const int cs0 = (u.pn & 1) * 256 + wc * 32 + 8 * fq;
        if (sec == 1 || sec == 2) {
            const float* lb = as_global(lbt) + (size_t)(sec - 1) * 1024;
            logf_part<0>(acc, u, O, lb, cs0, wr, fr); logf_part<1>(acc, u, O, lb, cs0, wr, fr);
            return;
        }
        const bool rope_sec = (sec == 5 || sec == 6), silu_sec = (sec == 0);
        if (rope_sec && u.pm * 256 >= TC) {
            const int p0 = (wc & 1) * 16 + 4 * fq;
#pragma unroll
            for (int ai = 0; ai < 2; ++ai) {
                f32x4 cs4[4], sn4[4];
#pragma unroll
                for (int m = 0; m < 4; ++m) { const int t = (u.pm * 256 + ai * 128 + wr * 64 + m * 16 + fr - TC) & (SEQ - 1);
                    cs4[m] = GLD(f32x4, rope + (size_t)t * 32 + p0); sn4[m] = GLD(f32x4, rope + 65536 + (size_t)t * 32 + p0); }
#pragma unroll
                for (int m = 0; m < 4; ++m) { const size_t row = (size_t)(u.pm * 256 + ai * 128 + wr * 64 + m * 16 + fr);
#pragma unroll
                    for (int bj = 0; bj < 2; ++bj) { const f32x4 v0 = acc[ai][bj][m][0], v1 = acc[ai][bj][m][1]; f32x4 r0, r1;
                        r0[0] = v0[0] * cs4[m][0] - v0[1] * sn4[m][0]; r0[1] = v0[1] * cs4[m][0] + v0[0] * sn4[m][0];
                        r0[2] = v0[2] * cs4[m][1] - v0[3] * sn4[m][1]; r0[3] = v0[3] * cs4[m][1] + v0[2] * sn4[m][1];
                        r1[0] = v1[0] * cs4[m][2] - v1[1] * sn4[m][2]; r1[1] = v1[1] * cs4[m][2] + v1[0] * sn4[m][2];
                        r1[2] = v1[2] * cs4[m][3] - v1[3] * sn4[m][3]; r1[3] = v1[3] * cs4[m][3] + v1[2] * sn4[m][3];
                        st8bf(O + row * 512 + cs0 + bj * 128, r0, r1); } }
                __builtin_amdgcn_sched_barrier(0); }
            return;
        }
#pragma unroll
        for (int ai = 0; ai < 2; ++ai)
#pragma unroll
            for (int m = 0; m < 4; ++m) { const size_t row = (size_t)(u.pm * 256 + ai * 128 + wr * 64 + m * 16 + fr);
#pragma unroll
                for (int bj = 0; bj < 2; ++bj) { f32x4 v0 = acc[ai][bj][m][0], v1 = acc[ai][bj][m][1]; const int cs = cs0 + bj * 128;
                    if (silu_sec) {
#pragma unroll
                        for (int j = 0; j < 4; ++j) { v0[j] = siluf_(v0[j]); v1[j] = siluf_(v1[j]); }
                    }
                    st8bf(O + row * 512 + cs, v0, v1); } __builtin_amdgcn_sched_barrier(0); }
    }
};

struct PF1 {
    int skew_ticks = 0;
    static constexpr int SEGT = 2;
    int nt; __device__ __forceinline__ int nt_of(const Unit&) const { return nt; }
    static constexpr bool PERM = true, GATHER = false;
    const char* Alat; const char* Actx; const char* B; int G, c, nunits; u16* Olat; u16* Octx;
    __device__ __forceinline__ bool next(int i, Unit& u) const { const int L = i * G + c; if (L >= nunits) return false;
        if (L < 256) { u.aux = L >> 2; u.pn = L & 3; u.pm = 0; } else { u.aux = L - 256; u.pn = 0; u.pm = 1; } return true; }
    __device__ __forceinline__ const char* kA(const Unit& u, int h, int kt) const { return (u.pm ? Actx : Alat) + (size_t)h * 128 * 512 + (size_t)kt * 128; }
    __device__ __forceinline__ const char* kB(const Unit& u, int h, int kt) const { const int b = u.aux >> 2, g = u.aux & 3;
        if (u.pm) return B + ((size_t)(b * LC + h * 128) * 512 + g * 128) * 2 + (size_t)kt * 128;
        return B + ((size_t)(TC + b * SEQ + (kt >> 1) * 1024 + u.pn * 256 + h * 128) * 512 + g * 128 + (kt & 1) * 64) * 2; }
    __device__ __forceinline__ const char* uA(const Unit& u, int h) const { return kA(u, h, 0); }
    __device__ __forceinline__ const char* uB(const Unit& u, int h) const { return kB(u, h, 0); }
    __device__ __forceinline__ unsigned laneA(int R, int C) const { return (unsigned)(R * 512 + C * 2); }
    __device__ __forceinline__ unsigned laneB(int R, int C) const { return (unsigned)(R * 1024 + C * 2); }
    __device__ __forceinline__ void seg_hook(Acc&, const Unit&, int, int, int, int, int) const {}
    __device__ __forceinline__ void epi(const Acc& acc, const Unit& u, int wr, int wc, int fr, int fq) const {
        u16* Ob = (u.pm ? Octx : Olat) + (size_t)(u.aux * 128 + wr * 64 + fr) * 2048 + u.pn * 256 + wc * 32 + 8 * fq;
        const int half_off = u.pm ? 256 : 1024;
#pragma unroll
        for (int ai = 0; ai < 2; ++ai)
#pragma unroll
            for (int m = 0; m < 4; ++m) {
#pragma unroll
                for (int bj = 0; bj < 2; ++bj)
                    st8bf(Ob + (size_t)m * 16 * 2048 + ai * half_off + bj * 128, acc[ai][bj][m][0], acc[ai][bj][m][1]);
                __builtin_amdgcn_sched_barrier(0); }
    }
};
struct PF2 {
    int skew_ticks = 0;
    static constexpr int SEGT = 0; __device__ __forceinline__ const char* kA(const Unit&, int, int) const { return nullptr; } __device__ __forceinline__ const char* kB(const Unit&, int, int) const { return nullptr; }
    static constexpr bool PERM = true, GATHER = false;
    const char* Alat; const char* Blat; const char* Actx; const char* Bctx; int G, c, nunits; u16* O; const float* ucm;
    int nt_lat, nt_ctx; __device__ __forceinline__ int nt_of(const Unit& u) const { return u.aux ? nt_ctx : nt_lat; }
    __device__ __forceinline__ bool next(int i, Unit& u) const { const int L = i * G + c; if (L >= nunits) return false;
        if (L < 256) { int pm, pn; pg8::static_tile(L, 8, 32, pm, pn); u.pm = pm; u.pn = pn; u.aux = 0; } else { u.pm = 0; u.pn = L - 256; u.aux = 1; } return true; }
    __device__ __forceinline__ const char* uA(const Unit& u, int h) const { return (u.aux ? Actx : Alat) + (size_t)(u.pm * 256 + h * 128) * 4096; }
    __device__ __forceinline__ const char* uB(const Unit& u, int h) const { return (u.aux ? Bctx : Blat) + (size_t)(u.pn * 256 + h * 128) * 4096; }
    __device__ __forceinline__ unsigned laneA(int R, int C) const { return (unsigned)(R * 4096 + C * 2); }
    __device__ __forceinline__ unsigned laneB(int R, int C) const { return (unsigned)(R * 4096 + C * 2); }
    __device__ __forceinline__ void epi(const Acc& acc, const Unit& u, int wr, int wc, int fr, int fq) const {
        const float scale = u.aux ? 0.005524271728019903f : (1.f / 512.f);
        const int lseg = u.aux ? LC : SEQ, rowbase = u.aux ? 0 : TC;
        const int ci0 = u.pn * 256 + wc * 32 + 8 * fq, b = ci0 >> 9, rem = ci0 & 511;
        u16* Ob = O + (size_t)(rowbase + b * lseg + u.pm * 256 + wr * 64 + fr) * 512 + rem;
        f32x4 mid[2][2];
        const float sg = u.aux ? 0.f : ((fr & 1) ? -1.f : 1.f);
#pragma unroll
        for (int bj = 0; bj < 2; ++bj)
#pragma unroll
            for (int n = 0; n < 2; ++n) mid[bj][n] = GLD(f32x4, ucm + ci0 + bj * 128 + n * 4) * sg;
#pragma unroll
        for (int ai = 0; ai < 2; ++ai)
#pragma unroll
            for (int m = 0; m < 4; ++m) {
#pragma unroll
                for (int bj = 0; bj < 2; ++bj)
                    st8bf(Ob + (size_t)(ai * 128 + m * 16) * 512 + bj * 128, (acc[ai][bj][m][0] + mid[bj][0]) * scale, (acc[ai][bj][m][1] + mid[bj][1]) * scale);
                __builtin_amdgcn_sched_barrier(0); }
    }
};
struct PMerge {
    static constexpr int SEGT = 8;
    __device__ __forceinline__ int nt_of(const Unit&) const { return nt; }
    static constexpr bool PERM = true, GATHER = false;
    unsigned char* ws; int nt, G, c, nM, rt0; int dry = 0;
    __device__ __forceinline__ bool next(int i, Unit& u) const { int pm, pn; if (!pg8::static_tile((long)i * G + c, nM, 4, pm, pn)) return false; u.pm = rt0 + pm; u.pn = pn; u.aux = 0; return true; }
    __device__ __forceinline__ const char* kA(const Unit& u, int h, int kt) const { const int sg = kt >> 3; const size_t off = sg == 0 ? WS_P0 : (sg == 1 ? WS_P5 : WS_P3);
        return (const char*)ws + off + (size_t)(u.pm * 256 + h * 128) * 1024 + (size_t)(kt & 7) * 128; }
    __device__ __forceinline__ const char* kB(const Unit& u, int h, int kt) const { const int sg = kt >> 3;
        return (const char*)ws + WS_WL + WL_WPA + (size_t)sg * MiB + (size_t)(u.pn * 256 + h * 128) * 1024 + (size_t)(kt & 7) * 128; }
    __device__ __forceinline__ const char* uA(const Unit& u, int h) const { return kA(u, h, 0); }
    __device__ __forceinline__ const char* uB(const Unit& u, int h) const { return kB(u, h, 0); }
    __device__ __forceinline__ unsigned laneA(int R, int C) const { return (unsigned)(R * 1024 + C * 2); }
    __device__ __forceinline__ unsigned laneB(int R, int C) const { return (unsigned)(R * 1024 + C * 2); }
    __device__ __forceinline__ void seg_hook(Acc& acc, const Unit& u, int sg, int wr, int wc, int fr, int fq) const {
        if (dry == 2) return;
        const int tidf = (wr * 4 + wc) * 64 + fq * 16 + fr;
        const u16* Gp = (const u16*)(ws + WS_GATES) + ((size_t)(u.pm * 3 + (sg - 1)) * 4 + u.pn) * 65536 + tidf * 8;
        const u16* Gn = Gp + 4 * 65536;
        u32x4 bp[2][2][2], bn[2][2][2];
#define HK_LOAD(buf, q) do { _Pragma("unroll") for (int mm = 0; mm < 2; ++mm) _Pragma("unroll") for (int bj = 0; bj < 2; ++bj) { \
            const int fo = ((((q) >> 1) * 4 + ((q) & 1) * 2 + mm) * 2 + bj) * 4096; bp[buf][mm][bj] = *(const u32x4*)(Gp + fo); bn[buf][mm][bj] = *(const u32x4*)(Gn + fo); } } while (0)
#define HK_APPLY(buf, q) do { _Pragma("unroll") for (int mm = 0; mm < 2; ++mm) _Pragma("unroll") for (int bj = 0; bj < 2; ++bj) { float fp[8], fn[8]; unpack8(bp[buf][mm][bj], fp); unpack8(bn[buf][mm][bj], fn); \
            const int ai = (q) >> 1, m = ((q) & 1) * 2 + mm; \
            _Pragma("unroll") for (int j = 0; j < 4; ++j) { acc[ai][bj][m][0][j] *= fn[j] * __builtin_amdgcn_rcpf(fp[j]); acc[ai][bj][m][1][j] *= fn[4 + j] * __builtin_amdgcn_rcpf(fp[4 + j]); } } } while (0)
        HK_LOAD(0, 0); HK_LOAD(1, 1); __builtin_amdgcn_sched_barrier(0);
        HK_APPLY(0, 0); __builtin_amdgcn_sched_barrier(0); HK_LOAD(0, 2); __builtin_amdgcn_sched_barrier(0);
        HK_APPLY(1, 1); __builtin_amdgcn_sched_barrier(0); HK_LOAD(1, 3); __builtin_amdgcn_sched_barrier(0);
        HK_APPLY(0, 2); __builtin_amdgcn_sched_barrier(0);
        HK_APPLY(1, 3); __builtin_amdgcn_sched_barrier(0);
#undef HK_LOAD
#undef HK_APPLY
    }
    __device__ __forceinline__ void epi(const Acc& acc, const Unit& u, int wr, int wc, int fr, int fq) const {
        const int tidf = (wr * 4 + wc) * 64 + fq * 16 + fr;
        const u16* Gt = (const u16*)(ws + WS_GATES) + ((size_t)(u.pm * 3 + 2) * 4 + u.pn) * 65536 + tidf * 8;
        u16* M = (u16*)(ws + (dry ? WS_P1 : WS_H)) + (size_t)(u.pm * 256 + wr * 64 + fr) * 1024 + u.pn * 256 + wc * 32 + 8 * fq;
#pragma unroll
        for (int ai = 0; ai < 2; ++ai) {
            u32x4 g[4][2];
#pragma unroll
            for (int m = 0; m < 4; ++m)
#pragma unroll
                for (int bj = 0; bj < 2; ++bj) g[m][bj] = *(const u32x4*)(Gt + ((ai * 4 + m) * 2 + bj) * 4096);
#pragma unroll
            for (int m = 0; m < 4; ++m)
#pragma unroll
                for (int bj = 0; bj < 2; ++bj) { float fg[8]; unpack8(g[m][bj], fg);
                    f32x4 v0 = acc[ai][bj][m][0], v1 = acc[ai][bj][m][1];
#pragma unroll
                    for (int j = 0; j < 4; ++j) { v0[j] *= __builtin_amdgcn_rcpf(fg[j]); v1[j] *= __builtin_amdgcn_rcpf(fg[4 + j]); }
                    st8bf(M + (size_t)(ai * 128 + m * 16) * 1024 + bj * 128, v0, v1); }
            __builtin_amdgcn_sched_barrier(0); }
    }
};
struct POut {
    static constexpr int SEGT = 0; __device__ __forceinline__ const char* kA(const Unit&, int, int) const { return nullptr; } __device__ __forceinline__ const char* kB(const Unit&, int, int) const { return nullptr; }
    __device__ __forceinline__ int nt_of(const Unit&) const { return nt; }
    static constexpr bool PERM = true, GATHER = false;
    const char* A; const char* B; int nt, G, c, nM, rt0;
    const float* src_c; const float* src_l; u16* xb; const float* mod;
    __device__ __forceinline__ bool next(int i, Unit& u) const { int pm, pn; if (!pg8::static_tile((long)i * G + c, nM, 4, pm, pn)) return false; u.pm = rt0 + pm; u.pn = pn; u.aux = 0; return true; }
    __device__ __forceinline__ const char* uA(const Unit& u, int h) const { return A + (size_t)(u.pm * 256 + h * 128) * 2048; }
    __device__ __forceinline__ const char* uB(const Unit& u, int h) const { return B + (size_t)(u.pn * 256 + h * 128) * 2048; }
    __device__ __forceinline__ unsigned laneA(int R, int C) const { return (unsigned)(R * 2048 + C * 2); }
    __device__ __forceinline__ unsigned laneB(int R, int C) const { return (unsigned)(R * 2048 + C * 2); }
    __device__ __forceinline__ void epi(const Acc& acc, const Unit& u, int wr, int wc, int fr, int fq) const {
        const int row0 = u.pm * 256;
        const int mi = row0 < TC ? 16 : ((row0 - TC) >> 11);
        const int col0 = u.pn * 256 + wc * 32 + 8 * fq;
        const float* g1 = mod + (size_t)mi * 6144 + 2048 + col0;
        f32x4 gv[2][2];
#pragma unroll
        for (int bj = 0; bj < 2; ++bj)
#pragma unroll
            for (int n = 0; n < 2; ++n) gv[bj][n] = *(const f32x4*)(g1 + bj * 128 + n * 4);
        const int rb = row0 + wr * 64 + fr;
        const float* sp0 = (row0 < TC ? src_c + (size_t)rb * 1024 : src_l + (size_t)(rb - TC) * 1024) + col0;
        u16* dp0 = xb + (size_t)rb * 1024 + col0;
#pragma unroll
        for (int ai = 0; ai < 2; ++ai)
#pragma unroll
            for (int mp = 0; mp < 2; ++mp) {
                f32x4 xv[2][2][2];
#pragma unroll
                for (int mm = 0; mm < 2; ++mm)
#pragma unroll
                    for (int bj = 0; bj < 2; ++bj)
#pragma unroll
                        for (int n = 0; n < 2; ++n) xv[mm][bj][n] = *(const f32x4*)(sp0 + (size_t)(ai * 128 + (2 * mp + mm) * 16) * 1024 + bj * 128 + n * 4);
#pragma unroll
                for (int mm = 0; mm < 2; ++mm)
#pragma unroll
                    for (int bj = 0; bj < 2; ++bj)
                        st8bf(dp0 + (size_t)(ai * 128 + (2 * mp + mm) * 16) * 1024 + bj * 128, xv[mm][bj][0] * ALPHA + gv[bj][0] * acc[ai][bj][2 * mp + mm][0], xv[mm][bj][1] * ALPHA + gv[bj][1] * acc[ai][bj][2 * mp + mm][1]);
                __builtin_amdgcn_sched_barrier(0); }
    }
};
struct PRouter {
    static constexpr int SEGT = 0; __device__ __forceinline__ const char* kA(const Unit&, int, int) const { return nullptr; } __device__ __forceinline__ const char* kB(const Unit&, int, int) const { return nullptr; }
    __device__ __forceinline__ int nt_of(const Unit&) const { return nt; }
    static constexpr bool PERM = false, GATHER = false;
    const char* A; const char* B; int nt, G, c, nM, rt0; float* logits;
    __device__ __forceinline__ bool next(int i, Unit& u) const { const long L = (long)i * G + c; if (L >= nM) return false; u.pm = rt0 + (int)L; u.pn = 0; u.aux = 0; return true; }
    __device__ __forceinline__ const char* uA(const Unit& u, int h) const { return A + (size_t)(u.pm * 256 + h * 128) * 2048; }
    __device__ __forceinline__ const char* uB(const Unit&, int h) const { return B + (size_t)(h * 128) * 2048; }
    __device__ __forceinline__ unsigned laneA(int R, int C) const { return (unsigned)(R * 2048 + C * 2); }
    __device__ __forceinline__ unsigned laneB(int R, int C) const { return (unsigned)(R * 2048 + C * 2); }
    __device__ __forceinline__ void epi(const Acc& acc, const Unit& u, int wr, int wc, int fr, int fq) const {
        if (wc >= 2) return;
#pragma unroll
        for (int ai = 0; ai < 2; ++ai)
#pragma unroll
            for (int m = 0; m < 4; ++m) { const size_t row = (size_t)(u.pm * 256 + ai * 128 + wr * 64 + m * 16 + fr);
#pragma unroll
                for (int n = 0; n < 2; ++n) *(f32x4*)(logits + row * 64 + wc * 32 + n * 16 + 4 * fq) = acc[ai][0][m][n]; }
    }
};
__device__ __forceinline__ int ld_agent_i(const int* p) { return (int)__hip_atomic_load((const unsigned*)p, __ATOMIC_RELAXED, __HIP_MEMORY_SCOPE_AGENT); }
struct PUpGate {
    static constexpr int SEGT = 0; __device__ __forceinline__ const char* kA(const Unit&, int, int) const { return nullptr; } __device__ __forceinline__ const char* kB(const Unit&, int, int) const { return nullptr; }
    __device__ __forceinline__ int nt_of(const Unit&) const { return nt; }
    static constexpr bool PERM = true, GATHER = true;
    const char* A; const char* B; int nt, G, c, ntiles; const LAS int* lrt; const LAS int* lte; u16* hb;
    __device__ __forceinline__ bool next(int i, Unit& u) const { const long L = (long)i * G + c; if (L >= 2L * ntiles) return false; u.pm = (int)(L >> 1); u.pn = (int)(L & 1); u.ord = i;
        u.aux = __builtin_amdgcn_readfirstlane(lte[u.pm]); return true; }
    __device__ __forceinline__ const char* uA(const Unit&, int) const { return A; }
    __device__ __forceinline__ const char* uB(const Unit& u, int h) const { return B + (size_t)u.aux * MiB + (size_t)(u.pn * 256 + h * 128) * 2048; }
    __device__ __forceinline__ unsigned laneA(int, int) const { return 0u; }
    __device__ __forceinline__ unsigned laneB(int R, int C) const { return (unsigned)(R * 2048 + C * 2); }
    __device__ __forceinline__ void gatherA(const Unit& u, const int (&R)[2], const int (&C)[2], unsigned (&vo)[2][2]) const {
#pragma unroll
        for (int h = 0; h < 2; ++h)
#pragma unroll
            for (int i = 0; i < 2; ++i) { int tok = lrt[u.ord * 256 + h * 128 + R[i]]; tok = tok < 0 ? 0 : tok; vo[h][i] = (unsigned)tok * 2048u + (unsigned)(C[i] * 2); }
    }
    __device__ __forceinline__ void epi(const Acc& acc, const Unit& u, int wr, int wc, int fr, int fq) const {
#pragma unroll
        for (int ai = 0; ai < 2; ++ai)
#pragma unroll
            for (int m = 0; m < 4; ++m) { const size_t row = (size_t)u.pm * 256 + ai * 128 + wr * 64 + m * 16 + fr;
                f32x4 v0, v1;
#pragma unroll
                for (int j = 0; j < 4; ++j) { v0[j] = siluf_(acc[ai][0][m][0][j]) * acc[ai][1][m][0][j]; v1[j] = siluf_(acc[ai][0][m][1][j]) * acc[ai][1][m][1][j]; }
                st8bf(hb + row * 256 + u.pn * 128 + wc * 32 + 8 * fq, v0, v1); __builtin_amdgcn_sched_barrier(0); }
    }
};
struct PDown {
    static constexpr int SEGT = 0; __device__ __forceinline__ const char* kA(const Unit&, int, int) const { return nullptr; } __device__ __forceinline__ const char* kB(const Unit&, int, int) const { return nullptr; }
    __device__ __forceinline__ int nt_of(const Unit&) const { return nt; }
    static constexpr bool PERM = true, GATHER = false;
    const char* A; const char* B; int nt, G, c, ntiles; const LAS int* lte; unsigned char* so;
    __device__ __forceinline__ bool next(int i, Unit& u) const { const long L = (long)i * G + c; if (L >= 4L * ntiles) return false; u.pm = (int)(L >> 2); u.pn = (int)(L & 3); u.ord = i;
        u.aux = __builtin_amdgcn_readfirstlane(lte[u.pm]); return true; }
    __device__ __forceinline__ const char* uA(const Unit& u, int h) const { return A + (size_t)(u.pm * 256 + h * 128) * 512; }
    __device__ __forceinline__ const char* uB(const Unit& u, int h) const { return B + (size_t)u.aux * 524288 + (size_t)(u.pn * 256 + h * 128) * 512; }
    __device__ __forceinline__ unsigned laneA(int R, int C) const { return (unsigned)(R * 512 + C * 2); }
    __device__ __forceinline__ unsigned laneB(int R, int C) const { return (unsigned)(R * 512 + C * 2); }
    __device__ __forceinline__ void epi(const Acc& acc, const Unit& u, int wr, int wc, int fr, int fq) const {
#pragma unroll
        for (int ai = 0; ai < 2; ++ai)
#pragma unroll
            for (int m = 0; m < 4; ++m) { const size_t row = (size_t)u.pm * 256 + ai * 128 + wr * 64 + m * 16 + fr;
                {
                    int w[2][2];
#pragma unroll
                    for (int bj = 0; bj < 2; ++bj) { const f32x4 v0 = acc[ai][bj][m][0] * 16.f, v1 = acc[ai][bj][m][1] * 16.f; int w0 = 0, w1 = 0;
                        w0 = __builtin_amdgcn_cvt_pk_fp8_f32(v0[0], v0[1], w0, false); w0 = __builtin_amdgcn_cvt_pk_fp8_f32(v0[2], v0[3], w0, true);
                        w1 = __builtin_amdgcn_cvt_pk_fp8_f32(v1[0], v1[1], w1, false); w1 = __builtin_amdgcn_cvt_pk_fp8_f32(v1[2], v1[3], w1, true);
                        w[bj][0] = w0; w[bj][1] = w1; }
                    const auto r0 = __builtin_amdgcn_permlane16_swap((unsigned)w[0][0], (unsigned)w[1][0], false, false);
                    const auto r1 = __builtin_amdgcn_permlane16_swap((unsigned)w[0][1], (unsigned)w[1][1], false, false);
                    const u32x4 q = {r0[0], r1[0], r0[1], r1[1]};
                    const int colo = (fq & 1) ? 128 + 8 * (fq - 1) : 8 * fq;
                    *(u32x4*)(so + row * 1024 + u.pn * 256 + wc * 32 + colo) = q; }
                __builtin_amdgcn_sched_barrier(0); }
    }
};
namespace att {
constexpr int NW = 8, QBLK = 32, KVBLK = 64;
constexpr float SCALE = 0.125f;
constexpr float THR = 8.f;
constexpr int SHM_V = KVBLK * 128 * 2, SHM_K = KVBLK * 64 * 2, SHM_ATTN = 2 * SHM_V + 2 * SHM_K + NW * 64 * 4;
#define KSWZ64(row, colB) ((row) * 128 + ((colB) ^ (((row) & 7) << 4)))
#ifndef ATT_NOSBAR
#define ATT_NOSBAR 0
#endif
#if ATT_NOSBAR
#define SBAR() do {} while (0)
#else
#define SBAR() __builtin_amdgcn_sched_barrier(0)
#endif
template <bool NOEXP = false>
__device__ __forceinline__ void partialSM(f32x16& p0, f32x16& p1, float& m_reg, float& mn, float& alpha) {
  constexpr float C = SCALE * 1.4426950408889634f;
  float pm4[4];
#pragma unroll
  for (int k = 0; k < 4; ++k) pm4[k] = fmaxf(fmaxf(p0[k], p0[4 + k]), fmaxf(p0[8 + k], p0[12 + k]));
#pragma unroll
  for (int k = 0; k < 4; ++k) pm4[k] = fmaxf(pm4[k], fmaxf(fmaxf(p1[k], p1[4 + k]), fmaxf(p1[8 + k], p1[12 + k])));
  float pmax = fmaxf(fmaxf(pm4[0], pm4[1]), fmaxf(pm4[2], pm4[3]));
  { auto rr = __builtin_amdgcn_permlane32_swap(__float_as_uint(pmax), __float_as_uint(pmax), false, false);
    pmax = fmaxf(__uint_as_float(rr[0]), __uint_as_float(rr[1])); }
  if (__builtin_expect(__all(pmax - m_reg <= THR / SCALE), 1)) { mn = m_reg; alpha = 1.f; }
  else { mn = fmaxf(m_reg, pmax); alpha = __builtin_amdgcn_exp2f((m_reg - mn) * C); m_reg = mn; }
  float mnC = -mn * C;
#pragma unroll
  for (int r = 0; r < 16; ++r) p0[r] = fmaf(p0[r], C, mnC);
#pragma unroll
  for (int r = 0; r < 16; ++r) p1[r] = fmaf(p1[r], C, mnC);
#pragma unroll
  for (int r = 0; r < 16; ++r) p0[r] = NOEXP ? p0[r] : __builtin_amdgcn_exp2f(p0[r]);
}
template <bool NOEXP = false, bool NOSUM = false>
__device__ __forceinline__ void finishSM(f32x16& p0, f32x16& p1, float alpha, float& l_reg, bf16x8& pa0, bf16x8& pa1, bf16x8& pa2, bf16x8& pa3) {
#pragma unroll
  for (int r = 0; r < 16; ++r) p1[r] = NOEXP ? p1[r] : __builtin_amdgcn_exp2f(p1[r]);
  float ps4[4];
#pragma unroll
  for (int k = 0; k < 4; ++k) ps4[k] = (p0[k] + p0[4 + k]) + (p0[8 + k] + p0[12 + k]);
#pragma unroll
  for (int k = 0; k < 4; ++k) ps4[k] += (p1[k] + p1[4 + k]) + (p1[8 + k] + p1[12 + k]);
  if (!NOSUM) {
  float ps = (ps4[0] + ps4[1]) + (ps4[2] + ps4[3]);
  { auto rr = __builtin_amdgcn_permlane32_swap(__float_as_uint(ps), __float_as_uint(ps), false, false);
    ps = __uint_as_float(rr[0]) + __uint_as_float(rr[1]); }
  l_reg = l_reg * alpha + ps; }
#define PK4(P, BASE, OUT) do { unsigned a0 = cvtpk(P[BASE + 0], P[BASE + 1]), a1 = cvtpk(P[BASE + 2], P[BASE + 3]);   \
    unsigned b0 = cvtpk(P[BASE + 4], P[BASE + 5]), b1 = cvtpk(P[BASE + 6], P[BASE + 7]);                              \
    auto r0 = __builtin_amdgcn_permlane32_swap(a0, b0, false, false); auto r1 = __builtin_amdgcn_permlane32_swap(a1, b1, false, false); \
    u32x4 w = {r0[0], r1[0], r0[1], r1[1]}; OUT = *reinterpret_cast<bf16x8*>(&w); } while (0)
  PK4(p0, 0, pa0); PK4(p0, 8, pa1); PK4(p1, 0, pa2); PK4(p1, 8, pa3);
#undef PK4
}
__device__ __forceinline__ void qkt(f32x16& p0, f32x16& p1, const LAS char* Ks, const bf16x8* qr, int r32, int hi) {
  p0 = f32x16{}; p1 = f32x16{};
#pragma unroll
  for (int d0 = 0; d0 < 4; ++d0) { int cb = (d0 * 16 + hi * 8) * 2;
    bf16x8 b0 = *(const LAS bf16x8*)(Ks + KSWZ64(r32, cb));
    bf16x8 b1 = *(const LAS bf16x8*)(Ks + KSWZ64(32 + r32, cb));
    p0 = __builtin_amdgcn_mfma_f32_32x32x16_bf16(b0, qr[d0], p0, 0, 0, 0);
    p1 = __builtin_amdgcn_mfma_f32_32x32x16_bf16(b1, qr[d0], p1, 0, 0, 0); }
}
__device__ __forceinline__ int v_st(int k, int c) { const int kk = (k & ~0xC) | ((k & 4) << 1) | ((k & 8) >> 1); return ((kk >> 3) * 4 + (c >> 5)) * 512 + ((kk & 7) * 32 + (c & 31)) * 2; }
__device__ __forceinline__ int v_rd_base(int lane) { return ((lane & 3) << 3) | (((lane >> 2) & 3) << 6) | (((lane >> 4) & 1) << 5) | (((lane >> 5) & 1) << 8); }
constexpr int v_rd_off(int d0, int ks, int half) { return d0 * 512 + ks * 4096 + half * 2048; }
template <int OFF> __device__ __forceinline__ s16x4 tr_read(int vb) {
  s16x4 r; asm volatile("ds_read_b64_tr_b16 %0, %1 offset:%2" : "=&v"(r) : "v"(vb), "i"(OFF) : "memory"); return r;
}
template <int D0> __device__ __forceinline__ void pv_one(f32x16& od, int vb, bf16x8 pa0, bf16x8 pa1, bf16x8 pa2, bf16x8 pa3) {
  const s16x4 l0 = tr_read<v_rd_off(D0, 0, 0)>(vb), h0 = tr_read<v_rd_off(D0, 0, 1)>(vb), l1 = tr_read<v_rd_off(D0, 1, 0)>(vb), h1 = tr_read<v_rd_off(D0, 1, 1)>(vb);
  const s16x4 l2 = tr_read<v_rd_off(D0, 2, 0)>(vb), h2 = tr_read<v_rd_off(D0, 2, 1)>(vb), l3 = tr_read<v_rd_off(D0, 3, 0)>(vb), h3 = tr_read<v_rd_off(D0, 3, 1)>(vb);
  asm volatile("s_waitcnt lgkmcnt(0)" ::: "memory"); SBAR();
#define PK(L, H) (bf16x8){L[0], L[1], L[2], L[3], H[0], H[1], H[2], H[3]}
  od = __builtin_amdgcn_mfma_f32_32x32x16_bf16(pa0, PK(l0, h0), od, 0, 0, 0);
  od = __builtin_amdgcn_mfma_f32_32x32x16_bf16(pa1, PK(l1, h1), od, 0, 0, 0);
  od = __builtin_amdgcn_mfma_f32_32x32x16_bf16(pa2, PK(l2, h2), od, 0, 0, 0);
  od = __builtin_amdgcn_mfma_f32_32x32x16_bf16(pa3, PK(l3, h3), od, 0, 0, 0);
#undef PK
}
__device__ __forceinline__ void pv_d0(f32x16* o, int vb, bf16x8 pa0, bf16x8 pa1, bf16x8 pa2, bf16x8 pa3) {
  pv_one<0>(o[0], vb, pa0, pa1, pa2, pa3); pv_one<1>(o[1], vb, pa0, pa1, pa2, pa3); pv_one<2>(o[2], vb, pa0, pa1, pa2, pa3); pv_one<3>(o[3], vb, pa0, pa1, pa2, pa3);
}
__device__ __forceinline__ void attn_unit(const u16* __restrict__ Q, const u16* __restrict__ K, const u16* __restrict__ V, u16* __restrict__ On,
                                          int qrow0, int b, int h, int map, int NT, LAS char* lds) {
  int tid_ = threadIdx.x; asm volatile("" : "+v"(tid_));
  const int tid = tid_, wid = tid >> 6, lane = tid & 63, r32 = lane & 31, hi = lane >> 5;
  LAS char* V_lds = lds; LAS char* K_lds = lds + 2 * SHM_V;
  LAS float* ws = (LAS float*)(lds + 2 * SHM_V + 2 * SHM_K) + wid * 64; LAS float* li_l = ws; LAS float* al_l = ws + 32;
  float m_reg = -1e30f, l_reg = 0; f32x16 o[4] = {}; bf16x8 qr[4];
  const u16* Qw = Q + (size_t)(qrow0 + wid * QBLK + r32) * 512 + h * 128 + map * 64 + hi * 8;
#pragma unroll
  for (int d0 = 0; d0 < 4; ++d0) qr[d0] = *reinterpret_cast<const bf16x8*>(Qw + d0 * 16);
  const int sr = tid >> 4, sc = (tid & 15) * 8, vst0 = v_st(sr, sc), vst1 = v_st(32 + sr, sc);
  const int kr = tid >> 3, kc = (tid & 7) * 8, kst = KSWZ64(kr, kc * 2);
  const int vb0 = (int)(uintptr_t)V_lds + v_rd_base(lane);
  const u16* Kc = K + h * 128 + map * 64 + kc; const u16* Vc = V + h * 128 + sc;
  struct { bf16x8 vs0, vs1, ks0; } sr_[2];
#define KROW(k0) ((k0) < LC ? b * LC + (k0) : TC + b * SEQ + (k0) - LC)
#define SLOAD(i, k0) do { const size_t _r = (size_t)KROW(k0); sr_[i].vs0 = *reinterpret_cast<const bf16x8*>(Vc + (_r + sr) * 512); sr_[i].vs1 = *reinterpret_cast<const bf16x8*>(Vc + (_r + 32 + sr) * 512); \
    sr_[i].ks0 = *reinterpret_cast<const bf16x8*>(Kc + (_r + kr) * 512); } while (0)
#define SWRITE(bb, i) do { *(LAS bf16x8*)(V_lds + (bb) * SHM_V + vst0) = sr_[i].vs0; *(LAS bf16x8*)(V_lds + (bb) * SHM_V + vst1) = sr_[i].vs1; \
    *(LAS bf16x8*)(K_lds + (bb) * SHM_K + kst) = sr_[i].ks0; } while (0)
#define SWAIT() asm volatile("s_waitcnt vmcnt(3)" ::: "memory")
#define RESC(a) do { if (__any((a) < 1.f)) { if (hi == 0) al_l[r32] = (a); asm volatile("s_waitcnt lgkmcnt(0)" ::: "memory"); \
    _Pragma("unroll") for (int d = 0; d < 4; ++d) _Pragma("unroll") for (int r = 0; r < 16; ++r) o[d][r] *= al_l[crow(r, hi)]; } } while (0)
  f32x16 pA0, pA1, pB0, pB1; float mnA, mnB, alA, alB; bf16x8 pa0, pa1, pa2, pa3;
  constexpr int SE = 0, SO = 1;
  SLOAD(SE, 0); asm volatile("s_waitcnt vmcnt(0)" ::: "memory"); SWRITE(0, SE); __syncthreads();
  qkt(pA0, pA1, K_lds, qr, r32, hi); partialSM(pA0, pA1, m_reg, mnA, alA);
  SLOAD(SO, KVBLK); if (2 < NT) SLOAD(SE, 2 * KVBLK);
  SWAIT(); SWRITE(1, SO); __syncthreads();
  for (int j = 1; j + 1 < NT; j += 2) {
    SBAR(); qkt(pB0, pB1, K_lds + SHM_K, qr, r32, hi);
    finishSM(pA0, pA1, alA, l_reg, pa0, pa1, pa2, pa3); SBAR();
    SLOAD(SO, (j + 2) * KVBLK); SBAR();
    pv_d0(o, vb0, pa0, pa1, pa2, pa3); partialSM(pB0, pB1, m_reg, mnB, alB);
    __syncthreads(); SWAIT(); SWRITE(0, SE);
    RESC(alB); __syncthreads();
    SBAR(); qkt(pA0, pA1, K_lds, qr, r32, hi);
    finishSM(pB0, pB1, alB, l_reg, pa0, pa1, pa2, pa3); SBAR();
    if (j + 3 < NT) SLOAD(SE, (j + 3) * KVBLK); SBAR();
    pv_d0(o, vb0 + SHM_V, pa0, pa1, pa2, pa3); partialSM(pA0, pA1, m_reg, mnA, alA);
    __syncthreads(); SWAIT(); SWRITE(1, SO);
    RESC(alA); __syncthreads();
  }
  SBAR(); qkt(pB0, pB1, K_lds + SHM_K, qr, r32, hi);
  finishSM(pA0, pA1, alA, l_reg, pa0, pa1, pa2, pa3); SBAR();
  pv_d0(o, vb0, pa0, pa1, pa2, pa3); partialSM(pB0, pB1, m_reg, mnB, alB);
  __syncthreads(); RESC(alB);
  finishSM(pB0, pB1, alB, l_reg, pa0, pa1, pa2, pa3); SBAR();
  pv_d0(o, vb0 + SHM_V, pa0, pa1, pa2, pa3);
  if (hi == 0) li_l[r32] = l_reg; asm volatile("s_waitcnt lgkmcnt(0)" ::: "memory");
  float rli[16];
#pragma unroll
  for (int r = 0; r < 16; ++r) rli[r] = __builtin_amdgcn_rcpf(li_l[crow(r, hi)]);
  u16* Ow = On + (size_t)(qrow0 + wid * QBLK) * 512 + h * 128;
#pragma unroll
  for (int r = 0; r < 16; ++r) { int orow = crow(r, hi);
#pragma unroll
    for (int d0 = 0; d0 < 4; ++d0) Ow[(size_t)orow * 512 + d0 * 32 + r32] = f2bf(o[d0][r] * rli[r]); }
  __syncthreads();
#undef KROW
#undef SLOAD
#undef SWRITE
#undef SWAIT
#undef RESC
}
template <int AD = 0>
__device__ __forceinline__ void attn_unit_dma(const u16* __restrict__ Q, const u16* __restrict__ K, const u16* __restrict__ V, u16* __restrict__ On,
                                              int qrow0, int b, int h, int map, int NT, LAS char* lds) {
  int tid_ = threadIdx.x; asm volatile("" : "+v"(tid_));
  const int tid = tid_, wid = __builtin_amdgcn_readfirstlane(tid >> 6), lane = tid & 63, r32 = lane & 31, hi = lane >> 5;
  LAS char* V_lds = lds; LAS char* K_lds = lds + 4 * SHM_V;
  LAS float* ws = (LAS float*)(lds + 4 * SHM_V + 4 * SHM_K) + wid * 64; LAS float* li_l = ws; LAS float* al_l = ws + 32;
  float m_reg = -1e30f, l_reg = 0; f32x16 o[4] = {}; bf16x8 qr[4];
  f32x16 o5 = {};
  const bf16x8 ONES = {(short)0x3F80, (short)0x3F80, (short)0x3F80, (short)0x3F80, (short)0x3F80, (short)0x3F80, (short)0x3F80, (short)0x3F80};
#define PV_ONES() do { o5 = __builtin_amdgcn_mfma_f32_32x32x16_bf16(pa0, ONES, o5, 0, 0, 0); o5 = __builtin_amdgcn_mfma_f32_32x32x16_bf16(pa1, ONES, o5, 0, 0, 0); \
    o5 = __builtin_amdgcn_mfma_f32_32x32x16_bf16(pa2, ONES, o5, 0, 0, 0); o5 = __builtin_amdgcn_mfma_f32_32x32x16_bf16(pa3, ONES, o5, 0, 0, 0); } while (0)
  const u16* Qw = Q + (size_t)(qrow0 + wid * QBLK + r32) * 512 + h * 128 + map * 64 + hi * 8;
#pragma unroll
  for (int d0 = 0; d0 < 4; ++d0) qr[d0] = *reinterpret_cast<const bf16x8*>(Qw + d0 * 16);
  const int vb0 = (int)(uintptr_t)V_lds + v_rd_base(lane);
  unsigned vsrc[2], ksrc;
#pragma unroll
  for (int i = 0; i < 2; ++i) { const int B = (tid + 512 * i) * 16, st = B >> 9, off = B & 511, kk = (st >> 2) * 8 + (off >> 6), c = (st & 3) * 32 + ((off & 63) >> 1);
    const int k = (kk & ~0xC) | ((kk & 4) << 1) | ((kk & 8) >> 1);
    vsrc[i] = (unsigned)(k * 512 + h * 128 + c); }
  { const int row = tid >> 3, colB = ((tid & 7) * 16) ^ ((row & 7) << 4); ksrc = (unsigned)(row * 512 + h * 128 + map * 64 + (colB >> 1)); }
#define KROW(k0) ((k0) < LC ? b * LC + (k0) : TC + b * SEQ + (k0) - LC)
#define DMA_TILE(t) do { const size_t _r = (size_t)KROW((t) * KVBLK) * 512; const int _s = (t) & 3; \
    __builtin_amdgcn_global_load_lds((const unsigned*)(V + _r + vsrc[0]), (LAS unsigned*)(V_lds + _s * SHM_V + wid * 1024), 16, 0, 0); \
    __builtin_amdgcn_global_load_lds((const unsigned*)(V + _r + vsrc[1]), (LAS unsigned*)(V_lds + _s * SHM_V + 8192 + wid * 1024), 16, 0, 0); \
    __builtin_amdgcn_global_load_lds((const unsigned*)(K + _r + ksrc), (LAS unsigned*)(K_lds + _s * SHM_K + wid * 1024), 16, 0, 0); } while (0)
#define TILE_READY(t) do { if ((t) + 1 < NT) asm volatile("s_waitcnt vmcnt(3)" ::: "memory"); else asm volatile("s_waitcnt vmcnt(0)" ::: "memory"); \
    __builtin_amdgcn_s_barrier(); asm volatile("" ::: "memory"); } while (0)
#define RESC(a) do { if (__any((a) < 1.f)) { if (hi == 0) al_l[r32] = (a); asm volatile("s_waitcnt lgkmcnt(0)" ::: "memory"); \
    _Pragma("unroll") for (int r = 0; r < 16; ++r) { const float a_ = al_l[crow(r, hi)]; o5[r] *= a_; _Pragma("unroll") for (int d = 0; d < 4; ++d) o[d][r] *= a_; } } } while (0)
  f32x16 pA0 = {}, pA1 = {}, pB0 = {}, pB1 = {}; float mnA = 0.f, mnB = 0.f, alA = 1.f, alB = 1.f; bf16x8 pa0 = {}, pa1 = {}, pa2 = {}, pa3 = {};
  DMA_TILE(0); DMA_TILE(1); DMA_TILE(2);
  asm volatile("s_waitcnt vmcnt(6)" ::: "memory"); __builtin_amdgcn_s_barrier(); asm volatile("" ::: "memory");
  if (AD != 4) qkt(pA0, pA1, K_lds, qr, r32, hi); if (AD != 5) partialSM<AD == 2>(pA0, pA1, m_reg, mnA, alA);
  TILE_READY(1); DMA_TILE(3);
  for (int j = 1; j + 1 < NT; j += 2) {
    SBAR(); if (AD != 4) qkt(pB0, pB1, K_lds + (j & 3) * SHM_K, qr, r32, hi);
    if (AD != 5) finishSM<AD == 2, true>(pA0, pA1, alA, l_reg, pa0, pa1, pa2, pa3); SBAR();
    if (AD != 3) pv_d0(o, vb0 + ((j - 1) & 3) * SHM_V, pa0, pa1, pa2, pa3); PV_ONES(); if (AD != 5) partialSM<AD == 2>(pB0, pB1, m_reg, mnB, alB);
    TILE_READY(j + 1); if (j + 3 < NT) DMA_TILE(j + 3);
    RESC(alB);
    SBAR(); if (AD != 4) qkt(pA0, pA1, K_lds + ((j + 1) & 3) * SHM_K, qr, r32, hi);
    if (AD != 5) finishSM<AD == 2, true>(pB0, pB1, alB, l_reg, pa0, pa1, pa2, pa3); SBAR();
    if (AD != 3) pv_d0(o, vb0 + (j & 3) * SHM_V, pa0, pa1, pa2, pa3); PV_ONES(); if (AD != 5) partialSM<AD == 2>(pA0, pA1, m_reg, mnA, alA);
    TILE_READY(j + 2); if (j + 4 < NT) DMA_TILE(j + 4);
    RESC(alA);
  }
  SBAR(); if (AD != 4) qkt(pB0, pB1, K_lds + ((NT - 1) & 3) * SHM_K, qr, r32, hi);
  if (AD != 5) finishSM<AD == 2, true>(pA0, pA1, alA, l_reg, pa0, pa1, pa2, pa3); SBAR();
  if (AD != 3) pv_d0(o, vb0 + ((NT - 2) & 3) * SHM_V, pa0, pa1, pa2, pa3); PV_ONES(); if (AD != 5) partialSM<AD == 2>(pB0, pB1, m_reg, mnB, alB);
  RESC(alB);
  if (AD != 5) finishSM<AD == 2, true>(pB0, pB1, alB, l_reg, pa0, pa1, pa2, pa3); SBAR();
  if (AD != 3) pv_d0(o, vb0 + ((NT - 1) & 3) * SHM_V, pa0, pa1, pa2, pa3); PV_ONES();
  float rli[16];
#pragma unroll
  for (int r = 0; r < 16; ++r) rli[r] = __builtin_amdgcn_rcpf(o5[r]);
  u16* Ow = On + (size_t)(qrow0 + wid * QBLK) * 512 + h * 128;
#pragma unroll
  for (int r = 0; r < 16; ++r) { int orow = crow(r, hi);
#pragma unroll
    for (int d0 = 0; d0 < 4; ++d0) Ow[(size_t)orow * 512 + d0 * 32 + r32] = f2bf(o[d0][r] * rli[r]); }
  __syncthreads();
#undef KROW
#undef DMA_TILE
#undef TILE_READY
#undef RESC
#undef PV_ONES
}
}

namespace hg {
constexpr int RS = 136, RS2 = 72;
constexpr int O_QH = 0, O_KH = 17408, O_KB = 35840, O_QQ = 48896, O_QD = 75008, O_KD = 92416, O_VT = 109824, O_PP = 119040, O_ST = 128256, O_TOT = 145664, O_DEC = 153856, O_END = 154368;
__device__ __forceinline__ void h4(const u32x2& w, float (&f)[4]) {
    f[0] = (float)__builtin_bit_cast(_Float16, (u16)(w[0] & 0xffffu)); f[1] = (float)__builtin_bit_cast(_Float16, (u16)(w[0] >> 16));
    f[2] = (float)__builtin_bit_cast(_Float16, (u16)(w[1] & 0xffffu)); f[3] = (float)__builtin_bit_cast(_Float16, (u16)(w[1] >> 16));
}
__device__ __forceinline__ void b4(const u32x2& w, float (&f)[4]) { f[0] = bf2f(w[0] & 0xffffu); f[1] = bf2f(w[0] >> 16); f[2] = bf2f(w[1] & 0xffffu); f[3] = bf2f(w[1] >> 16); }
__device__ __forceinline__ u32x2 pk4(float a, float b, float c, float d) { u32x2 w = {cvtpk(a, b), cvtpk(c, d)}; return w; }
template <int HD = 0>
__device__ __forceinline__ void hgrn_unit(unsigned char* ws, LAS unsigned char* lds, int layer, int b, int h, int dir, int eh) {
    int tid_ = threadIdx.x; asm volatile("" : "+v"(tid_));
    const int tid = tid_, wid = __builtin_amdgcn_readfirstlane(tid >> 6), lane = tid & 63;
    const u16* QHg = (const u16*)(ws + WS_P0);
    const u16* LFg = (const u16*)(ws + (dir ? WS_P2 : WS_P1));
    const u16* VVg = (const u16*)(ws + WS_P3);
    u16* OOg = (u16*)(ws + (HD ? WS_TT : (dir ? WS_OB : WS_OF)));
    LAS u16* sQH = (LAS u16*)(lds + O_QH); LAS u16* sKH = (LAS u16*)(lds + O_KH); LAS u16* sKB = (LAS u16*)(lds + O_KB); LAS u16* sQQ = (LAS u16*)(lds + O_QQ);
    LAS u16* sQD = (LAS u16*)(lds + O_QD); LAS u16* sKD = (LAS u16*)(lds + O_KD); LAS u16* sVT = (LAS u16*)(lds + O_VT); LAS u16* sPP = (LAS u16*)(lds + O_PP);
    LAS u16* sST = (LAS u16*)(lds + O_ST); LAS float* sTOT = (LAS float*)(lds + O_TOT); LAS float* sDEC = (LAS float*)(lds + O_DEC);
    for (int i = tid; i < (O_TOT - O_PP) / 4; i += 512) ((LAS unsigned*)(lds + O_PP))[i] = 0u;
    f32x16 S = {};
    __syncthreads();
    const int cq = tid & 31, rg = tid >> 5, d0 = 4 * cq, sb = rg >> 2;
    const int e4 = tid & 15, s2 = tid >> 4;
    const int l15 = lane & 15, q4 = lane >> 4, l32 = lane & 31, hi = lane >> 5;
    const int dt = wid >> 1, et = wid & 1;
    u32x2 pg[4], pq[4], pv[2];
#define HG_LOAD(c_) do { const bool ic_ = (c_) < 4; const int cc_ = ic_ ? (c_) : (c_) - 4, ls_ = ic_ ? LC : SEQ, rb_ = ic_ ? b * LC : TC + b * SEQ; \
        _Pragma("unroll") for (int r = 0; r < 4; ++r) { int pos = 64 * cc_ + 4 * rg + r; if (dir) pos = ls_ - 1 - pos; const size_t row = (size_t)(rb_ + pos); \
            pg[r] = *(const u32x2*)(LFg + row * 512 + h * 128 + d0); pq[r] = *(const u32x2*)(QHg + row * 512 + h * 128 + d0); } \
        _Pragma("unroll") for (int r = 0; r < 2; ++r) { int pos = 64 * cc_ + 2 * s2 + r; if (dir) pos = ls_ - 1 - pos; \
            pv[r] = *(const u32x2*)(VVg + (size_t)(rb_ + pos) * 512 + h * 128 + eh * 64 + 4 * e4); } } while (0)
    HG_LOAD(0);
    for (int c = 0; c < 36; ++c) {
        const bool isctx = c < 4; const int cc = isctx ? c : c - 4, lseg = isctx ? LC : SEQ, rowbase = isctx ? b * LC : TC + b * SEQ;
        const bool need_o = !(layer == DEPTH - 1 && isctx);
        float g[4][4], q[4][4], bl[4][4];
#pragma unroll
        for (int r = 0; r < 4; ++r) { h4(pg[r], g[r]); b4(pq[r], q[r]); }
#pragma unroll
        for (int cl = 0; cl < 4; ++cl) { float run = 0.f;
#pragma unroll
            for (int r = 0; r < 4; ++r) { run += g[r][cl]; bl[r][cl] = run; } }
        *(LAS f32x4*)(sTOT + rg * 128 + d0) = (f32x4){bl[3][0], bl[3][1], bl[3][2], bl[3][3]};
        const u32x2 v0 = pv[0], v1 = pv[1];
        __syncthreads();
        if (c > 0) {
#pragma unroll
            for (int rg4 = 0; rg4 < 4; ++rg4) { u32x2 w = {cvtpk(S[4 * rg4], S[4 * rg4 + 1]), cvtpk(S[4 * rg4 + 2], S[4 * rg4 + 3])};
                *(LAS u32x2*)(sST + (32 * et + l32) * RS + 32 * dt + 8 * rg4 + 4 * hi) = w; }
        }
#define EXPF(x) (HD == 2 ? (x) : __expf(x))
        if (HD != 4) {
            f32x4 acc4 = {0.f, 0.f, 0.f, 0.f}, P = acc4, br_i = acc4, bm_i = acc4, br_n = acc4, c3 = acc4, c7 = acc4, c11 = acc4;
#pragma unroll
            for (int rr = 0; rr < 16; ++rr) {
                if (rr == rg) P = acc4;
                if (rr == 4 * sb) br_i = acc4;
                acc4 += *(const LAS f32x4*)(sTOT + rr * 128 + d0);
                if (rr == 4 * sb + 1) bm_i = acc4;
                if (rr == 4 * sb + 3) br_n = acc4;
                if (rr == 3) c3 = acc4;
                if (rr == 7) c7 = acc4;
                if (rr == 11) c11 = acc4;
            }
            const f32x4 bend = acc4;
            if (rg == 0) { f32x4 dv;
#pragma unroll
                for (int cl = 0; cl < 4; ++cl) dv[cl] = EXPF(bend[cl]);
                *(LAS f32x4*)(sDEC + d0) = dv; }
            float cP[4], cE[4], cq0[4], cq1[4], cq2[4], pr[4], wn[4], wm[4];
#pragma unroll
            for (int cl = 0; cl < 4; ++cl) { cP[cl] = EXPF(br_i[cl]); cE[cl] = EXPF(bend[cl] - br_n[cl]);
                cq0[cl] = EXPF(br_i[cl] - c3[cl]); cq1[cl] = EXPF(br_i[cl] - c7[cl]); cq2[cl] = EXPF(br_i[cl] - c11[cl]);
                pr[cl] = P[cl] - br_i[cl]; wn[cl] = br_n[cl] - br_i[cl]; wm[cl] = bm_i[cl] - br_i[cl]; }
            const int pbase = sb * (sb - 1) / 2;
            float kh[4][4];
#pragma unroll
            for (int r = 0; r < 4; ++r) { const int t = 4 * rg + r, tk = t & 15;
                float vq[4], vk[4], vkb[4], vqq0[4], vqq1[4], vqq2[4], vqd[4], vkd[4];
#pragma unroll
                for (int cl = 0; cl < 4; ++cl) { const float brel = pr[cl] + bl[r][cl];
                    const float e1 = EXPF(brel), e2 = EXPF(wn[cl] - brel), kk = 1.f - EXPF(g[r][cl]);
                    const float qe = q[r][cl] * e1, ke = kk * e2, dm = brel - wm[cl];
                    vq[cl] = qe * cP[cl]; kh[r][cl] = ke * cE[cl]; vkb[cl] = ke;
                    vqq0[cl] = qe * cq0[cl]; vqq1[cl] = qe * cq1[cl]; vqq2[cl] = qe * cq2[cl];
                    vqd[cl] = q[r][cl] * EXPF(dm); vkd[cl] = kk * EXPF(-dm); }
                *(LAS u32x2*)(sQH + t * RS + d0) = pk4(vq[0], vq[1], vq[2], vq[3]);
                if (sb < 3) *(LAS u32x2*)(sKB + t * RS + d0) = pk4(vkb[0], vkb[1], vkb[2], vkb[3]);
                if (sb >= 1) *(LAS u32x2*)(sQQ + ((pbase + 0) * 16 + tk) * RS + d0) = pk4(vqq0[0], vqq0[1], vqq0[2], vqq0[3]);
                if (sb >= 2) *(LAS u32x2*)(sQQ + ((pbase + 1) * 16 + tk) * RS + d0) = pk4(vqq1[0], vqq1[1], vqq1[2], vqq1[3]);
                if (sb >= 3) *(LAS u32x2*)(sQQ + ((pbase + 2) * 16 + tk) * RS + d0) = pk4(vqq2[0], vqq2[1], vqq2[2], vqq2[3]);
                *(LAS u32x2*)(sQD + t * RS + d0) = pk4(vqd[0], vqd[1], vqd[2], vqd[3]);
                *(LAS u32x2*)(sKD + t * RS + d0) = pk4(vkd[0], vkd[1], vkd[2], vkd[3]); }
#pragma unroll
            for (int cl = 0; cl < 4; ++cl) *(LAS u32x2*)(sKH + (d0 + cl) * RS2 + 4 * rg) = pk4(kh[0][cl], kh[1][cl], kh[2][cl], kh[3][cl]);
            *(LAS unsigned*)(sVT + (4 * e4 + 0) * RS2 + 2 * s2) = (v0[0] & 0xffffu) | (v1[0] << 16);
            *(LAS unsigned*)(sVT + (4 * e4 + 1) * RS2 + 2 * s2) = (v0[0] >> 16) | (v1[0] & 0xffff0000u);
            *(LAS unsigned*)(sVT + (4 * e4 + 2) * RS2 + 2 * s2) = (v0[1] & 0xffffu) | (v1[1] << 16);
            *(LAS unsigned*)(sVT + (4 * e4 + 3) * RS2 + 2 * s2) = (v0[1] >> 16) | (v1[1] & 0xffff0000u);
        }
        if (c + 1 < 36) HG_LOAD(c + 1);
        __syncthreads();
        if (need_o && HD != 3) {
            for (int bi = wid; bi < 10; bi += 8) {
                int i, j, p = 0;
                if (bi < 4) { i = bi; j = bi; } else { p = bi - 4; i = p < 1 ? 1 : (p < 3 ? 2 : 3); j = p - i * (i - 1) / 2; }
                const LAS u16* Ab = (i == j ? sQD + (16 * i + l15) * RS : sQQ + (p * 16 + l15) * RS) + 8 * q4;
                const LAS u16* Bb = (i == j ? sKD + (16 * i + l15) * RS : sKB + (16 * j + l15) * RS) + 8 * q4;
                f32x4 acc = {0.f, 0.f, 0.f, 0.f};
#pragma unroll
                for (int ks = 0; ks < 4; ++ks) acc = __builtin_amdgcn_mfma_f32_16x16x32_bf16(*(const LAS bf16x8*)(Ab + ks * 32), *(const LAS bf16x8*)(Bb + ks * 32), acc, 0, 0, 0);
#pragma unroll
                for (int r = 0; r < 4; ++r) { const int t = 4 * q4 + r; float v = acc[r]; if (i == j && l15 > t) v = 0.f; sPP[(16 * i + t) * RS2 + 16 * j + l15] = f2bf(v); }
            }
        }
        if (HD != 3) {
#pragma unroll
            for (int r = 0; r < 16; ++r) S[r] *= sDEC[32 * dt + crow(r, hi)];
#pragma unroll
            for (int ks = 0; ks < 4; ++ks)
                S = __builtin_amdgcn_mfma_f32_32x32x16_bf16(*(const LAS bf16x8*)(sKH + (32 * dt + l32) * RS2 + ks * 16 + 8 * hi), *(const LAS bf16x8*)(sVT + (32 * et + l32) * RS2 + ks * 16 + 8 * hi), S, 0, 0, 0);
        }
        __syncthreads();
        if (need_o && HD != 3) {
            const int tt = wid >> 1;
#pragma unroll
            for (int e2i = 0; e2i < 2; ++e2i) { const int et2 = (wid & 1) * 2 + e2i;
                f32x4 acc = {0.f, 0.f, 0.f, 0.f};
#pragma unroll
                for (int ks = 0; ks < 2; ++ks) acc = __builtin_amdgcn_mfma_f32_16x16x32_bf16(*(const LAS bf16x8*)(sVT + (16 * et2 + l15) * RS2 + ks * 32 + 8 * q4), *(const LAS bf16x8*)(sPP + (16 * tt + l15) * RS2 + ks * 32 + 8 * q4), acc, 0, 0, 0);
#pragma unroll
                for (int ks = 0; ks < 4; ++ks) acc = __builtin_amdgcn_mfma_f32_16x16x32_bf16(*(const LAS bf16x8*)(sST + (16 * et2 + l15) * RS + ks * 32 + 8 * q4), *(const LAS bf16x8*)(sQH + (16 * tt + l15) * RS + ks * 32 + 8 * q4), acc, 0, 0, 0);
                { int pos = 64 * cc + 16 * tt + l15; if (dir) pos = lseg - 1 - pos;
                  *(u32x2*)(OOg + (size_t)(rowbase + pos) * 512 + h * 128 + eh * 64 + 16 * et2 + 4 * q4) = pk4(acc[0], acc[1], acc[2], acc[3]); }
            }
        }
    }
#undef HG_LOAD
    __syncthreads();
}
}

__device__ __forceinline__ void ln_stats(const f32x4 (&x)[4], float& mu, float& rstd) {
    float s = 0.f;
#pragma unroll
    for (int j = 0; j < 4; ++j) s += (x[j][0] + x[j][1]) + (x[j][2] + x[j][3]);
    mu = wsum(s) * (1.f / 1024.f);
    float v = 0.f;
#pragma unroll
    for (int j = 0; j < 4; ++j) { const f32x4 dd = x[j] - mu; v += (dd[0] * dd[0] + dd[1] * dd[1]) + (dd[2] * dd[2] + dd[3] * dd[3]); }
    rstd = rsqrtf(wsum(v) * (1.f / 1024.f) + LN_EPS);
}
template <bool FIRST_LN>
__device__ __forceinline__ void ln_phase(const Frame& F, int r0, const float* src_c, const float* src_l, float* dst_c, float* dst_l,
                                         const float* lng, const float* lnb, bool do_mod, const float* modl, int ch_shift, int ch_scale) {
    u16* H = (u16*)(F.ws + WS_H);
    constexpr int NR = 4;
    for (int row0 = r0 + (F.blk * 8 + F.wave) * NR; row0 < TT; row0 += F.G * 8 * NR) {
        f32x4 x[NR][4];
#pragma unroll
        for (int k = 0; k < NR; ++k) { const int row = row0 + k; const float* sp = row < TC ? src_c + (size_t)row * 1024 : src_l + (size_t)(row - TC) * 1024;
#pragma unroll
            for (int j = 0; j < 4; ++j) x[k][j] = *(const f32x4*)(sp + j * 256 + F.lane * 4); }
        const int mi = row0 < TC ? 16 : ((row0 - TC) >> 11);
        if (FIRST_LN) {
            f32x4 gg[4], bb[4];
#pragma unroll
            for (int j = 0; j < 4; ++j) { gg[j] = *(const f32x4*)(lng + j * 256 + F.lane * 4); bb[j] = *(const f32x4*)(lnb + j * 256 + F.lane * 4); }
#pragma unroll
            for (int k = 0; k < NR; ++k) { const int row = row0 + k; float mu, rstd; ln_stats(x[k], mu, rstd);
                float* dp = row < TC ? dst_c + (size_t)row * 1024 : dst_l + (size_t)(row - TC) * 1024;
#pragma unroll
                for (int j = 0; j < 4; ++j) { x[k][j] = (x[k][j] - mu) * rstd * gg[j] + bb[j]; *(f32x4*)(dp + j * 256 + F.lane * 4) = x[k][j]; } }
        }
        if (do_mod) {
            const float* mp = modl + (size_t)mi * 6144;
            f32x4 sh[4], sc[4];
#pragma unroll
            for (int j = 0; j < 4; ++j) { sh[j] = *(const f32x4*)(mp + ch_shift * 1024 + j * 256 + F.lane * 4); sc[j] = *(const f32x4*)(mp + ch_scale * 1024 + j * 256 + F.lane * 4) + 1.f; }
#pragma unroll
            for (int k = 0; k < NR; ++k) { const int row = row0 + k; float mu, rstd; ln_stats(x[k], mu, rstd);
#pragma unroll
                for (int j = 0; j < 4; ++j) { const f32x4 hv = (x[k][j] - mu) * rstd * sc[j] + sh[j];
                    u32x2 w = {cvtpk(hv[0], hv[1]), cvtpk(hv[2], hv[3])};
                    *(u32x2*)(H + (size_t)row * 1024 + j * 256 + F.lane * 4) = w; } }
        }
    }
}

__device__ __forceinline__ void ln1_phase(const Frame& F, int r0, const float* lng, const float* lnb, const float* modl) {
    const u16* XB = (const u16*)(F.ws + WS_XB); u16* H = (u16*)(F.ws + WS_H);
    constexpr int NR = 4; const int co = F.lane * 16;
    for (int row0 = r0 + (F.blk * 8 + F.wave) * NR; row0 < TT; row0 += F.G * 8 * NR) {
        u32x4 raw[NR][2];
#pragma unroll
        for (int k = 0; k < NR; ++k) { raw[k][0] = *(const u32x4*)(XB + (size_t)(row0 + k) * 1024 + co); raw[k][1] = *(const u32x4*)(XB + (size_t)(row0 + k) * 1024 + co + 8); }
        const int mi = row0 < TC ? 16 : ((row0 - TC) >> 11);
        const float* mp = modl + (size_t)mi * 6144 + co;
        f32x4 gg[4], bb[4], sh[4], sc[4];
#pragma unroll
        for (int j = 0; j < 4; ++j) { gg[j] = *(const f32x4*)(lng + co + 4 * j); bb[j] = *(const f32x4*)(lnb + co + 4 * j); sh[j] = *(const f32x4*)(mp + 3 * 1024 + 4 * j); sc[j] = *(const f32x4*)(mp + 4 * 1024 + 4 * j) + 1.f; }
#pragma unroll
        for (int k = 0; k < NR; ++k) { float f0[8], f1[8]; unpack8(raw[k][0], f0); unpack8(raw[k][1], f1);
            f32x4 x[4] = {{f0[0], f0[1], f0[2], f0[3]}, {f0[4], f0[5], f0[6], f0[7]}, {f1[0], f1[1], f1[2], f1[3]}, {f1[4], f1[5], f1[6], f1[7]}};
            float mu, rstd; ln_stats(x, mu, rstd);
#pragma unroll
            for (int j = 0; j < 4; ++j) x[j] = (x[j] - mu) * rstd * gg[j] + bb[j];
            ln_stats(x, mu, rstd);
            f32x4 hv[4];
#pragma unroll
            for (int j = 0; j < 4; ++j) hv[j] = (x[j] - mu) * rstd * sc[j] + sh[j];
            st8bf(H + (size_t)(row0 + k) * 1024 + co, hv[0], hv[1]); st8bf(H + (size_t)(row0 + k) * 1024 + co + 8, hv[2], hv[3]); }
    }
}

__device__ __forceinline__ void readout_phase(const Frame& F, int l, int r0) {
    const float* lp = GIN(F, 9) + l * 256;
    float s1 = lp[F.lane] * lp[64 + F.lane], s2 = lp[128 + F.lane] * lp[192 + F.lane];
    s1 = wsum(s1); s2 = wsum(s2);
    const float lam_init = 0.8f - 0.6f * expf(-0.3f * (float)l);
    const float lam = expf(s1) - expf(s2) + lam_init;
    const int e0 = (F.lane & 15) * 8, c0 = F.lane * 8;
    float hgv[8], dav[8];
#pragma unroll
    for (int j = 0; j < 8; ++j) { hgv[j] = GIN(F, 8)[l * 128 + e0 + j]; dav[j] = GIN(F, 10)[l * 128 + e0 + j] * (1.f - lam_init); }
    const u16* OF = (const u16*)(F.ws + WS_OF); const u16* OB = (const u16*)(F.ws + WS_OB); const u16* SG = (const u16*)(F.ws + WS_P4);
    const u16* O1 = (const u16*)(F.ws + WS_ON1); const u16* O2 = (const u16*)(F.ws + WS_ON2);
    u16* Aa = (u16*)(F.ws + WS_P0); u16* Bb = (u16*)(F.ws + WS_P5);
    constexpr int NR = 4;
    for (int row0 = r0 + (F.blk * 8 + F.wave) * NR; row0 < TT; row0 += F.G * 8 * NR) {
        u32x4 ra_[NR], rb_[NR], rs_[NR], r1_[NR], r2_[NR];
#pragma unroll
        for (int k = 0; k < NR; ++k) { const size_t off = (size_t)(row0 + k) * 512 + c0;
            ra_[k] = *(const u32x4*)(OF + off); rb_[k] = *(const u32x4*)(OB + off); rs_[k] = *(const u32x4*)(SG + off); r1_[k] = *(const u32x4*)(O1 + off); r2_[k] = *(const u32x4*)(O2 + off); }
#pragma unroll
        for (int k = 0; k < NR; ++k) { const size_t off = (size_t)(row0 + k) * 512 + c0;
            float a[8], b2[8], sg[8], p1[8], p2[8];
            unpack8(ra_[k], a); unpack8(rb_[k], b2); unpack8(rs_[k], sg); unpack8(r1_[k], p1); unpack8(r2_[k], p2);
            float ssa = 0.f, ssb = 0.f;
#pragma unroll
            for (int j = 0; j < 8; ++j) { a[j] += b2[j]; ssa += a[j] * a[j]; p1[j] -= lam * p2[j]; ssb += p1[j] * p1[j]; }
#pragma unroll
            for (int m = 8; m >= 1; m >>= 1) { ssa += __shfl_xor(ssa, m); ssb += __shfl_xor(ssb, m); }
            const float ra = rsqrtf(ssa * (1.f / 128.f) + LN_EPS), rb = rsqrtf(ssb * (1.f / 128.f) + LN_EPS);
            f32x4 v0, v1, w0, w1;
#pragma unroll
            for (int j = 0; j < 4; ++j) { v0[j] = a[j] * ra * hgv[j] * siluf_(sg[j]); v1[j] = a[4 + j] * ra * hgv[4 + j] * siluf_(sg[4 + j]); w0[j] = p1[j] * rb * dav[j]; w1[j] = p1[4 + j] * rb * dav[4 + j]; }
            st8bf(Aa + off, v0, v1); st8bf(Bb + off, w0, w1); }
    }
}

__device__ __forceinline__ void adaln_phase(const Frame& F) {
    if (F.blk >= 192) return;
    LAS float* sT = (LAS float*)F.lds; LAS float* red = (LAS float*)(F.lds + 81920);
    const float* c = GIN(F, 1); const float* cc = GIN(F, 3); const float* wada = GIN(F, 4); const float* bada = GIN(F, 5);
    float* mod = (float*)(F.ws + WS_MOD);
    for (int idx = F.tid; idx < 17 * 1024; idx += 512) { const int j = idx >> 10, k = idx & 1023; const float v = j < 16 ? c[idx] : cc[k]; sT[k * 20 + j] = v / (1.f + __expf(-v)); }
    __syncthreads();
    for (int u = F.blk; u < 192; u += F.G) {
        const int l = u / 96, n0 = (u % 96) * 64;
        float acc[17];
#pragma unroll
        for (int j = 0; j < 17; ++j) acc[j] = 0.f;
        const float* wp = wada + (size_t)l * 1024 * 6144 + n0 + F.lane;
        for (int k = F.wave * 128; k < F.wave * 128 + 128; ++k) {
            const float wv = wp[(size_t)k * 6144];
            const f32x4 a0 = *(const LAS f32x4*)(sT + k * 20), a1 = *(const LAS f32x4*)(sT + k * 20 + 4), a2 = *(const LAS f32x4*)(sT + k * 20 + 8), a3 = *(const LAS f32x4*)(sT + k * 20 + 12);
            const float a4 = sT[k * 20 + 16];
#pragma unroll
            for (int j = 0; j < 4; ++j) { acc[j] += a0[j] * wv; acc[4 + j] += a1[j] * wv; acc[8 + j] += a2[j] * wv; acc[12 + j] += a3[j] * wv; }
            acc[16] += a4 * wv;
        }
#pragma unroll
        for (int j = 0; j < 17; ++j) red[(F.wave * 17 + j) * 64 + F.lane] = acc[j];
        __syncthreads();
        for (int idx = F.tid; idx < 17 * 64; idx += 512) { const int j = idx >> 6, ln = idx & 63; float s = bada[l * 6144 + n0 + ln];
#pragma unroll
            for (int w = 0; w < 8; ++w) s += red[(w * 17 + j) * 64 + ln];
            mod[(size_t)(l * 17 + j) * 6144 + n0 + ln] = s; }
        __syncthreads();
    }
}

__device__ __forceinline__ void fold_phase(const Frame& F) {
    u16* U = (u16*)(F.ws + WS_P8) + (size_t)TC * 512; float* ucm = (float*)(F.ws + WS_UCM);
    for (int it = F.blk * 8 + F.wave; it < NB * 512; it += F.G * 8) {
        const int b = it >> 9, l = (it & 511) + 1;
        u16* r0p = U + ((size_t)b * SEQ + l) * 512 + F.lane * 8; u16* r1p = U + ((size_t)b * SEQ + (SEQ - l)) * 512 + F.lane * 8;
        u16* r2p = U + ((size_t)b * SEQ + (1024 - l)) * 512 + F.lane * 8; u16* r3p = U + ((size_t)b * SEQ + (1024 + l)) * 512 + F.lane * 8;
        float a[8], bq[8], c2[8], d[8];
        unpack8(*(const u32x4*)r0p, a); unpack8(*(const u32x4*)r1p, bq);
        if (l < 512) { unpack8(*(const u32x4*)r2p, c2); unpack8(*(const u32x4*)r3p, d); }
        f32x4 e0, e1, o0, o1;
#pragma unroll
        for (int j = 0; j < 4; ++j) { e0[j] = a[j] + bq[j]; e1[j] = a[4 + j] + bq[4 + j]; o0[j] = a[j] - bq[j]; o1[j] = a[4 + j] - bq[4 + j]; }
        if (l < 512) {
            f32x4 f0, f1, p0, p1;
#pragma unroll
            for (int j = 0; j < 4; ++j) { f0[j] = c2[j] + d[j]; f1[j] = c2[4 + j] + d[4 + j]; p0[j] = c2[j] - d[j]; p1[j] = c2[4 + j] - d[4 + j]; }
            st8bf(r0p, e0, e1); st8bf(r2p, f0, f1); st8bf(r3p, o0, o1); st8bf(r1p, p0, p1);
        } else { st8bf(r0p, e0, e1); st8bf(r1p, o0, o1); }
    }
    for (int i = F.blk * 512 + F.tid; i < 8192; i += F.G * 512) { const int b = i >> 9, g = (i >> 7) & 3, n = i & 127;
        const u16* up = U + ((size_t)b * SEQ + 1024) * 512 + g * 128; float acc = 0.f;
        for (int k = 0; k < 128; ++k) acc += bf2f(up[k]) * cospif((float)((n * k) & 127) * (1.f / 64.f));
        ucm[i] = acc; }
}
__device__ __forceinline__ void tables_phase(const Frame& F) {
    const int gid = F.blk * 512 + F.tid, stride = F.G * 512;
    float* lbt = (float*)(F.ws + WS_LBT); float* rope = (float*)(F.ws + WS_ROPE);
    u16* w2t = (u16*)(F.ws + WS_W2T); u16* w2tl = (u16*)(F.ws + WS_W2TL); u16* dftc = (u16*)(F.ws + WS_DFTC); u16* dft = (u16*)(F.ws + WS_DFT);
    const float* lbl = GIN(F, 7);
    for (int i = gid; i < 2048; i += stride) { const int l = i >> 10, rem = i & 1023; const float a0 = lbl[rem], a1 = lbl[1024 + rem], mx = fmaxf(a0, a1);
        const float e0 = expf(a0 - mx), e1 = expf(a1 - mx); const float lb = l == 0 ? 0.f : e1 / (e0 + e1);
        lbt[i * 2] = fmaxf(lb, 1e-30f); lbt[i * 2 + 1] = 1.f - lb; }
    for (int i = gid; i < 65536; i += stride) { const int t = i >> 5, p = i & 31; const float pos = (float)(p < 16 ? (t >> 6) : (t & 63));
        const float inv = powf(10000.f, -(float)(p & 15) / 16.f); const float ang = pos * inv; rope[i] = cosf(ang); rope[65536 + i] = sinf(ang); }
    for (int i = gid; i < 65536; i += stride) { const int np = i >> 8, k = i & 255; float v = 0.f;
        if (k < 128) { const int idx = ((np & 127) * k) & 127; const float x = (float)idx * (1.f / 64.f); v = np < 128 ? cospif(x) : sinpif(x); }
        w2t[i] = f2bf(v);
        float vl = 0.f; if (np < 128 && k < 128) vl = cospif((float)((np * k) & 127) * (1.f / 64.f)); if (np >= 128 && k >= 128) vl = sinpif((float)(((np - 128) * (k - 128)) & 127) * (1.f / 64.f));
        w2tl[i] = f2bf(vl); }
    for (int i = gid; i < 131072; i += stride) { const int m = i >> 9, ci = i & 511, lq = ci & 255, idx = (m * lq) & 255; const float x = (float)idx * (1.f / 128.f);
        dftc[(size_t)m * 2048 + ci] = f2bf(ci < 256 ? cospif(x) : -sinpif(x)); }
    for (int i = gid; i < 2048 * 2048; i += stride) { const int m = i >> 11, ci = i & 2047, lq = ci & 1023, idx = (m * lq) & 2047; const float x = (float)idx * (1.f / 1024.f);
        dft[i] = f2bf(ci < 1024 ? cospif(x) : -sinpif(x)); }
}

__device__ __forceinline__ int rowmap(int map, int n) {
    if (map == 1) { const int sec = n >> 9; if (sec == 5 || sec == 6) { const int dd = n & 63; n = (n & ~63) + (dd < 32 ? 2 * dd : 2 * (dd - 32) + 1); } return n; }
    if (map == 2) return (n >> 7) * 256 + (n & 127);
    if (map == 3) return (n >> 7) * 256 + 128 + (n & 127);
    return n;
}
__device__ __forceinline__ void cvt_job(const Frame& F, const float* src, const float* src_last, size_t src_stride, int nmat, int K, int N, u16* dst, size_t dst_stride, int ldd, int map) {
    LAS float* tile = (LAS float*)F.lds;
    const int ntn = N / 64, per = (K / 64) * ntn, total = per * nmat;
    const int kk = F.tid >> 3, c8 = (F.tid & 7) * 8;
    constexpr int NTL = 4;
    for (int i4 = F.blk * NTL; i4 < total; i4 += F.G * NTL) {
        f32x4 a[NTL], b[NTL];
#pragma unroll
        for (int q = 0; q < NTL; ++q) { const int idx = i4 + q; if (idx < total) {
            const int e = idx / per, t = idx - e * per, kt = t / ntn, tn = t - kt * ntn;
            const float* sp = (src_last && e == nmat - 1) ? src_last : src + (size_t)e * src_stride;
            a[q] = *(const f32x4*)(sp + (size_t)(kt * 64 + kk) * N + tn * 64 + c8); b[q] = *(const f32x4*)(sp + (size_t)(kt * 64 + kk) * N + tn * 64 + c8 + 4); } }
#pragma unroll
        for (int q = 0; q < NTL; ++q) if (i4 + q < total) {
#pragma unroll
            for (int j = 0; j < 4; ++j) { tile[q * 4160 + kk * 65 + c8 + j] = a[q][j]; tile[q * 4160 + kk * 65 + c8 + 4 + j] = b[q][j]; } }
        __syncthreads();
#pragma unroll
        for (int q = 0; q < NTL; ++q) { const int idx = i4 + q; if (idx < total) {
            const int e = idx / per, t = idx - e * per, kt = t / ntn, tn = t - kt * ntn;
            f32x4 v0, v1;
#pragma unroll
            for (int j = 0; j < 4; ++j) { v0[j] = tile[q * 4160 + (c8 + j) * 65 + kk]; v1[j] = tile[q * 4160 + (c8 + 4 + j) * 65 + kk]; }
            const int drow = rowmap(map, tn * 64 + kk);
            st8bf(dst + (size_t)e * dst_stride + (size_t)drow * ldd + kt * 64 + c8, v0, v1); } }
        __syncthreads();
    }
}
__device__ __forceinline__ void cvt_layer_weights(const Frame& F, int l) {
    u16* wl = (u16*)(F.ws + WS_WL);
    cvt_job(F, GIN(F, 6) + (size_t)l * 1024 * INW, nullptr, 0, 1, 1024, INW, wl + WL_WIN / 2, 0, 1024, 1);
    cvt_job(F, GIN(F, 11) + (size_t)l * 524288, nullptr, 0, 1, 512, 1024, wl + WL_WPA / 2, 0, 512, 0);
    cvt_job(F, GIN(F, 12) + (size_t)l * 524288, nullptr, 0, 1, 512, 1024, wl + WL_WPB / 2, 0, 512, 0);
    cvt_job(F, GIN(F, 13) + (size_t)l * 524288, nullptr, 0, 1, 512, 1024, wl + WL_WPC / 2, 0, 512, 0);
    cvt_job(F, GIN(F, 14) + (size_t)l * 1048576, nullptr, 0, 1, 1024, 1024, wl + WL_WO / 2, 0, 1024, 0);
    cvt_job(F, GIN(F, 19) + (size_t)l * 65536, nullptr, 0, 1, 1024, 64, wl + WL_WR / 2, 0, 1024, 0);
    unsigned* z = (unsigned*)(F.ws + WS_WL + WL_WR + 64 * 2048);
    for (int i = F.blk * 512 + F.tid; i < 192 * 512; i += F.G * 512) z[i] = 0u;
}
__device__ __forceinline__ void cvt_expert_weights(const Frame& F, int l) {
    cvt_job(F, GIN(F, 21) + (size_t)l * 64 * 262144, GIN(F, 24) + (size_t)l * 262144, 262144, NEXP1, 1024, 256, (u16*)(F.ws + WS_WGU), 524288, 1024, 2);
    cvt_job(F, GIN(F, 22) + (size_t)l * 64 * 262144, GIN(F, 25) + (size_t)l * 262144, 262144, NEXP1, 1024, 256, (u16*)(F.ws + WS_WGU), 524288, 1024, 3);
    cvt_job(F, GIN(F, 23) + (size_t)l * 64 * 262144, GIN(F, 26) + (size_t)l * 262144, 262144, NEXP1, 256, 1024, (u16*)(F.ws + WS_WD), 262144, 256, 0);
}

__device__ __forceinline__ void route1_phase(const Frame& F, int l, int r0) {
    LAS int* lcnt = (LAS int*)F.lds;
    unsigned* ctl = (unsigned*)(F.ws + WS_CTL);
    const float* logits = (const float*)(F.ws + WS_LOGIT); int* eidx = (int*)(F.ws + WS_EIDX); float* wgt = (float*)(F.ws + WS_WGT);
    int* rtok = (int*)(F.ws + WS_RTOK); int* blkb = (int*)(F.ws + WS_BLKB);
    const float* bias = GIN(F, 20) + l * 64;
    const int t1 = pass_tile0(l, 1) * 256, t2 = pass_tile0(l, 2) * 256;
    if (F.tid < NPASS * 64) lcnt[F.tid] = 0;
    __syncthreads();
    for (int i = F.blk * 512 + F.tid; i < NPASS * MAXROWS; i += F.G * 512) rtok[i] = -1;
    for (int tl = F.blk; tl * 256 + r0 < TT; tl += F.G) {
        if (F.tid >= 256) break;
        const int tok = r0 + tl * 256 + F.tid;
        const int ps = (tok >= t1) + (tok >= t2);
        float s[64];
#pragma unroll
        for (int j = 0; j < 16; ++j) { const f32x4 v = __builtin_nontemporal_load((const f32x4*)(logits + (size_t)tok * 64 + j * 4));
#pragma unroll
            for (int k = 0; k < 4; ++k) s[4 * j + k] = 1.f / (1.f + expf(-v[k])); }
        float gs[8];
#pragma unroll
        for (int g = 0; g < 8; ++g) { float m1 = -3.0e38f, m2 = -3.0e38f;
#pragma unroll
            for (int j = 0; j < 8; ++j) { const float v = s[8 * g + j] + bias[8 * g + j]; if (v > m1) { m2 = m1; m1 = v; } else if (v > m2) m2 = v; }
            gs[g] = m1 + m2; }
        unsigned gmask = 0u;
#pragma unroll
        for (int it = 0; it < 4; ++it) { float best = -3.0e38f; int bi = 0;
#pragma unroll
            for (int g = 0; g < 8; ++g) { const bool ok = !((gmask >> g) & 1u) && gs[g] > best; best = ok ? gs[g] : best; bi = ok ? g : bi; }
            gmask |= 1u << bi; }
        unsigned long long chosen = 0ull; float tot = 0.f; int eid[8]; float ew[8];
#pragma unroll
        for (int it = 0; it < 8; ++it) { float best = -3.0e38f, bs = 0.f; int bi = 0;
#pragma unroll
            for (int e = 0; e < 64; ++e) { const float v = s[e] + bias[e]; const bool ok = ((gmask >> (e >> 3)) & 1u) && !((chosen >> e) & 1ull) && v > best;
                best = ok ? v : best; bi = ok ? e : bi; bs = ok ? s[e] : bs; }
            chosen |= 1ull << bi; eid[it] = bi; ew[it] = bs; tot += bs; }
        const float rs = 2.5f / tot;
#pragma unroll
        for (int it = 0; it < 8; ++it) { eidx[(size_t)tok * 8 + it] = eid[it]; wgt[(size_t)tok * 8 + it] = ew[it] * rs; __hip_atomic_fetch_add(&lcnt[ps * 64 + eid[it]], 1, __ATOMIC_RELAXED, __HIP_MEMORY_SCOPE_WORKGROUP); }
    }
    __syncthreads();
    if (F.tid < NPASS * 64) { const int cnt = lcnt[F.tid]; int base = 0; if (cnt) base = (int)atomicAdd(&ctl[CW_GCNT + l * NPASS * 64 + F.tid], (unsigned)cnt); blkb[F.blk * (NPASS * 64) + F.tid] = base; }
}
__device__ __forceinline__ void route2_phase(const Frame& F, int l, int r0) {
    LAS int* lcnt = (LAS int*)F.lds; LAS int* base = lcnt + NPASS * 64;
    unsigned* ctl = (unsigned*)(F.ws + WS_CTL);
    const int* eidx = (const int*)(F.ws + WS_EIDX); int* srow = (int*)(F.ws + WS_SROW);
    int* rtok = (int*)(F.ws + WS_RTOK); const int* blkb = (const int*)(F.ws + WS_BLKB); int* tile_e = (int*)(F.ws + WS_TILEE);
    const int t1 = pass_tile0(l, 1) * 256, t2 = pass_tile0(l, 2) * 256;
    if (F.tid < NPASS * 64) lcnt[F.tid] = 0;
    if (F.tid < NPASS) { const int ps = F.tid; int acc = 0;
        for (int e = 0; e < 64; ++e) { const int cnt = (int)__hip_atomic_load(&ctl[CW_GCNT + (l * NPASS + ps) * 64 + e], __ATOMIC_RELAXED, __HIP_MEMORY_SCOPE_AGENT); base[ps * 66 + e] = acc; acc += (cnt + 255) & ~255; }
        base[ps * 66 + 64] = acc; acc += (pass_tile0(l, ps + 1) - pass_tile0(l, ps)) * 256; base[ps * 66 + 65] = acc; }
    __syncthreads();
    if (F.blk < NPASS) { const int ps = F.blk; const int ntl = base[ps * 66 + 65] >> 8;
        for (int ti = F.tid; ti < ntl; ti += 512) { int e = 0; for (int k = 1; k <= 64; ++k) if (ti * 256 >= base[ps * 66 + k]) e = k; tile_e[ps * 1024 + ti] = e; }
        if (F.tid == 0) __hip_atomic_store(&ctl[CW_NTILES + l * NPASS + ps], (unsigned)ntl, __ATOMIC_RELAXED, __HIP_MEMORY_SCOPE_AGENT);
    }
    for (int tl = F.blk; tl * 256 + r0 < TT; tl += F.G) {
        if (F.tid >= 256) break;
        const int tok = r0 + tl * 256 + F.tid;
        const int ps = (tok >= t1) + (tok >= t2);
        int* rt = rtok + (size_t)ps * MAXROWS;
#pragma unroll
        for (int j = 0; j < 8; ++j) { const int e = eidx[(size_t)tok * 8 + j]; const int rank = __hip_atomic_fetch_add(&lcnt[ps * 64 + e], 1, __ATOMIC_RELAXED, __HIP_MEMORY_SCOPE_WORKGROUP);
            const int row = base[ps * 66 + e] + blkb[F.blk * (NPASS * 64) + ps * 64 + e] + rank;
            rt[row] = tok; srow[(size_t)tok * 9 + j] = row; }
        const int row = base[ps * 66 + 64] + (tok - pass_tile0(l, ps) * 256); rt[row] = tok; srow[(size_t)tok * 9 + 8] = row;
    }
    __syncthreads();
}
__device__ __forceinline__ void comb_ln2_phase(const Frame& F, int tok0, int tok1, float* dst_c, float* dst_l, const float* modl, const float* lng1, const float* lnb1, const float* lng, const float* lnb, bool do_mod, const float* modn) {
    const int* srow = (const int*)(F.ws + WS_SROW); const float* wgt = (const float*)(F.ws + WS_WGT); const unsigned char* so = F.ws + WS_SO;
    u16* H = (u16*)(F.ws + WS_H);
    const int co = F.lane * 16;
    for (int tok = tok0 + F.blk * 8 + F.wave; tok < tok1; tok += F.G * 8) {
        const int myrow = F.lane < 9 ? srow[(size_t)tok * 9 + F.lane] : 0; const float myw = (F.lane < 8 ? wgt[(size_t)tok * 8 + F.lane] : 1.f) * (1.f / 16.f);
        u32x4 sv[9];
#pragma unroll
        for (int j = 0; j < 9; ++j) { const int row = __shfl(myrow, j); sv[j] = *(const u32x4*)(so + (size_t)row * 1024 + co); }
        const int mi = tok < TC ? 16 : ((tok - TC) >> 11);
        float* xp = (tok < TC ? dst_c + (size_t)tok * 1024 : dst_l + (size_t)(tok - TC) * 1024) + co;
        f32x4 x[4];
        { const u16* xb = (const u16*)(F.ws + WS_XB) + (size_t)tok * 1024 + co; float f0[8], f1[8]; unpack8(*(const u32x4*)xb, f0); unpack8(*(const u32x4*)(xb + 8), f1);
          x[0] = (f32x4){f0[0], f0[1], f0[2], f0[3]}; x[1] = (f32x4){f0[4], f0[5], f0[6], f0[7]}; x[2] = (f32x4){f1[0], f1[1], f1[2], f1[3]}; x[3] = (f32x4){f1[4], f1[5], f1[6], f1[7]};
          float mu1, rs1; ln_stats(x, mu1, rs1);
#pragma unroll
          for (int k = 0; k < 4; ++k) x[k] = (x[k] - mu1) * rs1 * *(const f32x4*)(lng1 + co + 4 * k) + *(const f32x4*)(lnb1 + co + 4 * k); }
        f32x4 y[4];
#pragma unroll
        for (int k = 0; k < 4; ++k) y[k] = (f32x4){0.f, 0.f, 0.f, 0.f};
#pragma unroll
        for (int j = 0; j < 9; ++j) { const float w = __shfl(myw, j);
#pragma unroll
            for (int k = 0; k < 4; ++k) { const f32x2_ lo = __builtin_amdgcn_cvt_pk_f32_fp8((int)sv[j][k], false), hi = __builtin_amdgcn_cvt_pk_f32_fp8((int)sv[j][k], true);
                y[k][0] += w * lo[0]; y[k][1] += w * lo[1]; y[k][2] += w * hi[0]; y[k][3] += w * hi[1]; } }
#pragma unroll
        for (int k = 0; k < 4; ++k) { const f32x4 g2 = *(const f32x4*)(modl + (size_t)mi * 6144 + 5 * 1024 + co + 4 * k); x[k] = x[k] * ALPHA + g2 * y[k]; }
        float mu, rstd;
        ln_stats(x, mu, rstd);
#pragma unroll
        for (int k = 0; k < 4; ++k) { const f32x4 gg = *(const f32x4*)(lng + co + 4 * k), bb = *(const f32x4*)(lnb + co + 4 * k);
            x[k] = (x[k] - mu) * rstd * gg + bb; *(f32x4*)(xp + 4 * k) = x[k]; }
        if (do_mod) {
            ln_stats(x, mu, rstd);
            const float* mp = modn + (size_t)mi * 6144 + co;
            f32x4 hv[4];
#pragma unroll
            for (int k = 0; k < 4; ++k) { const f32x4 sh = *(const f32x4*)(mp + 4 * k), sc = *(const f32x4*)(mp + 1024 + 4 * k); hv[k] = (x[k] - mu) * rstd * (sc + 1.f) + sh; }
            st8bf(H + (size_t)tok * 1024 + co, hv[0], hv[1]); st8bf(H + (size_t)tok * 1024 + co + 8, hv[2], hv[3]);
        }
    }
}
__device__ __forceinline__ int opaque_int(int v) { asm volatile("" : "+s"(v)); return v; }
__device__ __forceinline__ const void* launder_ptr(const void* p) {
    unsigned lo = (unsigned)(uintptr_t)p, hi = (unsigned)((uintptr_t)p >> 32);
    asm volatile("" : "+v"(lo), "+v"(hi));
    lo = __builtin_amdgcn_readfirstlane(lo); hi = __builtin_amdgcn_readfirstlane(hi);
    return (const void*)(((uintptr_t)hi << 32) | (uintptr_t)lo);
}
constexpr int NPL = 16;
constexpr int NINT = 2 + (10 + 2 * npass_of(0)) + (10 + 2 * npass_of(1));
__global__ void __launch_bounds__(512, 2) mk_fwd(Args args) {
    extern __shared__ __attribute__((aligned(16))) unsigned char lds_raw[];
    Frame F0;
    F0.in = nullptr; F0.out = args.out; F0.ws = args.ws; F0.lds = (LAS unsigned char*)lds_raw;
    F0.tid = threadIdx.x; F0.lane = F0.tid & 63; F0.wave = __builtin_amdgcn_readfirstlane(F0.tid >> 6); F0.G = gridDim.x; F0.blk = blockIdx.x;
    const int lo = args.ph_lo, hi = args.ph_hi;
    unsigned* ctl = (unsigned*)(args.ws + WS_CTL);
    volatile LAS unsigned* misc = (volatile LAS unsigned*)(F0.lds + LDS_MISC);
    if (F0.tid < 16) misc[F0.tid] = 0u;
    __syncthreads();
    XcdBarrier bar; bar.bar = ctl + CW_BAR; bar.x = 0; bar.st = misc;
    if (hi - lo > 1) bar = xcd_barrier_post(ctl + CW_BAR, misc);
#define IN(k) (lo <= (k) && (k) < hi)
#ifndef DBL_BAR
#define DBL_BAR 0
#endif
#define SEAM(k) do { if (IN(k) && IN((k) + 1)) { xcd_barrier(bar); if (DBL_BAR) xcd_barrier(bar); } } while (0)
    const float* const* in0 = (const float* const*)__builtin_amdgcn_kernarg_segment_ptr(); float* out0 = args.out; unsigned char* ws0 = args.ws;
#define PH_BEGIN Frame F = F0; { const unsigned _z = (unsigned)opaque_int(0); F.in = in0 + _z; F.out = out0 + _z; F.ws = ws0 + _z; } F.G = opaque_int(F0.G); F.blk = opaque_int(F0.blk); F.vcu = (F.G % 8 == 0) ? (F.blk % 8) * (F.G / 8) + F.blk / 8 : F.blk; { int _t = F0.tid; asm volatile("" : "+v"(_t)); F.tid = _t; F.lane = _t & 63; F.wave = __builtin_amdgcn_readfirstlane(_t >> 6); } \
    unsigned char* ws = F.ws; float* xc = (float*)(ws + WS_XC); const float* modall = (const float*)(ws + WS_MOD); (void)xc; (void)modall;
#define PH_BEGIN_L PH_BEGIN const int l = opaque_int(lyr); const int r0 = l == 0 ? 0 : TC, rt0 = r0 / 256, nM = (TT - r0) / 256; (void)rt0; (void)nM;

    if (EN(0) && IN(0)) for (int rp = 0; rp < NREP(0); ++rp) { PH_BEGIN adaln_phase(F); __syncthreads(); tables_phase(F); cvt_layer_weights(F, 0); }
    SEAM(0);
    if (EN(1) && IN(1)) for (int rp = 0; rp < NREP(1); ++rp) { PH_BEGIN ln_phase<false>(F, 0, GIN(F, 2), GIN(F, 0), nullptr, nullptr, nullptr, nullptr, true, modall, 0, 1); }
    SEAM(1);

    for (int lyr = 0; lyr < DEPTH; ++lyr) {
        const int NP = npass_of(lyr), base = 2 + (lyr == 0 ? 0 : 10 + 2 * npass_of(0));
        if (hi <= base || lo >= base + 10 + 2 * NP) continue;

        if (EN(2) && IN(base + 0)) for (int rp = 0; rp < NREP(2); ++rp) {
            PH_BEGIN_L
            PIn p; p.A = (const char*)(ws + WS_H); p.B = (const char*)(ws + WS_WL + WL_WIN); p.nt = opaque_int(16); p.G = F.G; p.c = F.blk; p.nM = l == 0 ? TT / 256 : TL / 256; p.nN = 18; p.rt0 = l == 0 ? 0 : TC / 256; p.pn0 = 0; p.nctx = l == 0 ? 0 : 16 * 12;
            p.ws = ws; p.lbt = (const float*)(ws + WS_LBT) + (size_t)l * 2048; p.rope = (const float*)(ws + WS_ROPE);
            pg8::gemm_phase(F.lds, p);
        }
        SEAM(base + 0);
        if (IN(base + 1)) {
            if (EN(5)) { PH_BEGIN_L fold_phase(F); }
            if (EN(3)) for (int rp = 0; rp < NREP(3); ++rp) { PH_BEGIN_L for (int u = F.blk; u < 256; u += F.G) { if (rp == 0) hg::hgrn_unit<0>(ws, F.lds, l, u >> 4, (u >> 2) & 3, (u >> 1) & 1, u & 1); else hg::hgrn_unit<HG_DRY>(ws, F.lds, l, u >> 4, (u >> 2) & 3, (u >> 1) & 1, u & 1); } }
            if (EN(4)) for (int rp = 0; rp < NREP(4); ++rp) {
                PH_BEGIN_L
                const int nlat = NB * 4 * 8 * 2, nctx = l == 0 ? NB * 4 * 2 : 0;
                for (int u = F.vcu; u < nlat + nctx; u += F.G) {
                    int map, b, h, qrow0, NT;
                    if (u < nlat) { map = u & 1; const int qb = (u >> 1) & 7; h = (u >> 4) & 3; b = u >> 6; qrow0 = TC + b * SEQ + qb * 256; NT = 36; }
                    else { const int v = u - nlat; map = v & 1; h = (v >> 1) & 3; b = v >> 3; qrow0 = b * LC; NT = 4; }
                    if (rp == 0) att::attn_unit_dma<0>((const u16*)(ws + WS_P5), (const u16*)(ws + WS_P6), (const u16*)(ws + WS_P7), (u16*)(ws + (map ? WS_ON2 : WS_ON1)), qrow0, b, h, map, NT, (LAS char*)F.lds);
                    else att::attn_unit_dma<AT_DRY>((const u16*)(ws + WS_P5), (const u16*)(ws + WS_P6), (const u16*)(ws + WS_P7), (u16*)(ws + WS_TT), qrow0, b, h, map, NT, (LAS char*)F.lds);
                }
            }
        }
        SEAM(base + 1);
        if (IN(base + 2)) {
            if (EN(5)) for (int rp = 0; rp < NREP(5); ++rp) {
                PH_BEGIN_L
                PF1 p; p.nt = opaque_int(4); p.Alat = (const char*)(ws + WS_W2TL); p.Actx = (const char*)(ws + WS_W2T); p.B = (const char*)(ws + WS_P8); p.G = F.G; p.c = F.blk; p.nunits = l == 0 ? 320 : 256;
                p.Olat = (u16*)(ws + WS_TT); p.Octx = (u16*)F.out;
                pg8::gemm_phase(F.lds, p);
            }
            if (EN(6)) for (int rp = 0; rp < NREP(19); ++rp) { PH_BEGIN_L readout_phase(F, l, r0); }
        }
        SEAM(base + 2);
        if (IN(base + 3)) {
            if (EN(6)) for (int rp = 0; rp < NREP(6); ++rp) {
                PH_BEGIN_L
                PF2 p; p.ucm = (const float*)(ws + WS_UCM); p.nt_lat = opaque_int(32); p.nt_ctx = opaque_int(8); p.Alat = (const char*)(ws + WS_DFT); p.Blat = (const char*)(ws + WS_TT); p.Actx = (const char*)(ws + WS_DFTC); p.Bctx = (const char*)F.out; p.G = F.G; p.c = F.blk;
                p.nunits = l == 0 ? 288 : 256; p.O = (u16*)(ws + WS_P3);
                pg8::gemm_phase(F.lds, p);
            }
            if (EN(7)) for (int rp = 0; rp < NREP(7); ++rp) {
                PH_BEGIN_L
                PIn p; p.A = (const char*)(ws + WS_H); p.B = (const char*)(ws + WS_WL + WL_WIN); p.nt = opaque_int(16); p.G = F.G; p.c = F.blk; p.nM = nM; p.nN = 12; p.rt0 = rt0; p.pn0 = 18; p.nctx = 0; p.dry = rp ? DRY_MODE : 0;
                p.ws = ws; p.lbt = nullptr; p.rope = nullptr;
                pg8::gemm_phase(F.lds, p);
            }
        }
        SEAM(base + 3);
        if (EN(8) && IN(base + 4)) for (int rp = 0; rp < NREP(8); ++rp) { PH_BEGIN_L PMerge p; p.dry = rp ? DRY_MODE : 0; p.ws = ws; p.nt = opaque_int(24); p.G = F.G; p.c = F.blk; p.nM = nM; p.rt0 = rt0; pg8::gemm_phase(F.lds, p); }
        SEAM(base + 4);
        if (EN(9) && IN(base + 5)) for (int rp = 0; rp < NREP(9); ++rp) {
            PH_BEGIN_L
            POut p; p.A = (const char*)(ws + WS_H); p.B = (const char*)(ws + WS_WL + WL_WO); p.nt = opaque_int(16); p.G = F.G; p.c = F.blk; p.nM = nM; p.rt0 = rt0;
            p.src_c = l == 0 ? GIN(F, 2) : xc; p.src_l = l == 0 ? GIN(F, 0) : F.out; p.xb = (u16*)(ws + WS_XB); p.mod = modall + (size_t)l * 17 * 6144;
            pg8::gemm_phase(F.lds, p);
        }
        SEAM(base + 5);
        if (EN(10) && IN(base + 6)) {
            for (int rp = 0; rp < NREP(10); ++rp) { PH_BEGIN_L ln1_phase(F, r0, GIN(F, 15) + l * 1024, GIN(F, 16) + l * 1024, modall + (size_t)l * 17 * 6144); }
            for (int rp = 0; rp < NREP(18); ++rp) { PH_BEGIN_L cvt_expert_weights(F, l); }
        }
        SEAM(base + 6);
        if (IN(base + 7)) {
            if (EN(11)) for (int rp = 0; rp < NREP(11); ++rp) {
                PH_BEGIN_L
                PRouter p; p.A = (const char*)(ws + WS_H); p.B = (const char*)(ws + WS_WL + WL_WR); p.nt = opaque_int(16); p.G = F.G; p.c = F.blk; p.nM = nM; p.rt0 = rt0; p.logits = (float*)(ws + WS_LOGIT);
                pg8::gemm_phase(F.lds, p);
            }
            asm volatile("s_waitcnt vmcnt(0)" ::: "memory"); __syncthreads();
            if (EN(12)) { { PH_BEGIN_L route1_phase(F, l, r0); } if (lyr + 1 < DEPTH) { PH_BEGIN_L __syncthreads(); cvt_layer_weights(F, l + 1); } }
        }
        SEAM(base + 7);
        if (EN(13) && IN(base + 8)) { PH_BEGIN_L route2_phase(F, l, r0); }
        SEAM(base + 8);
        for (int ps = 0; ps < NP; ++ps) {
            if (EN(14) && IN(base + 9 + 2 * ps)) for (int rp = 0; rp < NREP(14); ++rp) {
                PH_BEGIN_L
                PUpGate p; p.A = (const char*)(ws + WS_H); p.B = (const char*)(ws + WS_WGU); p.nt = opaque_int(16); p.G = F.G; p.c = F.vcu;
                p.ntiles = (int)__builtin_amdgcn_readfirstlane(__hip_atomic_load((unsigned*)(ws + WS_CTL) + CW_NTILES + l * NPASS + ps, __ATOMIC_RELAXED, __HIP_MEMORY_SCOPE_AGENT));
                p.hb = (u16*)(ws + WS_HB);
                {
                    LAS int* lte = (LAS int*)(F.lds + 131072); LAS int* lrt = (LAS int*)(F.lds + 131072 + 8192);
                    const int* te = (const int*)(ws + WS_TILEE) + ps * 1024; const int* rt = (const int*)(ws + WS_RTOK) + (size_t)ps * MAXROWS;
                    for (int i = F.tid; i < p.ntiles; i += 512) lte[i] = te[i];
                    for (int i = 0; i < 11; ++i) { const long L = (long)i * F.G + F.vcu; if (L >= 2L * p.ntiles) break; if (F.tid < 256) lrt[i * 256 + F.tid] = rt[(size_t)(L >> 1) * 256 + F.tid]; }
                    __syncthreads();
                    p.lte = lte; p.lrt = lrt;
                }
                pg8::gemm_phase(F.lds, p);
            }
            if (EN(16) && ps > 0 && IN(base + 9 + 2 * ps)) for (int rp = 0; rp < NREP(16); ++rp) {
                PH_BEGIN_L
                const bool more = l + 1 < DEPTH;
                comb_ln2_phase(F, pass_tile0(l, ps - 1) * 256, pass_tile0(l, ps) * 256, xc, F.out, modall + (size_t)l * 17 * 6144, GIN(F, 15) + l * 1024, GIN(F, 16) + l * 1024, GIN(F, 17) + l * 1024, GIN(F, 18) + l * 1024, more, modall + (size_t)(more ? l + 1 : l) * 17 * 6144);
            }
            SEAM(base + 9 + 2 * ps);
            if (EN(15) && IN(base + 10 + 2 * ps)) for (int rp = 0; rp < NREP(15); ++rp) {
                PH_BEGIN_L
                PDown p; p.A = (const char*)(ws + WS_HB); p.B = (const char*)(ws + WS_WD); p.nt = opaque_int(4); p.G = F.G; p.c = F.vcu;
                p.ntiles = (int)__builtin_amdgcn_readfirstlane(__hip_atomic_load((unsigned*)(ws + WS_CTL) + CW_NTILES + l * NPASS + ps, __ATOMIC_RELAXED, __HIP_MEMORY_SCOPE_AGENT));
                p.so = ws + WS_SO;
                { LAS int* lte = (LAS int*)(F.lds + 131072); const int* te = (const int*)(ws + WS_TILEE) + ps * 1024; for (int i = F.tid; i < p.ntiles; i += 512) lte[i] = te[i]; __syncthreads(); p.lte = lte; }
                pg8::gemm_phase(F.lds, p);
            }
            SEAM(base + 10 + 2 * ps);
        }
        if (EN(16) && IN(base + 9 + 2 * NP)) for (int rp = 0; rp < NREP(16); ++rp) {
            PH_BEGIN_L
            const bool more = l + 1 < DEPTH;
            comb_ln2_phase(F, pass_tile0(l, NP - 1) * 256, pass_tile0(l, NP) * 256, xc, F.out, modall + (size_t)l * 17 * 6144, GIN(F, 15) + l * 1024, GIN(F, 16) + l * 1024, GIN(F, 17) + l * 1024, GIN(F, 18) + l * 1024, more, modall + (size_t)(more ? l + 1 : l) * 17 * 6144);
        }
        SEAM(base + 9 + 2 * NP);
    }
}


#ifndef DBG_STOP
#define DBG_STOP -1
#endif
struct DbgRegs { unsigned long long off[8]; unsigned long long len[8]; int n; int keep_out; };
__global__ void dbg_dump(unsigned char* ws, float* out, DbgRegs r) {
    const size_t OUT_N = (size_t)TL * DM;
    for (size_t i = (size_t)blockIdx.x * blockDim.x + threadIdx.x; i < OUT_N; i += (size_t)gridDim.x * blockDim.x) {
        unsigned h = 0;
        for (int k = 0; k < r.n; ++k) { const unsigned* p = (const unsigned*)(ws + r.off[k]); const size_t words = r.len[k] / 4;
            for (size_t w = i; w < words; w += OUT_N) { const unsigned v = p[w]; h = h * 31u + (v ^ (v >> 15)); } }
        const float b = r.keep_out ? out[i] : 0.f;
        out[i] = b + (float)(h & 0xffffu) * (1.f / 65536.f);
    }
}
extern "C" void kernel_launch(void* const* d_in, const int* in_sizes, int n_in, void* d_out, int out_size, void* d_ws, size_t ws_size, hipStream_t stream) {
    static int grid = 0;
    if (grid == 0) {
        if (n_in != 27 || out_size != TL * DM || ws_size < WS_END) { fprintf(stderr, "kernel_launch: unexpected shapes (n_in %d, out %d, ws %zu < %zu)\n", n_in, out_size, ws_size, (size_t)WS_END); grid = -1; return; }
        int dev = 0, cus = 0, per_cu = 0;
        if (hipGetDevice(&dev) != hipSuccess || hipDeviceGetAttribute(&cus, hipDeviceAttributeMultiprocessorCount, dev) != hipSuccess) { grid = -1; return; }
        if (hipFuncSetAttribute((const void*)mk_fwd, hipFuncAttributeMaxDynamicSharedMemorySize, LDS_BYTES) != hipSuccess) { fprintf(stderr, "kernel_launch: hipFuncSetAttribute failed\n"); grid = -1; return; }
        if (hipOccupancyMaxActiveBlocksPerMultiprocessor(&per_cu, (const void*)mk_fwd, 512, LDS_BYTES) != hipSuccess || per_cu < 1) { fprintf(stderr, "kernel_launch: occupancy query says %d\n", per_cu); }
        (void)hipGetLastError();
        grid = cus;
    }
    if (grid < 0) return;
    (void)hipMemsetAsync((char*)d_ws + WS_CTL, 0, 65536, stream);
    Args a{};
    for (int i = 0; i < 27; ++i) a.in[i] = (const float*)d_in[i];
    a.out = (float*)d_out; a.ws = (unsigned char*)d_ws;
#if DBG_STOP >= 0
    for (int k = 0; k <= DBG_STOP; ++k) { a.ph_lo = k; a.ph_hi = k + 1; hipLaunchKernelGGL(mk_fwd, dim3(grid), dim3(512), LDS_BYTES, stream, a); }
    { DbgRegs r{}; DBG_REGS; hipLaunchKernelGGL(dbg_dump, dim3(2048), dim3(256), 0, stream, (unsigned char*)d_ws, (float*)d_out, r); }
#elif MK_ONE_LAUNCH
    a.ph_lo = 0; a.ph_hi = NINT;
    hipLaunchKernelGGL(mk_fwd, dim3(grid), dim3(512), LDS_BYTES, stream, a);
#else
    for (int k = 0; k < NINT; ++k) { a.ph_lo = k; a.ph_hi = k + 1; hipLaunchKernelGGL(mk_fwd, dim3(grid), dim3(512), LDS_BYTES, stream, a); }
#endif
}
```

```cpp
#include <hip/hip_runtime.h>
#include <cstdio>
#include <cstdint>

#define LAS __attribute__((address_space(3)))
typedef unsigned short u16;
typedef short bf16x8 __attribute__((ext_vector_type(8)));
typedef short s16x4 __attribute__((ext_vector_type(4)));
typedef float f32x4 __attribute__((ext_vector_type(4)));
typedef float f32x16 __attribute__((ext_vector_type(16)));
typedef unsigned u32x4 __attribute__((ext_vector_type(4)));
typedef unsigned u32x2 __attribute__((ext_vector_type(2)));

#ifndef MK_ONE_LAUNCH
#define MK_ONE_LAUNCH 1
#endif
#ifndef PH_MASK
#define PH_MASK 0xFFFFFFFFu
#endif
constexpr bool EN(int k) { return ((PH_MASK) >> k) & 1u; }
#ifndef NT_GATES
#define NT_GATES 0
#endif
#if NT_GATES == 2
#define ST8G st8bf_wt
#elif NT_GATES
#define ST8G st8bf_nt
#else
#define ST8G st8bf
#endif
#ifndef DRY_MODE
#define DRY_MODE 0
#endif
#ifndef AT_DRY
#define AT_DRY 0
#endif
#ifndef HG_DRY
#define HG_DRY 0
#endif
#ifndef REP_MASK
#define REP_MASK 0u
#endif
constexpr int NREP(int k) { return (((REP_MASK) >> k) & 1u) ? 2 : 1; }

constexpr int DM = 1024, NB = 16, SEQ = 2048, DEPTH = 2, LC = 256;
constexpr int TC = NB * LC;
constexpr int TL = NB * SEQ;
constexpr int TT = TC + TL;
constexpr int INW = 7680;
constexpr int NEXP = 64, NEXP1 = 65;
constexpr int NSLOT = 9;
constexpr int NPASS = 3;
__host__ __device__ constexpr int npass_of(int l) { return l == 0 ? 3 : 2; }
constexpr int MAXTILES = 641;
constexpr int MAXROWS = MAXTILES * 256;
constexpr float LN_EPS = 1e-5f;
constexpr float ALPHA = 1.4142135623730951f;

constexpr size_t MiB = 1048576;
constexpr size_t WS_CTL = 0;
constexpr size_t WS_MOD = 65536;
constexpr size_t WS_LBT = WS_MOD + 1 * MiB;
constexpr size_t WS_ROPE = WS_LBT + 16384;
constexpr size_t WS_W2T = WS_ROPE + 524288;
constexpr size_t WS_W2TL = WS_W2T + 131072;
constexpr size_t WS_DFTC = WS_W2TL + 131072;
constexpr size_t WS_DFT = WS_DFTC + 1 * MiB;
constexpr size_t WS_XC = WS_DFT + 8 * MiB;
constexpr size_t WS_UCM = WS_MOD + 851968;
constexpr size_t WS_WL = WS_XC + 16 * MiB;
constexpr size_t WL_WIN = 0;
constexpr size_t WL_WPA = WL_WIN + (size_t)INW * DM * 2;
constexpr size_t WL_WPB = WL_WPA + 1 * MiB;
constexpr size_t WL_WPC = WL_WPB + 1 * MiB;
constexpr size_t WL_WO = WL_WPC + 1 * MiB;
constexpr size_t WL_WR = WL_WO + 2 * MiB;
constexpr size_t WL_SIZE = WL_WR + 524288;
constexpr size_t WS_DYN = (WS_WL + WL_SIZE + 255) / 256 * 256;
constexpr size_t PU = 36 * MiB;
constexpr size_t WS_H = WS_DYN;
constexpr size_t WS_P0 = WS_H + 72 * MiB;
constexpr size_t WS_P1 = WS_P0 + PU;
constexpr size_t WS_P2 = WS_P1 + PU;
constexpr size_t WS_P3 = WS_P2 + PU;
constexpr size_t WS_P4 = WS_P3 + PU;
constexpr size_t WS_P5 = WS_P4 + PU;
constexpr size_t WS_P6 = WS_P5 + PU;
constexpr size_t WS_P7 = WS_P6 + PU;
constexpr size_t WS_P8 = WS_P7 + PU;
constexpr size_t WS_OF = WS_P8 + PU;
constexpr size_t WS_OB = WS_OF + PU;
constexpr size_t WS_ON1 = WS_OB + PU;
constexpr size_t WS_ON2 = WS_ON1 + PU;
constexpr size_t WS_TT = WS_ON2 + PU;
constexpr size_t WS_END = WS_TT + 64 * MiB;
constexpr size_t WS_XB = WS_ON1;
constexpr size_t WS_GATES = WS_P6;
constexpr size_t WS_WGU = WS_P0;
constexpr size_t WS_WD = WS_WGU + (size_t)NEXP1 * 512 * 1024 * 2;
constexpr size_t WS_HB = WS_P3;
constexpr size_t WS_SO = WS_P3 + 84 * MiB;
constexpr size_t WS_LOGIT = WS_TT;
constexpr size_t WS_EIDX = WS_LOGIT + (size_t)TT * 64 * 4;
constexpr size_t WS_WGT = WS_EIDX + (size_t)TT * 8 * 4;
constexpr size_t WS_SROW = WS_WGT + (size_t)TT * 8 * 4;
constexpr size_t WS_RTOK = WS_SROW + (size_t)TT * 9 * 4;
constexpr size_t WS_TILEE = WS_RTOK + (size_t)NPASS * MAXROWS * 4;
constexpr size_t WS_BLKB = WS_TILEE + 16384;
static_assert(WS_WD + (size_t)NEXP1 * 1024 * 256 * 2 <= WS_P3, "expert weights vs hb");
static_assert(WS_HB + (size_t)MAXROWS * 512 <= WS_SO, "hb vs slotout");
static_assert(WS_BLKB + 1024 * 192 * 4 <= WS_END, "tables");
static_assert(WS_SO + (size_t)MAXROWS * 1024 <= WS_XB, "fp8 slot buffer vs the bf16 pre-norm residual (ON1+ON2)");
static_assert(WS_END <= 694845952ull, "workspace budget");
constexpr int CW_BAR = 0;
constexpr int CW_GCNT = 4096;
constexpr int CW_NTILES = 4096 + 512;
__host__ __device__ constexpr int pass_tile0(int l, int p) { return l == 0 ? 48 * p : (p == 0 ? 16 : (p == 1 ? 80 : 144)); }
__device__ __forceinline__ float bf2f(unsigned b) { return __uint_as_float(b << 16); }
typedef float f32x2_ __attribute__((ext_vector_type(2)));
typedef __bf16 bf16x2_ __attribute__((ext_vector_type(2)));
__device__ __forceinline__ unsigned cvtpk(float lo, float hi) { const f32x2_ v = {lo, hi}; const bf16x2_ b = __builtin_convertvector(v, bf16x2_); return __builtin_bit_cast(unsigned, b); }
__device__ __forceinline__ u16 f2bf(float f) { return (u16)(cvtpk(f, 0.f) & 0xffffu); }
__device__ __forceinline__ float wsum(float v) {
#pragma unroll
    for (int m = 32; m >= 1; m >>= 1) v += __shfl_xor(v, m);
    return v;
}
__device__ __forceinline__ float exp2_poly(float x) {
    const float f = __builtin_amdgcn_fractf(x), n = x - f;
    const float m = fmaf(f, fmaf(f, 0.3371894f, 0.657636f), 1.00172476f);
    return __builtin_amdgcn_ldexpf(m, (int)n);
}
__device__ __forceinline__ float sigmoidf_(float x) { return __builtin_amdgcn_rcpf(1.f + __expf(-x)); }
__device__ __forceinline__ float siluf_(float x) { return x * __builtin_amdgcn_rcpf(1.f + __expf(-x)); }
__device__ __forceinline__ int crow(int r, int hi) { return (r & 3) + 8 * (r >> 2) + 4 * hi; }

#define GLD(T, p) (*(const __attribute__((address_space(1))) T*)(p))
template <class T> __device__ __forceinline__ T* as_global(T* p) { return (T*)(__attribute__((address_space(1))) T*)p; }
#define GIN(F, i) as_global((F).in[i])
#define XB_TMO      128
#define XB_XCNT(j)  (256  + 64 * (j))
#define XB_XSUB(j)  (1280 + 64 * (j))
#define XB_XGEN(j)  (2304 + 64 * (j))
#define XB_TOP      3328
#define XB_TOPGEN   3392
#define XCD_BAR_WORDS 3456
#define XB_SPIN_CAP (1u << 18)
__device__ __forceinline__ unsigned xb_ld(unsigned* p)              { return __hip_atomic_load(p, __ATOMIC_RELAXED, __HIP_MEMORY_SCOPE_AGENT); }
__device__ __forceinline__ unsigned xb_add(unsigned* p, unsigned v) { return __hip_atomic_fetch_add(p, v, __ATOMIC_RELAXED, __HIP_MEMORY_SCOPE_AGENT); }
__device__ __forceinline__ unsigned xb_xcc_id() { return (unsigned)__builtin_amdgcn_s_getreg((3 << 11) | 20) & 0xFu; }
#define XB_SPIN(cond, bar) do { unsigned _sp = 0; while (cond) { __builtin_amdgcn_s_sleep(1); \
    if ((++_sp & 255u) == 0u) { if (xb_ld(&(bar)[XB_TMO])) break; if (_sp > XB_SPIN_CAP) { atomicAdd(&(bar)[XB_TMO], 1u); break; } } } } while (0)
struct XcdBarrier { unsigned* bar; unsigned x; volatile LAS unsigned* st; };
__device__ __forceinline__ XcdBarrier xcd_barrier_post(unsigned* bar, volatile LAS unsigned* st) {
    XcdBarrier b; b.bar = bar; b.x = xb_xcc_id(); b.st = st;
    if (threadIdx.x == 0) (void)xb_add(&bar[XB_XCNT(b.x)], 1u);
    return b;
}
__device__ __forceinline__ void xcd_barrier_complete(unsigned* bar, unsigned x, unsigned& nloc, unsigned& nx) {
    const unsigned G = gridDim.x * gridDim.y * gridDim.z;
    unsigned sum, cnt, mine, sp = 0u;
    for (;;) {
        sum = 0u; cnt = 0u; mine = 0u;
#pragma unroll
        for (unsigned j = 0; j < 16; ++j) { const unsigned c = xb_ld(&bar[XB_XCNT(j)]); sum += c; cnt += (c > 0u) ? 1u : 0u; mine = (j == x) ? c : mine; }
        if (sum == G) break;
        __builtin_amdgcn_s_sleep(1);
        if ((++sp & 255u) == 0u) { if (xb_ld(&bar[XB_TMO])) break; if (sp > XB_SPIN_CAP) { atomicAdd(&bar[XB_TMO], 1u); break; } }
    }
    nloc = mine > 0u ? mine : 1u; nx = cnt > 0u ? cnt : 1u;
}
__device__ __forceinline__ void xcd_barrier(const XcdBarrier& b) {
    asm volatile("s_waitcnt vmcnt(0)" ::: "memory");
    __syncthreads();
    if (threadIdx.x == 0) {
        unsigned* bar = b.bar;
        __builtin_amdgcn_s_waitcnt(0);
        unsigned nloc = b.st[0], nx = b.st[1];
        if (nloc == 0u) { xcd_barrier_complete(bar, b.x, nloc, nx); b.st[0] = nloc; b.st[1] = nx; }
        const unsigned old = xb_add(&bar[XB_XSUB(b.x)], 1u);
        const unsigned gen = old / nloc;
        if (old + 1u == (gen + 1u) * nloc) {
            __builtin_amdgcn_fence(__ATOMIC_RELEASE, "agent");
            asm volatile("s_waitcnt vmcnt(0)" ::: "memory");
            const unsigned og = xb_add(&bar[XB_TOP], 1u);
            const unsigned tg = og / nx;
            if (og + 1u == (tg + 1u) * nx) xb_add(&bar[XB_TOPGEN], 1u);
            else XB_SPIN(xb_ld(&bar[XB_TOPGEN]) == tg, bar);
            __builtin_amdgcn_fence(__ATOMIC_ACQUIRE, "agent");
            xb_add(&bar[XB_XGEN(b.x)], 1u);
            asm volatile("s_waitcnt vmcnt(0)" ::: "memory");
        } else {
            XB_SPIN(xb_ld(&bar[XB_XGEN(b.x)]) == gen, bar);
            __builtin_amdgcn_fence(__ATOMIC_ACQUIRE, "agent");
            asm volatile("s_waitcnt vmcnt(0)" ::: "memory");
        }
    }
    __syncthreads();
}

struct Args { const float* in[27]; float* out; unsigned char* ws; int ph_lo, ph_hi; };
struct Frame {
    const float* const* in; float* out; unsigned char* ws; LAS unsigned char* lds;
    int tid, lane, wave, G, blk, vcu;
};
constexpr int LDS_BYTES = 160 * 1024 - 64;
constexpr int LDS_MISC = LDS_BYTES - 64;

namespace pg8 {
constexpr int BM = 256, BK = 64, HALF = 128, HTB = HALF * BK * 2, STAGE_BYTES = 8 * HTB, NXCD = 8, WGM = 8;
__device__ __forceinline__ int lds_byte(int r, int c) { const int st = (r >> 4) * 2 + (c >> 5), rr = r & 15, cc = c & 31, ob = rr * 64 + cc * 2; return st * 1024 + (ob ^ (((ob >> 9) & 1) << 5)); }
__device__ __forceinline__ void stage_rc(int b, int& R, int& C) { const int st = b / 1024, sb = b % 1024, swz = sb ^ (((sb >> 9) & 1) << 5); R = (st >> 1) * 16 + swz / 64; C = (st & 1) * 32 + (swz % 64) / 2; }
__device__ __forceinline__ int perm32(int rho) { const int n = rho >> 4, i = rho & 15; return 8 * (i >> 2) + 4 * n + (i & 3); }
struct Unit { int pm, pn, aux, ord; };
typedef f32x4 Acc[2][2][4][2];

__device__ __forceinline__ bool static_tile(long L, int nM, int nN, int& pm, int& pn) {
    const int nwg = nM * nN; if (L >= nwg) return false;
    int wgid = (int)L; { const int q = nwg / NXCD, r = nwg % NXCD, xcd = wgid % NXCD, off = wgid / NXCD; wgid = (xcd < r ? xcd * (q + 1) : r * (q + 1) + (xcd - r) * q) + off; }
    const int nig = WGM * nN, gid = wgid / nig, fm = gid * WGM, gsz = (nM - fm) < WGM ? (nM - fm) : WGM;
    pm = fm + ((wgid % nig) % gsz); pn = (wgid % nig) / gsz; return true;
}

template <class P>
__device__ __forceinline__ void gemm_phase(LAS unsigned char* lds, const P& p) {
    int tid_ = threadIdx.x; asm volatile("" : "+v"(tid_));
    const int tid = tid_, wid = __builtin_amdgcn_readfirstlane(tid >> 6), lane = tid & 63, wr = wid >> 2, wc = wid & 3, fr = lane & 15, fq = lane >> 4;
    int R[2], C[2], Rb[2];
    unsigned lA[2], lB[2];
#pragma unroll
    for (int i = 0; i < 2; ++i) { stage_rc(tid * 16 + i * 8192, R[i], C[i]); Rb[i] = P::PERM ? ((R[i] & ~31) + perm32(R[i] & 31)) : R[i];
        lA[i] = P::GATHER ? 0u : p.laneA(R[i], C[i]); lB[i] = p.laneB(Rb[i], C[i]); }
    const unsigned ldsw = (unsigned)wid * 1024u;
    const int aoff = lds_byte(wr * 64 + fr, fq * 8), boff = lds_byte(wc * 32 + fr, fq * 8);
#define PG8_SA(b, h) (((b) * 2 + (h)) * HTB)
#define PG8_SB(b, h) ((4 + (b) * 2 + (h)) * HTB)
#define PG8_STAGE(bufoff, gbase, voff) do { _Pragma("unroll") for (int _i = 0; _i < 2; ++_i) \
        __builtin_amdgcn_global_load_lds((const unsigned*)((const char*)(gbase) + (voff)[_i]), (LAS unsigned*)(lds + (bufoff) + ldsw + _i * 8192), 16, 0, 0); } while (0)
#define PG8_LDA(dst, b, h) do { _Pragma("unroll") for (int m = 0; m < 4; ++m) _Pragma("unroll") for (int k = 0; k < 2; ++k) dst[m][k] = *(const LAS bf16x8*)(lds + PG8_SA(b, h) + aoff + m * 2048 + k * 1024); } while (0)
#define PG8_LDB(dst, b, h) do { _Pragma("unroll") for (int n = 0; n < 2; ++n) _Pragma("unroll") for (int k = 0; k < 2; ++k) dst[n][k] = *(const LAS bf16x8*)(lds + PG8_SB(b, h) + boff + n * 2048 + k * 1024); } while (0)
#define PG8_MMA(ai, bj, At, Bt) do { __builtin_amdgcn_s_setprio(1); _Pragma("unroll") for (int m = 0; m < 4; ++m) _Pragma("unroll") for (int n = 0; n < 2; ++n) _Pragma("unroll") for (int k = 0; k < 2; ++k) \
        acc[ai][bj][m][n] = __builtin_amdgcn_mfma_f32_16x16x32_bf16(Bt[n][k], At[m][k], acc[ai][bj][m][n], 0, 0, 0); __builtin_amdgcn_s_setprio(0); } while (0)
#define PG8_WAIT_V(n) asm volatile("s_waitcnt vmcnt(" #n ")" ::: "memory")
#define PG8_WAIT_L(n) asm volatile("s_waitcnt lgkmcnt(" #n ")" ::: "memory")
#define PG8_BAR __builtin_amdgcn_s_barrier()
#define PG8_SCHED __builtin_amdgcn_sched_barrier(0)
    Unit cur, nxt; int ui = 0;
    if (!p.next(0, cur)) return;
    Acc acc;
#pragma unroll
    for (int a = 0; a < 2; ++a)
#pragma unroll
        for (int b = 0; b < 2; ++b)
#pragma unroll
            for (int m = 0; m < 4; ++m)
#pragma unroll
                for (int n = 0; n < 2; ++n) acc[a][b][m][n] = (f32x4){0.f, 0.f, 0.f, 0.f};
    bf16x8 At[4][2], B0[2][2], B1[2][2];
    const char* cA0 = p.uA(cur, 0); const char* cA1 = P::GATHER ? cA0 : p.uA(cur, 1);
    const char* cB0 = p.uB(cur, 0); const char* cB1 = p.uB(cur, 1);
    unsigned gc[2][2] = {{0u, 0u}, {0u, 0u}}, gn[2][2] = {{0u, 0u}, {0u, 0u}};
    if constexpr (P::GATHER) p.gatherA(cur, R, C, gc);
#define A_OFF(sel, h) (P::GATHER ? sel[h] : lA)
#define KA(u, base, h, kt) (P::SEGT ? p.kA(u, h, kt) : (base) + (size_t)(kt) * 128)
#define KB(u, base, h, kt) (P::SEGT ? p.kB(u, h, kt) : (base) + (size_t)(kt) * 128)
    PG8_STAGE(PG8_SB(0, 0), cB0, lB); PG8_STAGE(PG8_SA(0, 0), cA0, A_OFF(gc, 0)); PG8_STAGE(PG8_SB(0, 1), cB1, lB); PG8_STAGE(PG8_SA(0, 1), cA1, A_OFF(gc, 1));
    if (wr == 1) PG8_BAR;
    PG8_WAIT_V(4); PG8_BAR;
    PG8_STAGE(PG8_SB(1, 0), KB(cur, cB0, 0, 1), lB); PG8_STAGE(PG8_SA(1, 0), KA(cur, cA0, 0, 1), A_OFF(gc, 0)); PG8_STAGE(PG8_SB(1, 1), KB(cur, cB1, 1, 1), lB);
    PG8_WAIT_V(6); PG8_BAR;
    for (;;) {
        const int nt = p.nt_of(cur);
        const bool has_next = p.next(ui + 1, nxt);
        const char* nA0 = cA0; const char* nA1 = cA1; const char* nB0 = cB0; const char* nB1 = cB1;
        if (!has_next) nxt = cur;
        if (has_next) { nA0 = p.uA(nxt, 0); nA1 = P::GATHER ? nA0 : p.uA(nxt, 1); nB0 = p.uB(nxt, 0); nB1 = p.uB(nxt, 1); }
        if constexpr (P::GATHER) { if (has_next) p.gatherA(nxt, R, C, gn); else { gn[0][0] = gc[0][0]; gn[0][1] = gc[0][1]; gn[1][0] = gc[1][0]; gn[1][1] = gc[1][1]; } }
        for (int t = 0; t < nt; t += 2) {
            const bool last = (t == nt - 2);
            if constexpr (P::SEGT > 0) { if (t > 0 && (t % (P::SEGT > 0 ? P::SEGT : 1)) == 0) p.seg_hook(acc, cur, t / (P::SEGT > 0 ? P::SEGT : 1), wr, wc, fr, fq); }
            const int kt2 = last ? 0 : t + 2, kt3 = kt2 + 1;
            const char* a1_1 = KA(cur, cA1, 1, t + 1);
            const char* a2_0 = last ? KA(nxt, nA0, 0, kt2) : KA(cur, cA0, 0, kt2); const char* a2_1 = last ? KA(nxt, nA1, 1, kt2) : KA(cur, cA1, 1, kt2);
            const char* b2_0 = last ? KB(nxt, nB0, 0, kt2) : KB(cur, cB0, 0, kt2); const char* b2_1 = last ? KB(nxt, nB1, 1, kt2) : KB(cur, cB1, 1, kt2);
            const char* a3_0 = last ? KA(nxt, nA0, 0, kt3) : KA(cur, cA0, 0, kt3); const char* a3_1 = last ? KA(nxt, nA1, 1, kt3) : KA(cur, cA1, 1, kt3);
            const char* b3_0 = last ? KB(nxt, nB0, 0, kt3) : KB(cur, cB0, 0, kt3); const char* b3_1 = last ? KB(nxt, nB1, 1, kt3) : KB(cur, cB1, 1, kt3);
            unsigned g2[2][2];
            if constexpr (P::GATHER) { g2[0][0] = last ? gn[0][0] : gc[0][0]; g2[0][1] = last ? gn[0][1] : gc[0][1]; g2[1][0] = last ? gn[1][0] : gc[1][0]; g2[1][1] = last ? gn[1][1] : gc[1][1]; }
            PG8_LDB(B0, 0, 0); PG8_SCHED; PG8_LDA(At, 0, 0); PG8_STAGE(PG8_SA(1, 1), a1_1, A_OFF(gc, 1));
            PG8_WAIT_L(8); PG8_BAR; PG8_WAIT_L(0); PG8_MMA(0, 0, At, B0); PG8_BAR; PG8_SCHED;
            PG8_LDB(B1, 0, 1); PG8_STAGE(PG8_SB(0, 0), b2_0, lB);
            PG8_BAR; PG8_WAIT_L(0); PG8_MMA(0, 1, At, B1); PG8_BAR;
            PG8_LDA(At, 0, 1); PG8_STAGE(PG8_SA(0, 0), a2_0, A_OFF(g2, 0));
            PG8_BAR; PG8_WAIT_L(0); PG8_MMA(1, 0, At, B0); PG8_BAR; PG8_SCHED;
            PG8_STAGE(PG8_SB(0, 1), b2_1, lB);
            PG8_WAIT_V(6); PG8_BAR; PG8_MMA(1, 1, At, B1); PG8_BAR;
            PG8_LDB(B0, 1, 0); PG8_SCHED; PG8_LDA(At, 1, 0); PG8_STAGE(PG8_SA(0, 1), a2_1, A_OFF(g2, 1));
            PG8_WAIT_L(8); PG8_BAR; PG8_WAIT_L(0); PG8_MMA(0, 0, At, B0); PG8_BAR; PG8_SCHED;
            PG8_LDB(B1, 1, 1); PG8_STAGE(PG8_SB(1, 0), b3_0, lB);
            PG8_BAR; PG8_WAIT_L(0); PG8_MMA(0, 1, At, B1); PG8_BAR;
            PG8_LDA(At, 1, 1); PG8_STAGE(PG8_SA(1, 0), a3_0, A_OFF(g2, 0));
            PG8_BAR; PG8_WAIT_L(0); PG8_MMA(1, 0, At, B0); PG8_BAR; PG8_SCHED;
            PG8_STAGE(PG8_SB(1, 1), b3_1, lB);
            PG8_WAIT_V(6); PG8_BAR; PG8_MMA(1, 1, At, B1); PG8_BAR;
        }
        p.epi(acc, cur, wr, wc, fr, fq);
        if (!has_next) break;
#pragma unroll
        for (int a = 0; a < 2; ++a)
#pragma unroll
            for (int b = 0; b < 2; ++b)
#pragma unroll
                for (int m = 0; m < 4; ++m)
#pragma unroll
                    for (int n = 0; n < 2; ++n) acc[a][b][m][n] = (f32x4){0.f, 0.f, 0.f, 0.f};
        cur = nxt; cA0 = nA0; cA1 = nA1; cB0 = nB0; cB1 = nB1; ++ui;
        if constexpr (P::GATHER) { gc[0][0] = gn[0][0]; gc[0][1] = gn[0][1]; gc[1][0] = gn[1][0]; gc[1][1] = gn[1][1]; }
    }
    PG8_WAIT_V(0);
    if (wr == 0) PG8_BAR;
    PG8_BAR;
#undef A_OFF
#undef KA
#undef KB
#undef PG8_SA
#undef PG8_SB
#undef PG8_STAGE
#undef PG8_LDA
#undef PG8_LDB
#undef PG8_MMA
#undef PG8_WAIT_V
#undef PG8_WAIT_L
#undef PG8_BAR
#undef PG8_SCHED
}
}
using pg8::Unit; using pg8::Acc;

__device__ __forceinline__ void unpack8(const u32x4& w, float (&f)[8]) {
#pragma unroll
    for (int j = 0; j < 4; ++j) { f[2 * j] = bf2f(w[j] & 0xffffu); f[2 * j + 1] = bf2f(w[j] >> 16); }
}
__device__ __forceinline__ void st8bf_nt(u16* p, const f32x4& v0, const f32x4& v1) {
    u32x4 w = {cvtpk(v0[0], v0[1]), cvtpk(v0[2], v0[3]), cvtpk(v1[0], v1[1]), cvtpk(v1[2], v1[3])};
    __builtin_nontemporal_store(w, (u32x4*)p);
}
__device__ __forceinline__ void st8bf_wt(u16* p, const f32x4& v0, const f32x4& v1) {
    u32x4 w = {cvtpk(v0[0], v0[1]), cvtpk(v0[2], v0[3]), cvtpk(v1[0], v1[1]), cvtpk(v1[2], v1[3])};
    asm volatile("global_store_dwordx4 %0, %1, off sc0 sc1\n\ts_nop 2" :: "v"(p), "v"(w) : "memory");
}
__device__ __forceinline__ void st8bf(u16* p, const f32x4& v0, const f32x4& v1) {
    u32x4 w = {cvtpk(v0[0], v0[1]), cvtpk(v0[2], v0[3]), cvtpk(v1[0], v1[1]), cvtpk(v1[2], v1[3])};
    *(u32x4*)p = w;
}
__device__ __forceinline__ unsigned pkh2(float a, float b) { const _Float16 x = (_Float16)a, y = (_Float16)b; return (unsigned)__builtin_bit_cast(u16, x) | ((unsigned)__builtin_bit_cast(u16, y) << 16); }
__device__ __forceinline__ float logf_gate(float v, float lbf, float oml) {
    return __logf(fmaf(oml, __builtin_amdgcn_rcpf(1.f + __expf(-v)), lbf));
}

struct PIn {
    static constexpr int SEGT = 0; __device__ __forceinline__ const char* kA(const Unit&, int, int) const { return nullptr; } __device__ __forceinline__ const char* kB(const Unit&, int, int) const { return nullptr; }
    __device__ __forceinline__ int nt_of(const Unit&) const { return nt; }
    static constexpr bool PERM = true, GATHER = false;
    const char* A; const char* B; int nt, G, c, nM, nN, rt0, pn0, nctx;
    unsigned char* ws; const float* lbt; const float* rope; int dry = 0;
    __device__ __forceinline__ bool next(int i, Unit& u) const { int pm, pn; const long L = (long)i * G + c; u.aux = 0;
        if (pg8::static_tile(L, nM, nN, pm, pn)) { u.pm = rt0 + pm; u.pn = pn0 + pn; return true; }
        const long L2 = L - (long)nM * nN; if (L2 >= nctx) return false; const int k = (int)(L2 % 12); u.pm = (int)(L2 / 12); u.pn = k < 8 ? k : k + 4; return true; }
    __device__ __forceinline__ const char* uA(const Unit& u, int h) const { return A + (size_t)(u.pm * 256 + h * 128) * 2048; }
    __device__ __forceinline__ const char* uB(const Unit& u, int h) const { return B + (size_t)(u.pn * 256 + h * 128) * 2048; }
    __device__ __forceinline__ unsigned laneA(int R, int C) const { return (unsigned)(R * 2048 + C * 2); }
    __device__ __forceinline__ unsigned laneB(int R, int C) const { return (unsigned)(R * 2048 + C * 2); }
    template <int BJ> __device__ __forceinline__ void logf_part(const Acc& acc, const Unit& u, u16* O, const float* lb, int cs0, int wr, int fr) const {
        const int cs = cs0 + BJ * 128;
        const f32x4 t0 = GLD(f32x4, lb + cs * 2), t1 = GLD(f32x4, lb + cs * 2 + 4), t2 = GLD(f32x4, lb + cs * 2 + 8), t3 = GLD(f32x4, lb + cs * 2 + 12);
#pragma unroll
        for (int ai = 0; ai < 2; ++ai)
#pragma unroll
            for (int m = 0; m < 4; ++m) { const size_t row = (size_t)(u.pm * 256 + ai * 128 + wr * 64 + m * 16 + fr);
                const f32x4 v0 = acc[ai][BJ][m][0], v1 = acc[ai][BJ][m][1];
                u32x4 w;
                w[0] = pkh2(logf_gate(v0[0], t0[0], t0[1]), logf_gate(v0[1], t0[2], t0[3]));
                w[1] = pkh2(logf_gate(v0[2], t1[0], t1[1]), logf_gate(v0[3], t1[2], t1[3]));
                w[2] = pkh2(logf_gate(v1[0], t2[0], t2[1]), logf_gate(v1[1], t2[2], t2[3]));
                w[3] = pkh2(logf_gate(v1[2], t3[0], t3[1]), logf_gate(v1[3], t3[2], t3[3]));
                *(u32x4*)(O + row * 512 + cs) = w; __builtin_amdgcn_sched_barrier(0); }
    }
    __device__ __forceinline__ void epi(const Acc& acc, const Unit& u, int wr, int wc, int fr, int fq) const {
        const int sec = u.pn >> 1;
        if (sec >= 9) {
            u16* G_ = (u16*)(ws + WS_GATES);
            const int col0 = (u.pn - 18) * 256 + wc * 32 + 8 * fq;
            if (dry) {
                u16* D_ = (u16*)(ws + WS_TT);
#pragma unroll
                for (int ai = 0; ai < 2; ++ai)
#pragma unroll
                    for (int m = 0; m < 4; ++m) { const size_t row = (size_t)(u.pm * 256 + ai * 128 + wr * 64 + m * 16 + fr);
#pragma unroll
                        for (int bj = 0; bj < 2; ++bj) { f32x4 v0 = acc[ai][bj][m][0], v1 = acc[ai][bj][m][1];
                            if (dry == 1) {
#pragma unroll
                                for (int j = 0; j < 4; ++j) { v0[j] = sigmoidf_(v0[j]); v1[j] = sigmoidf_(v1[j]); } }
                            if (dry == 4) {
#pragma unroll
                                for (int j = 0; j < 4; ++j) { v0[j] = 1.f + __builtin_amdgcn_exp2f(v0[j] * -1.44269504f); v1[j] = 1.f + __builtin_amdgcn_exp2f(v1[j] * -1.44269504f); } }
                            if (dry == 6) {
#pragma unroll
                                for (int j = 0; j < 4; ++j) { float a = v0[j], b = v1[j];
#pragma unroll
                                    for (int k = 0; k < 4; ++k) { a = __builtin_amdgcn_exp2f(a) - 1.5f; b = __builtin_amdgcn_exp2f(b) - 1.5f; } v0[j] = a; v1[j] = b; } }
                            if (dry == 7) {
#pragma unroll
                                for (int j = 0; j < 4; ++j) { float a = v0[j], b = v1[j];
#pragma unroll
                                    for (int k = 0; k < 4; ++k) { a = __builtin_amdgcn_rcpf(a) - 1.5f; b = __builtin_amdgcn_rcpf(b) - 1.5f; } v0[j] = a; v1[j] = b; } }
                            if (dry == 8) {
#pragma unroll
                                for (int j = 0; j < 4; ++j) { float a = v0[j], b = v1[j];
#pragma unroll
                                    for (int k = 0; k < 4; ++k) { a = fmaf(a, a, -1.5f) - 1.5f; b = fmaf(b, b, -1.5f) - 1.5f; } v0[j] = a; v1[j] = b; } }
                            if (dry == 5) {
#pragma unroll
                                for (int j = 0; j < 4; ++j) { v0[j] = 1.f + exp2_poly(v0[j] * -1.44269504f); v1[j] = 1.f + exp2_poly(v1[j] * -1.44269504f); } }
                            if (dry != 3 || (ai == 0 && m == 0 && bj == 0)) st8bf(D_ + ((row * 3072 + col0 + bj * 128) & (size_t)(16 * MiB - 1)), v0, v1);
                            else asm volatile("" :: "v"(v0[0] + v1[3])); } __builtin_amdgcn_sched_barrier(0); }
                return;
            }
            { const int gt = u.pn - 18, tidf = (wr * 4 + wc) * 64 + fq * 16 + fr;
              u16* Gb = G_ + ((size_t)(u.pm * 3 + (gt >> 2)) * 4 + (gt & 3)) * 65536 + tidf * 8;
#pragma unroll
              for (int ai = 0; ai < 2; ++ai)
#pragma unroll
                for (int m = 0; m < 4; ++m) {
#pragma unroll
                    for (int bj = 0; bj < 2; ++bj) { f32x4 v0 = acc[ai][bj][m][0], v1 = acc[ai][bj][m][1];
#pragma unroll
                        for (int j = 0; j < 4; ++j) { v0[j] = 1.f + __expf(-v0[j]); v1[j] = 1.f + __expf(-v1[j]); }
                        ST8G(Gb + ((ai * 4 + m) * 2 + bj) * 4096, v0, v1); } __builtin_amdgcn_sched_barrier(0); } }
            return;
        }
        u16* O = (u16*)(ws + WS_P0 + (size_t)sec * PU);
        const int cs0 = (u.pn & 1) * 256 + wc * 32 + 8 * fq;
        if (sec == 1 || sec == 2) {
            const float* lb = as_global(lbt) + (size_t)(sec - 1) * 1024;
            logf_part<0>(acc, u, O, lb, cs0, wr, fr); logf_part<1>(acc, u, O, lb, cs0, wr, fr);
            return;
        }
        const bool rope_sec = (sec == 5 || sec == 6), silu_sec = (sec == 0);
        if (rope_sec && u.pm * 256 >= TC) {
            const int p0 = (wc & 1) * 16 + 4 * fq;
#pragma unroll
            for (int ai = 0; ai < 2; ++ai) {
                f32x4 cs4[4], sn4[4];
#pragma unroll
                for (int m = 0; m < 4; ++m) { const int t = (u.pm * 256 + ai * 128 + wr * 64 + m * 16 + fr - TC) & (SEQ - 1);
                    cs4[m] = GLD(f32x4, rope + (size_t)t * 32 + p0); sn4[m] = GLD(f32x4, rope + 65536 + (size_t)t * 32 + p0); }
#pragma unroll
                for (int m = 0; m < 4; ++m) { const size_t row = (size_t)(u.pm * 256 + ai * 128 + wr * 64 + m * 16 + fr);
#pragma unroll
                    for (int bj = 0; bj < 2; ++bj) { const f32x4 v0 = acc[ai][bj][m][0], v1 = acc[ai][bj][m][1]; f32x4 r0, r1;
                        r0[0] = v0[0] * cs4[m][0] - v0[1] * sn4[m][0]; r0[1] = v0[1] * cs4[m][0] + v0[0] * sn4[m][0];
                        r0[2] = v0[2] * cs4[m][1] - v0[3] * sn4[m][1]; r0[3] = v0[3] * cs4[m][1] + v0[2] * sn4[m][1];
                        r1[0] = v1[0] * cs4[m][2] - v1[1] * sn4[m][2]; r1[1] = v1[1] * cs4[m][2] + v1[0] * sn4[m][2];
                        r1[2] = v1[2] * cs4[m][3] - v1[3] * sn4[m][3]; r1[3] = v1[3] * cs4[m][3] + v1[2] * sn4[m][3];
                        st8bf(O + row * 512 + cs0 + bj * 128, r0, r1); } }
                __builtin_amdgcn_sched_barrier(0); }
            return;
        }
#pragma unroll
        for (int ai = 0; ai < 2; ++ai)
#pragma unroll
            for (int m = 0; m < 4; ++m) { const size_t row = (size_t)(u.pm * 256 + ai * 128 + wr * 64 + m * 16 + fr);
#pragma unroll
                for (int bj = 0; bj < 2; ++bj) { f32x4 v0 = acc[ai][bj][m][0], v1 = acc[ai][bj][m][1]; const int cs = cs0 + bj * 128;
                    if (silu_sec) {
#pragma unroll
                        for (int j = 0; j < 4; ++j) { v0[j] = siluf_(v0[j]); v1[j] = siluf_(v1[j]); }
                    }
                    st8bf(O + row * 512 + cs, v0, v1); } __builtin_amdgcn_sched_barrier(0); }
    }
};

struct PF1 {
    int skew_ticks = 0;
    static constexpr int SEGT = 2;
    int nt; __device__ __forceinline__ int nt_of(const Unit&) const { return nt; }
    static constexpr bool PERM = true, GATHER = false;
    const char* Alat; const char* Actx; const char* B; int G, c, nunits; u16* Olat; u16* Octx;
    __device__ __forceinline__ bool next(int i, Unit& u) const { const int L = i * G + c; if (L >= nunits) return false;
        if (L < 256) { u.aux = L >> 2; u.pn = L & 3; u.pm = 0; } else { u.aux = L - 256; u.pn = 0; u.pm = 1; } return true; }
    __device__ __forceinline__ const char* kA(const Unit& u, int h, int kt) const { return (u.pm ? Actx : Alat) + (size_t)h * 128 * 512 + (size_t)kt * 128; }
    __device__ __forceinline__ const char* kB(const Unit& u, int h, int kt) const { const int b = u.aux >> 2, g = u.aux & 3;
        if (u.pm) return B + ((size_t)(b * LC + h * 128) * 512 + g * 128) * 2 + (size_t)kt * 128;
        return B + ((size_t)(TC + b * SEQ + (kt >> 1) * 1024 + u.pn * 256 + h * 128) * 512 + g * 128 + (kt & 1) * 64) * 2; }
    __device__ __forceinline__ const char* uA(const Unit& u, int h) const { return kA(u, h, 0); }
    __device__ __forceinline__ const char* uB(const Unit& u, int h) const { return kB(u, h, 0); }
    __device__ __forceinline__ unsigned laneA(int R, int C) const { return (unsigned)(R * 512 + C * 2); }
    __device__ __forceinline__ unsigned laneB(int R, int C) const { return (unsigned)(R * 1024 + C * 2); }
    __device__ __forceinline__ void seg_hook(Acc&, const Unit&, int, int, int, int, int) const {}
    __device__ __forceinline__ void epi(const Acc& acc, const Unit& u, int wr, int wc, int fr, int fq) const {
        u16* Ob = (u.pm ? Octx : Olat) + (size_t)(u.aux * 128 + wr * 64 + fr) * 2048 + u.pn * 256 + wc * 32 + 8 * fq;
        const int half_off = u.pm ? 256 : 1024;
#pragma unroll
        for (int ai = 0; ai < 2; ++ai)
#pragma unroll
            for (int m = 0; m < 4; ++m) {
#pragma unroll
                for (int bj = 0; bj < 2; ++bj)
                    st8bf(Ob + (size_t)m * 16 * 2048 + ai * half_off + bj * 128, acc[ai][bj][m][0], acc[ai][bj][m][1]);
                __builtin_amdgcn_sched_barrier(0); }
    }
};
struct PF2 {
    int skew_ticks = 0;
    static constexpr int SEGT = 0; __device__ __forceinline__ const char* kA(const Unit&, int, int) const { return nullptr; } __device__ __forceinline__ const char* kB(const Unit&, int, int) const { return nullptr; }
    static constexpr bool PERM = true, GATHER = false;
    const char* Alat; const char* Blat; const char* Actx; const char* Bctx; int G, c, nunits; u16* O; const float* ucm;
    int nt_lat, nt_ctx; __device__ __forceinline__ int nt_of(const Unit& u) const { return u.aux ? nt_ctx : nt_lat; }
    __device__ __forceinline__ bool next(int i, Unit& u) const { const int L = i * G + c; if (L >= nunits) return false;
        if (L < 256) { int pm, pn; pg8::static_tile(L, 8, 32, pm, pn); u.pm = pm; u.pn = pn; u.aux = 0; } else { u.pm = 0; u.pn = L - 256; u.aux = 1; } return true; }
    __device__ __forceinline__ const char* uA(const Unit& u, int h) const { return (u.aux ? Actx : Alat) + (size_t)(u.pm * 256 + h * 128) * 4096; }
    __device__ __forceinline__ const char* uB(const Unit& u, int h) const { return (u.aux ? Bctx : Blat) + (size_t)(u.pn * 256 + h * 128) * 4096; }
    __device__ __forceinline__ unsigned laneA(int R, int C) const { return (unsigned)(R * 4096 + C * 2); }
    __device__ __forceinline__ unsigned laneB(int R, int C) const { return (unsigned)(R * 4096 + C * 2); }
    __device__ __forceinline__ void epi(const Acc& acc, const Unit& u, int wr, int wc, int fr, int fq) const {
        const float scale = u.aux ? 0.005524271728019903f : (1.f / 512.f);
        const int lseg = u.aux ? LC : SEQ, rowbase = u.aux ? 0 : TC;
        const int ci0 = u.pn * 256 + wc * 32 + 8 * fq, b = ci0 >> 9, rem = ci0 & 511;
        u16* Ob = O + (size_t)(rowbase + b * lseg + u.pm * 256 + wr * 64 + fr) * 512 + rem;
        f32x4 mid[2][2];
        const float sg = u.aux ? 0.f : ((fr & 1) ? -1.f : 1.f);
#pragma unroll
        for (int bj = 0; bj < 2; ++bj)
#pragma unroll
            for (int n = 0; n < 2; ++n) mid[bj][n] = GLD(f32x4, ucm + ci0 + bj * 128 + n * 4) * sg;
#pragma unroll
        for (int ai = 0; ai < 2; ++ai)
#pragma unroll
            for (int m = 0; m < 4; ++m) {
#pragma unroll
                for (int bj = 0; bj < 2; ++bj)
                    st8bf(Ob + (size_t)(ai * 128 + m * 16) * 512 + bj * 128, (acc[ai][bj][m][0] + mid[bj][0]) * scale, (acc[ai][bj][m][1] + mid[bj][1]) * scale);
                __builtin_amdgcn_sched_barrier(0); }
    }
};
struct PMerge {
    static constexpr int SEGT = 8;
    __device__ __forceinline__ int nt_of(const Unit&) const { return nt; }
    static constexpr bool PERM = true, GATHER = false;
    unsigned char* ws; int nt, G, c, nM, rt0; int dry = 0;
    __device__ __forceinline__ bool next(int i, Unit& u) const { int pm, pn; if (!pg8::static_tile((long)i * G + c, nM, 4, pm, pn)) return false; u.pm = rt0 + pm; u.pn = pn; u.aux = 0; return true; }
    __device__ __forceinline__ const char* kA(const Unit& u, int h, int kt) const { const int sg = kt >> 3; const size_t off = sg == 0 ? WS_P0 : (sg == 1 ? WS_P5 : WS_P3);
        return (const char*)ws + off + (size_t)(u.pm * 256 + h * 128) * 1024 + (size_t)(kt & 7) * 128; }
    __device__ __forceinline__ const char* kB(const Unit& u, int h, int kt) const { const int sg = kt >> 3;
        return (const char*)ws + WS_WL + WL_WPA + (size_t)sg * MiB + (size_t)(u.pn * 256 + h * 128) * 1024 + (size_t)(kt & 7) * 128; }
    __device__ __forceinline__ const char* uA(const Unit& u, int h) const { return kA(u, h, 0); }
    __device__ __forceinline__ const char* uB(const Unit& u, int h) const { return kB(u, h, 0); }
    __device__ __forceinline__ unsigned laneA(int R, int C) const { return (unsigned)(R * 1024 + C * 2); }
    __device__ __forceinline__ unsigned laneB(int R, int C) const { return (unsigned)(R * 1024 + C * 2); }
    __device__ __forceinline__ void seg_hook(Acc& acc, const Unit& u, int sg, int wr, int wc, int fr, int fq) const {
        if (dry == 2) return;
        const int tidf = (wr * 4 + wc) * 64 + fq * 16 + fr;
        const u16* Gp = (const u16*)(ws + WS_GATES) + ((size_t)(u.pm * 3 + (sg - 1)) * 4 + u.pn) * 65536 + tidf * 8;
        const u16* Gn = Gp + 4 * 65536;
        u32x4 bp[2][2][2], bn[2][2][2];
#define HK_LOAD(buf, q) do { _Pragma("unroll") for (int mm = 0; mm < 2; ++mm) _Pragma("unroll") for (int bj = 0; bj < 2; ++bj) { \
            const int fo = ((((q) >> 1) * 4 + ((q) & 1) * 2 + mm) * 2 + bj) * 4096; bp[buf][mm][bj] = *(const u32x4*)(Gp + fo); bn[buf][mm][bj] = *(const u32x4*)(Gn + fo); } } while (0)
#define HK_APPLY(buf, q) do { _Pragma("unroll") for (int mm = 0; mm < 2; ++mm) _Pragma("unroll") for (int bj = 0; bj < 2; ++bj) { float fp[8], fn[8]; unpack8(bp[buf][mm][bj], fp); unpack8(bn[buf][mm][bj], fn); \
            const int ai = (q) >> 1, m = ((q) & 1) * 2 + mm; \
            _Pragma("unroll") for (int j = 0; j < 4; ++j) { acc[ai][bj][m][0][j] *= fn[j] * __builtin_amdgcn_rcpf(fp[j]); acc[ai][bj][m][1][j] *= fn[4 + j] * __builtin_amdgcn_rcpf(fp[4 + j]); } } } while (0)
        HK_LOAD(0, 0); HK_LOAD(1, 1); __builtin_amdgcn_sched_barrier(0);
        HK_APPLY(0, 0); __builtin_amdgcn_sched_barrier(0); HK_LOAD(0, 2); __builtin_amdgcn_sched_barrier(0);
        HK_APPLY(1, 1); __builtin_amdgcn_sched_barrier(0); HK_LOAD(1, 3); __builtin_amdgcn_sched_barrier(0);
        HK_APPLY(0, 2); __builtin_amdgcn_sched_barrier(0);
        HK_APPLY(1, 3); __builtin_amdgcn_sched_barrier(0);
#undef HK_LOAD
#undef HK_APPLY
    }
    __device__ __forceinline__ void epi(const Acc& acc, const Unit& u, int wr, int wc, int fr, int fq) const {
        const int tidf = (wr * 4 + wc) * 64 + fq * 16 + fr;
        const u16* Gt = (const u16*)(ws + WS_GATES) + ((size_t)(u.pm * 3 + 2) * 4 + u.pn) * 65536 + tidf * 8;
        u16* M = (u16*)(ws + (dry ? WS_P1 : WS_H)) + (size_t)(u.pm * 256 + wr * 64 + fr) * 1024 + u.pn * 256 + wc * 32 + 8 * fq;
#pragma unroll
        for (int ai = 0; ai < 2; ++ai) {
            u32x4 g[4][2];
#pragma unroll
            for (int m = 0; m < 4; ++m)
#pragma unroll
                for (int bj = 0; bj < 2; ++bj) g[m][bj] = *(const u32x4*)(Gt + ((ai * 4 + m) * 2 + bj) * 4096);
#pragma unroll
            for (int m = 0; m < 4; ++m)
#pragma unroll
                for (int bj = 0; bj < 2; ++bj) { float fg[8]; unpack8(g[m][bj], fg);
                    f32x4 v0 = acc[ai][bj][m][0], v1 = acc[ai][bj][m][1];
#pragma unroll
                    for (int j = 0; j < 4; ++j) { v0[j] *= __builtin_amdgcn_rcpf(fg[j]); v1[j] *= __builtin_amdgcn_rcpf(fg[4 + j]); }
                    st8bf(M + (size_t)(ai * 128 + m * 16) * 1024 + bj * 128, v0, v1); }
            __builtin_amdgcn_sched_barrier(0); }
    }
};
struct POut {
    static constexpr int SEGT = 0; __device__ __forceinline__ const char* kA(const Unit&, int, int) const { return nullptr; } __device__ __forceinline__ const char* kB(const Unit&, int, int) const { return nullptr; }
    __device__ __forceinline__ int nt_of(const Unit&) const { return nt; }
    static constexpr bool PERM = true, GATHER = false;
    const char* A; const char* B; int nt, G, c, nM, rt0;
    const float* src_c; const float* src_l; u16* xb; const float* mod;
    __device__ __forceinline__ bool next(int i, Unit& u) const { int pm, pn; if (!pg8::static_tile((long)i * G + c, nM, 4, pm, pn)) return false; u.pm = rt0 + pm; u.pn = pn; u.aux = 0; return true; }
    __device__ __forceinline__ const char* uA(const Unit& u, int h) const { return A + (size_t)(u.pm * 256 + h * 128) * 2048; }
    __device__ __forceinline__ const char* uB(const Unit& u, int h) const { return B + (size_t)(u.pn * 256 + h * 128) * 2048; }
    __device__ __forceinline__ unsigned laneA(int R, int C) const { return (unsigned)(R * 2048 + C * 2); }
    __device__ __forceinline__ unsigned laneB(int R, int C) const { return (unsigned)(R * 2048 + C * 2); }
    __device__ __forceinline__ void epi(const Acc& acc, const Unit& u, int wr, int wc, int fr, int fq) const {
        const int row0 = u.pm * 256;
        const int mi = row0 < TC ? 16 : ((row0 - TC) >> 11);
        const int col0 = u.pn * 256 + wc * 32 + 8 * fq;
        const float* g1 = mod + (size_t)mi * 6144 + 2048 + col0;
        f32x4 gv[2][2];
#pragma unroll
        for (int bj = 0; bj < 2; ++bj)
#pragma unroll
            for (int n = 0; n < 2; ++n) gv[bj][n] = *(const f32x4*)(g1 + bj * 128 + n * 4);
        const int rb = row0 + wr * 64 + fr;
        const float* sp0 = (row0 < TC ? src_c + (size_t)rb * 1024 : src_l + (size_t)(rb - TC) * 1024) + col0;
        u16* dp0 = xb + (size_t)rb * 1024 + col0;
#pragma unroll
        for (int ai = 0; ai < 2; ++ai)
#pragma unroll
            for (int mp = 0; mp < 2; ++mp) {
                f32x4 xv[2][2][2];
#pragma unroll
                for (int mm = 0; mm < 2; ++mm)
#pragma unroll
                    for (int bj = 0; bj < 2; ++bj)
#pragma unroll
                        for (int n = 0; n < 2; ++n) xv[mm][bj][n] = *(const f32x4*)(sp0 + (size_t)(ai * 128 + (2 * mp + mm) * 16) * 1024 + bj * 128 + n * 4);
#pragma unroll
                for (int mm = 0; mm < 2; ++mm)
#pragma unroll
                    for (int bj = 0; bj < 2; ++bj)
                        st8bf(dp0 + (size_t)(ai * 128 + (2 * mp + mm) * 16) * 1024 + bj * 128, xv[mm][bj][0] * ALPHA + gv[bj][0] * acc[ai][bj][2 * mp + mm][0], xv[mm][bj][1] * ALPHA + gv[bj][1] * acc[ai][bj][2 * mp + mm][1]);
                __builtin_amdgcn_sched_barrier(0); }
    }
};
struct PRouter {
    static constexpr int SEGT = 0; __device__ __forceinline__ const char* kA(const Unit&, int, int) const { return nullptr; } __device__ __forceinline__ const char* kB(const Unit&, int, int) const { return nullptr; }
    __device__ __forceinline__ int nt_of(const Unit&) const { return nt; }
    static constexpr bool PERM = false, GATHER = false;
    const char* A; const char* B; int nt, G, c, nM, rt0; float* logits;
    __device__ __forceinline__ bool next(int i, Unit& u) const { const long L = (long)i * G + c; if (L >= nM) return false; u.pm = rt0 + (int)L; u.pn = 0; u.aux = 0; return true; }
    __device__ __forceinline__ const char* uA(const Unit& u, int h) const { return A + (size_t)(u.pm * 256 + h * 128) * 2048; }
    __device__ __forceinline__ const char* uB(const Unit&, int h) const { return B + (size_t)(h * 128) * 2048; }
    __device__ __forceinline__ unsigned laneA(int R, int C) const { return (unsigned)(R * 2048 + C * 2); }
    __device__ __forceinline__ unsigned laneB(int R, int C) const { return (unsigned)(R * 2048 + C * 2); }
    __device__ __forceinline__ void epi(const Acc& acc, const Unit& u, int wr, int wc, int fr, int fq) const {
        if (wc >= 2) return;
#pragma unroll
        for (int ai = 0; ai < 2; ++ai)
#pragma unroll
            for (int m = 0; m < 4; ++m) { const size_t row = (size_t)(u.pm * 256 + ai * 128 + wr * 64 + m * 16 + fr);
#pragma unroll
                for (int n = 0; n < 2; ++n) *(f32x4*)(logits + row * 64 + wc * 32 + n * 16 + 4 * fq) = acc[ai][0][m][n]; }
    }
};
__device__ __forceinline__ int ld_agent_i(const int* p) { return (int)__hip_atomic_load((const unsigned*)p, __ATOMIC_RELAXED, __HIP_MEMORY_SCOPE_AGENT); }
struct PUpGate {
    static constexpr int SEGT = 0; __device__ __forceinline__ const char* kA(const Unit&, int, int) const { return nullptr; } __device__ __forceinline__ const char* kB(const Unit&, int, int) const { return nullptr; }
    __device__ __forceinline__ int nt_of(const Unit&) const { return nt; }
    static constexpr bool PERM = true, GATHER = true;
    const char* A; const char* B; int nt, G, c, ntiles; const LAS int* lrt; const LAS int* lte; u16* hb;
    __device__ __forceinline__ bool next(int i, Unit& u) const { const long L = (long)i * G + c; if (L >= 2L * ntiles) return false; u.pm = (int)(L >> 1); u.pn = (int)(L & 1); u.ord = i;
        u.aux = __builtin_amdgcn_readfirstlane(lte[u.pm]); return true; }
    __device__ __forceinline__ const char* uA(const Unit&, int) const { return A; }
    __device__ __forceinline__ const char* uB(const Unit& u, int h) const { return B + (size_t)u.aux * MiB + (size_t)(u.pn * 256 + h * 128) * 2048; }
    __device__ __forceinline__ unsigned laneA(int, int) const { return 0u; }
    __device__ __forceinline__ unsigned laneB(int R, int C) const { return (unsigned)(R * 2048 + C * 2); }
    __device__ __forceinline__ void gatherA(const Unit& u, const int (&R)[2], const int (&C)[2], unsigned (&vo)[2][2]) const {
#pragma unroll
        for (int h = 0; h < 2; ++h)
#pragma unroll
            for (int i = 0; i < 2; ++i) { int tok = lrt[u.ord * 256 + h * 128 + R[i]]; tok = tok < 0 ? 0 : tok; vo[h][i] = (unsigned)tok * 2048u + (unsigned)(C[i] * 2); }
    }
    __device__ __forceinline__ void epi(const Acc& acc, const Unit& u, int wr, int wc, int fr, int fq) const {
#pragma unroll
        for (int ai = 0; ai < 2; ++ai)
#pragma unroll
            for (int m = 0; m < 4; ++m) { const size_t row = (size_t)u.pm * 256 + ai * 128 + wr * 64 + m * 16 + fr;
                f32x4 v0, v1;
#pragma unroll
                for (int j = 0; j < 4; ++j) { v0[j] = siluf_(acc[ai][0][m][0][j]) * acc[ai][1][m][0][j]; v1[j] = siluf_(acc[ai][0][m][1][j]) * acc[ai][1][m][1][j]; }
                st8bf(hb + row * 256 + u.pn * 128 + wc * 32 + 8 * fq, v0, v1); __builtin_amdgcn_sched_barrier(0); }
    }
};
struct PDown {
    static constexpr int SEGT = 0; __device__ __forceinline__ const char* kA(const Unit&, int, int) const { return nullptr; } __device__ __forceinline__ const char* kB(const Unit&, int, int) const { return nullptr; }
    __device__ __forceinline__ int nt_of(const Unit&) const { return nt; }
    static constexpr bool PERM = true, GATHER = false;
    const char* A; const char* B; int nt, G, c, ntiles; const LAS int* lte; unsigned char* so;
    __device__ __forceinline__ bool next(int i, Unit& u) const { const long L = (long)i * G + c; if (L >= 4L * ntiles) return false; u.pm = (int)(L >> 2); u.pn = (int)(L & 3); u.ord = i;
        u.aux = __builtin_amdgcn_readfirstlane(lte[u.pm]); return true; }
    __device__ __forceinline__ const char* uA(const Unit& u, int h) const { return A + (size_t)(u.pm * 256 + h * 128) * 512; }
    __device__ __forceinline__ const char* uB(const Unit& u, int h) const { return B + (size_t)u.aux * 524288 + (size_t)(u.pn * 256 + h * 128) * 512; }
    __device__ __forceinline__ unsigned laneA(int R, int C) const { return (unsigned)(R * 512 + C * 2); }
    __device__ __forceinline__ unsigned laneB(int R, int C) const { return (unsigned)(R * 512 + C * 2); }
    __device__ __forceinline__ void epi(const Acc& acc, const Unit& u, int wr, int wc, int fr, int fq) const {
#pragma unroll
        for (int ai = 0; ai < 2; ++ai)
#pragma unroll
            for (int m = 0; m < 4; ++m) { const size_t row = (size_t)u.pm * 256 + ai * 128 + wr * 64 + m * 16 + fr;
                {
                    int w[2][2];
#pragma unroll
                    for (int bj = 0; bj < 2; ++bj) { const f32x4 v0 = acc[ai][bj][m][0] * 16.f, v1 = acc[ai][bj][m][1] * 16.f; int w0 = 0, w1 = 0;
                        w0 = __builtin_amdgcn_cvt_pk_fp8_f32(v0[0], v0[1], w0, false); w0 = __builtin_amdgcn_cvt_pk_fp8_f32(v0[2], v0[3], w0, true);
                        w1 = __builtin_amdgcn_cvt_pk_fp8_f32(v1[0], v1[1], w1, false); w1 = __builtin_amdgcn_cvt_pk_fp8_f32(v1[2], v1[3], w1, true);
                        w[bj][0] = w0; w[bj][1] = w1; }
                    const auto r0 = __builtin_amdgcn_permlane16_swap((unsigned)w[0][0], (unsigned)w[1][0], false, false);
                    const auto r1 = __builtin_amdgcn_permlane16_swap((unsigned)w[0][1], (unsigned)w[1][1], false, false);
                    const u32x4 q = {r0[0], r1[0], r0[1], r1[1]};
                    const int colo = (fq & 1) ? 128 + 8 * (fq - 1) : 8 * fq;
                    *(u32x4*)(so + row * 1024 + u.pn * 256 + wc * 32 + colo) = q; }
                __builtin_amdgcn_sched_barrier(0); }
    }
};
namespace att {
constexpr int NW = 8, QBLK = 32, KVBLK = 64;
constexpr float SCALE = 0.125f;
constexpr float THR = 8.f;
constexpr int SHM_V = KVBLK * 128 * 2, SHM_K = KVBLK * 64 * 2, SHM_ATTN = 2 * SHM_V + 2 * SHM_K + NW * 64 * 4;
#define KSWZ64(row, colB) ((row) * 128 + ((colB) ^ (((row) & 7) << 4)))
#ifndef ATT_FIXMAX
#define ATT_FIXMAX 1
#endif
#ifndef ATT_NOSBAR
#define ATT_NOSBAR 0
#endif
#if ATT_NOSBAR
#define SBAR() do {} while (0)
#else
#define SBAR() __builtin_amdgcn_sched_barrier(0)
#endif
template <bool NOEXP = false, bool NOMAX = false>
__device__ __forceinline__ void partialSM(f32x16& p0, f32x16& p1, float& m_reg, float& mn, float& alpha) {
  constexpr float C = SCALE * 1.4426950408889634f;
  if (NOMAX) { mn = m_reg; alpha = 1.f; } else {
  float pm4[4];
#pragma unroll
  for (int k = 0; k < 4; ++k) pm4[k] = fmaxf(fmaxf(p0[k], p0[4 + k]), fmaxf(p0[8 + k], p0[12 + k]));
#pragma unroll
  for (int k = 0; k < 4; ++k) pm4[k] = fmaxf(pm4[k], fmaxf(fmaxf(p1[k], p1[4 + k]), fmaxf(p1[8 + k], p1[12 + k])));
  float pmax = fmaxf(fmaxf(pm4[0], pm4[1]), fmaxf(pm4[2], pm4[3]));
  { auto rr = __builtin_amdgcn_permlane32_swap(__float_as_uint(pmax), __float_as_uint(pmax), false, false);
    pmax = fmaxf(__uint_as_float(rr[0]), __uint_as_float(rr[1])); }
  if (__builtin_expect(__all(pmax - m_reg <= THR / SCALE), 1)) { mn = m_reg; alpha = 1.f; }
  else { mn = fmaxf(m_reg, pmax); alpha = __builtin_amdgcn_exp2f((m_reg - mn) * C); m_reg = mn; }
  }
  float mnC = -mn * C;
#pragma unroll
  for (int r = 0; r < 16; ++r) p0[r] = fmaf(p0[r], C, mnC);
#pragma unroll
  for (int r = 0; r < 16; ++r) p1[r] = fmaf(p1[r], C, mnC);
#pragma unroll
  for (int r = 0; r < 16; ++r) p0[r] = NOEXP ? p0[r] : __builtin_amdgcn_exp2f(p0[r]);
}
template <bool NOEXP = false>
__device__ __forceinline__ void finishSM(f32x16& p0, f32x16& p1, float alpha, float& l_reg, bf16x8& pa0, bf16x8& pa1, bf16x8& pa2, bf16x8& pa3) {
#pragma unroll
  for (int r = 0; r < 16; ++r) p1[r] = NOEXP ? p1[r] : __builtin_amdgcn_exp2f(p1[r]);
  float ps4[4];
#pragma unroll
  for (int k = 0; k < 4; ++k) ps4[k] = (p0[k] + p0[4 + k]) + (p0[8 + k] + p0[12 + k]);
#pragma unroll
  for (int k = 0; k < 4; ++k) ps4[k] += (p1[k] + p1[4 + k]) + (p1[8 + k] + p1[12 + k]);
  float ps = (ps4[0] + ps4[1]) + (ps4[2] + ps4[3]);
  { auto rr = __builtin_amdgcn_permlane32_swap(__float_as_uint(ps), __float_as_uint(ps), false, false);
    ps = __uint_as_float(rr[0]) + __uint_as_float(rr[1]); }
  l_reg = l_reg * alpha + ps;
#define PK4(P, BASE, OUT) do { unsigned a0 = cvtpk(P[BASE + 0], P[BASE + 1]), a1 = cvtpk(P[BASE + 2], P[BASE + 3]);   \
    unsigned b0 = cvtpk(P[BASE + 4], P[BASE + 5]), b1 = cvtpk(P[BASE + 6], P[BASE + 7]);                              \
    auto r0 = __builtin_amdgcn_permlane32_swap(a0, b0, false, false); auto r1 = __builtin_amdgcn_permlane32_swap(a1, b1, false, false); \
    u32x4 w = {r0[0], r1[0], r0[1], r1[1]}; OUT = *reinterpret_cast<bf16x8*>(&w); } while (0)
  PK4(p0, 0, pa0); PK4(p0, 8, pa1); PK4(p1, 0, pa2); PK4(p1, 8, pa3);
#undef PK4
}
__device__ __forceinline__ void qkt(f32x16& p0, f32x16& p1, const LAS char* Ks, const bf16x8* qr, int r32, int hi) {
  p0 = f32x16{}; p1 = f32x16{};
#pragma unroll
  for (int d0 = 0; d0 < 4; ++d0) { int cb = (d0 * 16 + hi * 8) * 2;
    bf16x8 b0 = *(const LAS bf16x8*)(Ks + KSWZ64(r32, cb));
    bf16x8 b1 = *(const LAS bf16x8*)(Ks + KSWZ64(32 + r32, cb));
    p0 = __builtin_amdgcn_mfma_f32_32x32x16_bf16(b0, qr[d0], p0, 0, 0, 0);
    p1 = __builtin_amdgcn_mfma_f32_32x32x16_bf16(b1, qr[d0], p1, 0, 0, 0); }
}
__device__ __forceinline__ int v_st(int k, int c) { const int kk = (k & ~0xC) | ((k & 4) << 1) | ((k & 8) >> 1); return ((kk >> 3) * 4 + (c >> 5)) * 512 + ((kk & 7) * 32 + (c & 31)) * 2; }
__device__ __forceinline__ int v_rd_base(int lane) { return ((lane & 3) << 3) | (((lane >> 2) & 3) << 6) | (((lane >> 4) & 1) << 5) | (((lane >> 5) & 1) << 8); }
constexpr int v_rd_off(int d0, int ks, int half) { return d0 * 512 + ks * 4096 + half * 2048; }
template <int OFF> __device__ __forceinline__ s16x4 tr_read(int vb) {
  s16x4 r; asm volatile("ds_read_b64_tr_b16 %0, %1 offset:%2" : "=&v"(r) : "v"(vb), "i"(OFF) : "memory"); return r;
}
template <int D0> __device__ __forceinline__ void pv_one(f32x16& od, int vb, bf16x8 pa0, bf16x8 pa1, bf16x8 pa2, bf16x8 pa3) {
  const s16x4 l0 = tr_read<v_rd_off(D0, 0, 0)>(vb), h0 = tr_read<v_rd_off(D0, 0, 1)>(vb), l1 = tr_read<v_rd_off(D0, 1, 0)>(vb), h1 = tr_read<v_rd_off(D0, 1, 1)>(vb);
  const s16x4 l2 = tr_read<v_rd_off(D0, 2, 0)>(vb), h2 = tr_read<v_rd_off(D0, 2, 1)>(vb), l3 = tr_read<v_rd_off(D0, 3, 0)>(vb), h3 = tr_read<v_rd_off(D0, 3, 1)>(vb);
  asm volatile("s_waitcnt lgkmcnt(0)" ::: "memory"); SBAR();
#define PK(L, H) (bf16x8){L[0], L[1], L[2], L[3], H[0], H[1], H[2], H[3]}
  od = __builtin_amdgcn_mfma_f32_32x32x16_bf16(pa0, PK(l0, h0), od, 0, 0, 0);
  od = __builtin_amdgcn_mfma_f32_32x32x16_bf16(pa1, PK(l1, h1), od, 0, 0, 0);
  od = __builtin_amdgcn_mfma_f32_32x32x16_bf16(pa2, PK(l2, h2), od, 0, 0, 0);
  od = __builtin_amdgcn_mfma_f32_32x32x16_bf16(pa3, PK(l3, h3), od, 0, 0, 0);
#undef PK
}
__device__ __forceinline__ void pv_d0(f32x16* o, int vb, bf16x8 pa0, bf16x8 pa1, bf16x8 pa2, bf16x8 pa3) {
  pv_one<0>(o[0], vb, pa0, pa1, pa2, pa3); pv_one<1>(o[1], vb, pa0, pa1, pa2, pa3); pv_one<2>(o[2], vb, pa0, pa1, pa2, pa3); pv_one<3>(o[3], vb, pa0, pa1, pa2, pa3);
}
__device__ __forceinline__ void attn_unit(const u16* __restrict__ Q, const u16* __restrict__ K, const u16* __restrict__ V, u16* __restrict__ On,
                                          int qrow0, int b, int h, int map, int NT, LAS char* lds) {
  int tid_ = threadIdx.x; asm volatile("" : "+v"(tid_));
  const int tid = tid_, wid = tid >> 6, lane = tid & 63, r32 = lane & 31, hi = lane >> 5;
  LAS char* V_lds = lds; LAS char* K_lds = lds + 2 * SHM_V;
  LAS float* ws = (LAS float*)(lds + 2 * SHM_V + 2 * SHM_K) + wid * 64; LAS float* li_l = ws; LAS float* al_l = ws + 32;
  float m_reg = -1e30f, l_reg = 0; f32x16 o[4] = {}; bf16x8 qr[4];
  const u16* Qw = Q + (size_t)(qrow0 + wid * QBLK + r32) * 512 + h * 128 + map * 64 + hi * 8;
#pragma unroll
  for (int d0 = 0; d0 < 4; ++d0) qr[d0] = *reinterpret_cast<const bf16x8*>(Qw + d0 * 16);
  const int sr = tid >> 4, sc = (tid & 15) * 8, vst0 = v_st(sr, sc), vst1 = v_st(32 + sr, sc);
  const int kr = tid >> 3, kc = (tid & 7) * 8, kst = KSWZ64(kr, kc * 2);
  const int vb0 = (int)(uintptr_t)V_lds + v_rd_base(lane);
  const u16* Kc = K + h * 128 + map * 64 + kc; const u16* Vc = V + h * 128 + sc;
  struct { bf16x8 vs0, vs1, ks0; } sr_[2];
#define KROW(k0) ((k0) < LC ? b * LC + (k0) : TC + b * SEQ + (k0) - LC)
#define SLOAD(i, k0) do { const size_t _r = (size_t)KROW(k0); sr_[i].vs0 = *reinterpret_cast<const bf16x8*>(Vc + (_r + sr) * 512); sr_[i].vs1 = *reinterpret_cast<const bf16x8*>(Vc + (_r + 32 + sr) * 512); \
    sr_[i].ks0 = *reinterpret_cast<const bf16x8*>(Kc + (_r + kr) * 512); } while (0)
#define SWRITE(bb, i) do { *(LAS bf16x8*)(V_lds + (bb) * SHM_V + vst0) = sr_[i].vs0; *(LAS bf16x8*)(V_lds + (bb) * SHM_V + vst1) = sr_[i].vs1; \
    *(LAS bf16x8*)(K_lds + (bb) * SHM_K + kst) = sr_[i].ks0; } while (0)
#define SWAIT() asm volatile("s_waitcnt vmcnt(3)" ::: "memory")
#define RESC(a) do { if (__any((a) < 1.f)) { if (hi == 0) al_l[r32] = (a); asm volatile("s_waitcnt lgkmcnt(0)" ::: "memory"); \
    _Pragma("unroll") for (int d = 0; d < 4; ++d) _Pragma("unroll") for (int r = 0; r < 16; ++r) o[d][r] *= al_l[crow(r, hi)]; } } while (0)
  f32x16 pA0, pA1, pB0, pB1; float mnA, mnB, alA, alB; bf16x8 pa0, pa1, pa2, pa3;
  constexpr int SE = 0, SO = 1;
  SLOAD(SE, 0); asm volatile("s_waitcnt vmcnt(0)" ::: "memory"); SWRITE(0, SE); __syncthreads();
  qkt(pA0, pA1, K_lds, qr, r32, hi); partialSM(pA0, pA1, m_reg, mnA, alA);
  SLOAD(SO, KVBLK); if (2 < NT) SLOAD(SE, 2 * KVBLK);
  SWAIT(); SWRITE(1, SO); __syncthreads();
  for (int j = 1; j + 1 < NT; j += 2) {
    SBAR(); qkt(pB0, pB1, K_lds + SHM_K, qr, r32, hi);
    finishSM(pA0, pA1, alA, l_reg, pa0, pa1, pa2, pa3); SBAR();
    SLOAD(SO, (j + 2) * KVBLK); SBAR();
    pv_d0(o, vb0, pa0, pa1, pa2, pa3); partialSM(pB0, pB1, m_reg, mnB, alB);
    __syncthreads(); SWAIT(); SWRITE(0, SE);
    RESC(alB); __syncthreads();
    SBAR(); qkt(pA0, pA1, K_lds, qr, r32, hi);
    finishSM(pB0, pB1, alB, l_reg, pa0, pa1, pa2, pa3); SBAR();
    if (j + 3 < NT) SLOAD(SE, (j + 3) * KVBLK); SBAR();
    pv_d0(o, vb0 + SHM_V, pa0, pa1, pa2, pa3); partialSM(pA0, pA1, m_reg, mnA, alA);
    __syncthreads(); SWAIT(); SWRITE(1, SO);
    RESC(alA); __syncthreads();
  }
  SBAR(); qkt(pB0, pB1, K_lds + SHM_K, qr, r32, hi);
  finishSM(pA0, pA1, alA, l_reg, pa0, pa1, pa2, pa3); SBAR();
  pv_d0(o, vb0, pa0, pa1, pa2, pa3); partialSM(pB0, pB1, m_reg, mnB, alB);
  __syncthreads(); RESC(alB);
  finishSM(pB0, pB1, alB, l_reg, pa0, pa1, pa2, pa3); SBAR();
  pv_d0(o, vb0 + SHM_V, pa0, pa1, pa2, pa3);
  if (hi == 0) li_l[r32] = l_reg; asm volatile("s_waitcnt lgkmcnt(0)" ::: "memory");
  float rli[16];
#pragma unroll
  for (int r = 0; r < 16; ++r) rli[r] = __builtin_amdgcn_rcpf(li_l[crow(r, hi)]);
  u16* Ow = On + (size_t)(qrow0 + wid * QBLK) * 512 + h * 128;
#pragma unroll
  for (int r = 0; r < 16; ++r) { int orow = crow(r, hi);
#pragma unroll
    for (int d0 = 0; d0 < 4; ++d0) Ow[(size_t)orow * 512 + d0 * 32 + r32] = f2bf(o[d0][r] * rli[r]); }
  __syncthreads();
#undef KROW
#undef SLOAD
#undef SWRITE
#undef SWAIT
#undef RESC
}
template <int AD = 0>
__device__ __forceinline__ void attn_unit_dma(const u16* __restrict__ Q, const u16* __restrict__ K, const u16* __restrict__ V, u16* __restrict__ On,
                                              int qrow0, int b, int h, int map, int NT, LAS char* lds) {
  int tid_ = threadIdx.x; asm volatile("" : "+v"(tid_));
  const int tid = tid_, wid = __builtin_amdgcn_readfirstlane(tid >> 6), lane = tid & 63, r32 = lane & 31, hi = lane >> 5;
  LAS char* V_lds = lds; LAS char* K_lds = lds + 4 * SHM_V;
  LAS float* ws = (LAS float*)(lds + 4 * SHM_V + 4 * SHM_K) + wid * 64; LAS float* li_l = ws; LAS float* al_l = ws + 32;
  float m_reg = -1e30f, l_reg = 0; f32x16 o[4] = {}; bf16x8 qr[4];
  const u16* Qw = Q + (size_t)(qrow0 + wid * QBLK + r32) * 512 + h * 128 + map * 64 + hi * 8;
#pragma unroll
  for (int d0 = 0; d0 < 4; ++d0) qr[d0] = *reinterpret_cast<const bf16x8*>(Qw + d0 * 16);
  const int vb0 = (int)(uintptr_t)V_lds + v_rd_base(lane);
  unsigned vsrc[2], ksrc;
#pragma unroll
  for (int i = 0; i < 2; ++i) { const int B = (tid + 512 * i) * 16, st = B >> 9, off = B & 511, kk = (st >> 2) * 8 + (off >> 6), c = (st & 3) * 32 + ((off & 63) >> 1);
    const int k = (kk & ~0xC) | ((kk & 4) << 1) | ((kk & 8) >> 1);
    vsrc[i] = (unsigned)(k * 512 + h * 128 + c); }
  { const int row = tid >> 3, colB = ((tid & 7) * 16) ^ ((row & 7) << 4); ksrc = (unsigned)(row * 512 + h * 128 + map * 64 + (colB >> 1)); }
#define KROW(k0) ((k0) < LC ? b * LC + (k0) : TC + b * SEQ + (k0) - LC)
#define DMA_TILE(t) do { const size_t _r = (size_t)KROW((t) * KVBLK) * 512; const int _s = (t) & 3; \
    __builtin_amdgcn_global_load_lds((const unsigned*)(V + _r + vsrc[0]), (LAS unsigned*)(V_lds + _s * SHM_V + wid * 1024), 16, 0, 0); \
    __builtin_amdgcn_global_load_lds((const unsigned*)(V + _r + vsrc[1]), (LAS unsigned*)(V_lds + _s * SHM_V + 8192 + wid * 1024), 16, 0, 0); \
    __builtin_amdgcn_global_load_lds((const unsigned*)(K + _r + ksrc), (LAS unsigned*)(K_lds + _s * SHM_K + wid * 1024), 16, 0, 0); } while (0)
#define TILE_READY(t) do { if ((t) + 1 < NT) asm volatile("s_waitcnt vmcnt(3)" ::: "memory"); else asm volatile("s_waitcnt vmcnt(0)" ::: "memory"); \
    __builtin_amdgcn_s_barrier(); asm volatile("" ::: "memory"); } while (0)
#define RESC(a) do { if (__any((a) < 1.f)) { if (hi == 0) al_l[r32] = (a); asm volatile("s_waitcnt lgkmcnt(0)" ::: "memory"); \
    _Pragma("unroll") for (int d = 0; d < 4; ++d) _Pragma("unroll") for (int r = 0; r < 16; ++r) o[d][r] *= al_l[crow(r, hi)]; } } while (0)
  f32x16 pA0 = {}, pA1 = {}, pB0 = {}, pB1 = {}; float mnA = 0.f, mnB = 0.f, alA = 1.f, alB = 1.f; bf16x8 pa0 = {}, pa1 = {}, pa2 = {}, pa3 = {};
  DMA_TILE(0); DMA_TILE(1); DMA_TILE(2);
  asm volatile("s_waitcnt vmcnt(6)" ::: "memory"); __builtin_amdgcn_s_barrier(); asm volatile("" ::: "memory");
  if (AD != 4) qkt(pA0, pA1, K_lds, qr, r32, hi); if (AD != 5) partialSM<AD == 2>(pA0, pA1, m_reg, mnA, alA);
  TILE_READY(1); DMA_TILE(3);
  for (int j = 1; j + 1 < NT; j += 2) {
    SBAR(); if (AD != 4) qkt(pB0, pB1, K_lds + (j & 3) * SHM_K, qr, r32, hi);
    if (AD != 5) finishSM<AD == 2>(pA0, pA1, alA, l_reg, pa0, pa1, pa2, pa3); SBAR();
    if (AD != 3) pv_d0(o, vb0 + ((j - 1) & 3) * SHM_V, pa0, pa1, pa2, pa3); if (AD != 5) partialSM<AD == 2, ATT_FIXMAX != 0>(pB0, pB1, m_reg, mnB, alB);
    TILE_READY(j + 1); if (j + 3 < NT) DMA_TILE(j + 3);
    if (!ATT_FIXMAX) RESC(alB);
    SBAR(); if (AD != 4) qkt(pA0, pA1, K_lds + ((j + 1) & 3) * SHM_K, qr, r32, hi);
    if (AD != 5) finishSM<AD == 2>(pB0, pB1, alB, l_reg, pa0, pa1, pa2, pa3); SBAR();
    if (AD != 3) pv_d0(o, vb0 + (j & 3) * SHM_V, pa0, pa1, pa2, pa3); if (AD != 5) partialSM<AD == 2, ATT_FIXMAX != 0>(pA0, pA1, m_reg, mnA, alA);
    TILE_READY(j + 2); if (j + 4 < NT) DMA_TILE(j + 4);
    if (!ATT_FIXMAX) RESC(alA);
  }
  SBAR(); if (AD != 4) qkt(pB0, pB1, K_lds + ((NT - 1) & 3) * SHM_K, qr, r32, hi);
  if (AD != 5) finishSM<AD == 2>(pA0, pA1, alA, l_reg, pa0, pa1, pa2, pa3); SBAR();
  if (AD != 3) pv_d0(o, vb0 + ((NT - 2) & 3) * SHM_V, pa0, pa1, pa2, pa3); if (AD != 5) partialSM<AD == 2, ATT_FIXMAX != 0>(pB0, pB1, m_reg, mnB, alB);
  if (!ATT_FIXMAX) RESC(alB);
  if (AD != 5) finishSM<AD == 2>(pB0, pB1, alB, l_reg, pa0, pa1, pa2, pa3); SBAR();
  if (AD != 3) pv_d0(o, vb0 + ((NT - 1) & 3) * SHM_V, pa0, pa1, pa2, pa3);
  if (hi == 0) li_l[r32] = l_reg; asm volatile("s_waitcnt lgkmcnt(0)" ::: "memory");
  float rli[16];
#pragma unroll
  for (int r = 0; r < 16; ++r) rli[r] = __builtin_amdgcn_rcpf(li_l[crow(r, hi)]);
  u16* Ow = On + (size_t)(qrow0 + wid * QBLK) * 512 + h * 128;
#pragma unroll
  for (int r = 0; r < 16; ++r) { int orow = crow(r, hi);
#pragma unroll
    for (int d0 = 0; d0 < 4; ++d0) Ow[(size_t)orow * 512 + d0 * 32 + r32] = f2bf(o[d0][r] * rli[r]); }
  __syncthreads();
#undef KROW
#undef DMA_TILE
#undef TILE_READY
#undef RESC
}
}

namespace hg {
constexpr int RS = 136, RS2 = 72;
constexpr int O_QH = 0, O_KH = 17408, O_KB = 35840, O_QQ = 48896, O_QD = 75008, O_KD = 92416, O_VT = 109824, O_PP = 119040, O_ST = 128256, O_TOT = 145664, O_DEC = 153856, O_END = 154368;
__device__ __forceinline__ void h4(const u32x2& w, float (&f)[4]) {
    f[0] = (float)__builtin_bit_cast(_Float16, (u16)(w[0] & 0xffffu)); f[1] = (float)__builtin_bit_cast(_Float16, (u16)(w[0] >> 16));
    f[2] = (float)__builtin_bit_cast(_Float16, (u16)(w[1] & 0xffffu)); f[3] = (float)__builtin_bit_cast(_Float16, (u16)(w[1] >> 16));
}
__device__ __forceinline__ void b4(const u32x2& w, float (&f)[4]) { f[0] = bf2f(w[0] & 0xffffu); f[1] = bf2f(w[0] >> 16); f[2] = bf2f(w[1] & 0xffffu); f[3] = bf2f(w[1] >> 16); }
__device__ __forceinline__ u32x2 pk4(float a, float b, float c, float d) { u32x2 w = {cvtpk(a, b), cvtpk(c, d)}; return w; }
template <int HD = 0>
__device__ __forceinline__ void hgrn_unit(unsigned char* ws, LAS unsigned char* lds, int layer, int b, int h, int dir, int eh) {
    int tid_ = threadIdx.x; asm volatile("" : "+v"(tid_));
    const int tid = tid_, wid = __builtin_amdgcn_readfirstlane(tid >> 6), lane = tid & 63;
    const u16* QHg = (const u16*)(ws + WS_P0);
    const u16* LFg = (const u16*)(ws + (dir ? WS_P2 : WS_P1));
    const u16* VVg = (const u16*)(ws + WS_P3);
    u16* OOg = (u16*)(ws + (HD ? WS_TT : (dir ? WS_OB : WS_OF)));
    LAS u16* sQH = (LAS u16*)(lds + O_QH); LAS u16* sKH = (LAS u16*)(lds + O_KH); LAS u16* sKB = (LAS u16*)(lds + O_KB); LAS u16* sQQ = (LAS u16*)(lds + O_QQ);
    LAS u16* sQD = (LAS u16*)(lds + O_QD); LAS u16* sKD = (LAS u16*)(lds + O_KD); LAS u16* sVT = (LAS u16*)(lds + O_VT); LAS u16* sPP = (LAS u16*)(lds + O_PP);
    LAS u16* sST = (LAS u16*)(lds + O_ST); LAS float* sTOT = (LAS float*)(lds + O_TOT); LAS float* sDEC = (LAS float*)(lds + O_DEC);
    for (int i = tid; i < (O_TOT - O_PP) / 4; i += 512) ((LAS unsigned*)(lds + O_PP))[i] = 0u;
    f32x16 S = {};
    __syncthreads();
    const int cq = tid & 31, rg = tid >> 5, d0 = 4 * cq, sb = rg >> 2;
    const int e4 = tid & 15, s2 = tid >> 4;
    const int l15 = lane & 15, q4 = lane >> 4, l32 = lane & 31, hi = lane >> 5;
    const int dt = wid >> 1, et = wid & 1;
    u32x2 pg[4], pq[4], pv[2];
#define HG_LOAD(c_) do { const bool ic_ = (c_) < 4; const int cc_ = ic_ ? (c_) : (c_) - 4, ls_ = ic_ ? LC : SEQ, rb_ = ic_ ? b * LC : TC + b * SEQ; \
        _Pragma("unroll") for (int r = 0; r < 4; ++r) { int pos = 64 * cc_ + 4 * rg + r; if (dir) pos = ls_ - 1 - pos; const size_t row = (size_t)(rb_ + pos); \
            pg[r] = *(const u32x2*)(LFg + row * 512 + h * 128 + d0); pq[r] = *(const u32x2*)(QHg + row * 512 + h * 128 + d0); } \
        _Pragma("unroll") for (int r = 0; r < 2; ++r) { int pos = 64 * cc_ + 2 * s2 + r; if (dir) pos = ls_ - 1 - pos; \
            pv[r] = *(const u32x2*)(VVg + (size_t)(rb_ + pos) * 512 + h * 128 + eh * 64 + 4 * e4); } } while (0)
    HG_LOAD(0);
    for (int c = 0; c < 36; ++c) {
        const bool isctx = c < 4; const int cc = isctx ? c : c - 4, lseg = isctx ? LC : SEQ, rowbase = isctx ? b * LC : TC + b * SEQ;
        const bool need_o = !(layer == DEPTH - 1 && isctx);
        float g[4][4], q[4][4], bl[4][4];
#pragma unroll
        for (int r = 0; r < 4; ++r) { h4(pg[r], g[r]); b4(pq[r], q[r]); }
#pragma unroll
        for (int cl = 0; cl < 4; ++cl) { float run = 0.f;
#pragma unroll
            for (int r = 0; r < 4; ++r) { run += g[r][cl]; bl[r][cl] = run; } }
        *(LAS f32x4*)(sTOT + rg * 128 + d0) = (f32x4){bl[3][0], bl[3][1], bl[3][2], bl[3][3]};
        const u32x2 v0 = pv[0], v1 = pv[1];
        __syncthreads();
        if (c > 0) {
#pragma unroll
            for (int rg4 = 0; rg4 < 4; ++rg4) { u32x2 w = {cvtpk(S[4 * rg4], S[4 * rg4 + 1]), cvtpk(S[4 * rg4 + 2], S[4 * rg4 + 3])};
                *(LAS u32x2*)(sST + (32 * et + l32) * RS + 32 * dt + 8 * rg4 + 4 * hi) = w; }
        }
#define EXPF(x) (HD == 2 ? (x) : __expf(x))
        if (HD != 4) {
            f32x4 acc4 = {0.f, 0.f, 0.f, 0.f}, P = acc4, br_i = acc4, bm_i = acc4, br_n = acc4, c3 = acc4, c7 = acc4, c11 = acc4;
#pragma unroll
            for (int rr = 0; rr < 16; ++rr) {
                if (rr == rg) P = acc4;
                if (rr == 4 * sb) br_i = acc4;
                acc4 += *(const LAS f32x4*)(sTOT + rr * 128 + d0);
                if (rr == 4 * sb + 1) bm_i = acc4;
                if (rr == 4 * sb + 3) br_n = acc4;
                if (rr == 3) c3 = acc4;
                if (rr == 7) c7 = acc4;
                if (rr == 11) c11 = acc4;
            }
            const f32x4 bend = acc4;
            if (rg == 0) { f32x4 dv;
#pragma unroll
                for (int cl = 0; cl < 4; ++cl) dv[cl] = EXPF(bend[cl]);
                *(LAS f32x4*)(sDEC + d0) = dv; }
            float cP[4], cE[4], cq0[4], cq1[4], cq2[4], pr[4], wn[4], wm[4];
#pragma unroll
            for (int cl = 0; cl < 4; ++cl) { cP[cl] = EXPF(br_i[cl]); cE[cl] = EXPF(bend[cl] - br_n[cl]);
                cq0[cl] = EXPF(br_i[cl] - c3[cl]); cq1[cl] = EXPF(br_i[cl] - c7[cl]); cq2[cl] = EXPF(br_i[cl] - c11[cl]);
                pr[cl] = P[cl] - br_i[cl]; wn[cl] = br_n[cl] - br_i[cl]; wm[cl] = bm_i[cl] - br_i[cl]; }
            const int pbase = sb * (sb - 1) / 2;
            float kh[4][4];
#pragma unroll
            for (int r = 0; r < 4; ++r) { const int t = 4 * rg + r, tk = t & 15;
                float vq[4], vk[4], vkb[4], vqq0[4], vqq1[4], vqq2[4], vqd[4], vkd[4];
#pragma unroll
                for (int cl = 0; cl < 4; ++cl) { const float brel = pr[cl] + bl[r][cl];
                    const float e1 = EXPF(brel), e2 = EXPF(wn[cl] - brel), kk = 1.f - EXPF(g[r][cl]);
                    const float qe = q[r][cl] * e1, ke = kk * e2, dm = brel - wm[cl];
                    vq[cl] = qe * cP[cl]; kh[r][cl] = ke * cE[cl]; vkb[cl] = ke;
                    vqq0[cl] = qe * cq0[cl]; vqq1[cl] = qe * cq1[cl]; vqq2[cl] = qe * cq2[cl];
                    vqd[cl] = q[r][cl] * EXPF(dm); vkd[cl] = kk * EXPF(-dm); }
                *(LAS u32x2*)(sQH + t * RS + d0) = pk4(vq[0], vq[1], vq[2], vq[3]);
                if (sb < 3) *(LAS u32x2*)(sKB + t * RS + d0) = pk4(vkb[0], vkb[1], vkb[2], vkb[3]);
                if (sb >= 1) *(LAS u32x2*)(sQQ + ((pbase + 0) * 16 + tk) * RS + d0) = pk4(vqq0[0], vqq0[1], vqq0[2], vqq0[3]);
                if (sb >= 2) *(LAS u32x2*)(sQQ + ((pbase + 1) * 16 + tk) * RS + d0) = pk4(vqq1[0], vqq1[1], vqq1[2], vqq1[3]);
                if (sb >= 3) *(LAS u32x2*)(sQQ + ((pbase + 2) * 16 + tk) * RS + d0) = pk4(vqq2[0], vqq2[1], vqq2[2], vqq2[3]);
                *(LAS u32x2*)(sQD + t * RS + d0) = pk4(vqd[0], vqd[1], vqd[2], vqd[3]);
                *(LAS u32x2*)(sKD + t * RS + d0) = pk4(vkd[0], vkd[1], vkd[2], vkd[3]); }
#pragma unroll
            for (int cl = 0; cl < 4; ++cl) *(LAS u32x2*)(sKH + (d0 + cl) * RS2 + 4 * rg) = pk4(kh[0][cl], kh[1][cl], kh[2][cl], kh[3][cl]);
            *(LAS unsigned*)(sVT + (4 * e4 + 0) * RS2 + 2 * s2) = (v0[0] & 0xffffu) | (v1[0] << 16);
            *(LAS unsigned*)(sVT + (4 * e4 + 1) * RS2 + 2 * s2) = (v0[0] >> 16) | (v1[0] & 0xffff0000u);
            *(LAS unsigned*)(sVT + (4 * e4 + 2) * RS2 + 2 * s2) = (v0[1] & 0xffffu) | (v1[1] << 16);
            *(LAS unsigned*)(sVT + (4 * e4 + 3) * RS2 + 2 * s2) = (v0[1] >> 16) | (v1[1] & 0xffff0000u);
        }
        if (c + 1 < 36) HG_LOAD(c + 1);
        __syncthreads();
        if (need_o && HD != 3) {
            for (int bi = wid; bi < 10; bi += 8) {
                int i, j, p = 0;
                if (bi < 4) { i = bi; j = bi; } else { p = bi - 4; i = p < 1 ? 1 : (p < 3 ? 2 : 3); j = p - i * (i - 1) / 2; }
                const LAS u16* Ab = (i == j ? sQD + (16 * i + l15) * RS : sQQ + (p * 16 + l15) * RS) + 8 * q4;
                const LAS u16* Bb = (i == j ? sKD + (16 * i + l15) * RS : sKB + (16 * j + l15) * RS) + 8 * q4;
                f32x4 acc = {0.f, 0.f, 0.f, 0.f};
#pragma unroll
                for (int ks = 0; ks < 4; ++ks) acc = __builtin_amdgcn_mfma_f32_16x16x32_bf16(*(const LAS bf16x8*)(Ab + ks * 32), *(const LAS bf16x8*)(Bb + ks * 32), acc, 0, 0, 0);
#pragma unroll
                for (int r = 0; r < 4; ++r) { const int t = 4 * q4 + r; float v = acc[r]; if (i == j && l15 > t) v = 0.f; sPP[(16 * i + t) * RS2 + 16 * j + l15] = f2bf(v); }
            }
        }
        if (HD != 3) {
#pragma unroll
            for (int r = 0; r < 16; ++r) S[r] *= sDEC[32 * dt + crow(r, hi)];
#pragma unroll
            for (int ks = 0; ks < 4; ++ks)
                S = __builtin_amdgcn_mfma_f32_32x32x16_bf16(*(const LAS bf16x8*)(sKH + (32 * dt + l32) * RS2 + ks * 16 + 8 * hi), *(const LAS bf16x8*)(sVT + (32 * et + l32) * RS2 + ks * 16 + 8 * hi), S, 0, 0, 0);
        }
        __syncthreads();
        if (need_o && HD != 3) {
            const int tt = wid >> 1;
#pragma unroll
            for (int e2i = 0; e2i < 2; ++e2i) { const int et2 = (wid & 1) * 2 + e2i;
                f32x4 acc = {0.f, 0.f, 0.f, 0.f};
#pragma unroll
                for (int ks = 0; ks < 2; ++ks) acc = __builtin_amdgcn_mfma_f32_16x16x32_bf16(*(const LAS bf16x8*)(sVT + (16 * et2 + l15) * RS2 + ks * 32 + 8 * q4), *(const LAS bf16x8*)(sPP + (16 * tt + l15) * RS2 + ks * 32 + 8 * q4), acc, 0, 0, 0);
#pragma unroll
                for (int ks = 0; ks < 4; ++ks) acc = __builtin_amdgcn_mfma_f32_16x16x32_bf16(*(const LAS bf16x8*)(sST + (16 * et2 + l15) * RS + ks * 32 + 8 * q4), *(const LAS bf16x8*)(sQH + (16 * tt + l15) * RS + ks * 32 + 8 * q4), acc, 0, 0, 0);
                { int pos = 64 * cc + 16 * tt + l15; if (dir) pos = lseg - 1 - pos;
                  *(u32x2*)(OOg + (size_t)(rowbase + pos) * 512 + h * 128 + eh * 64 + 16 * et2 + 4 * q4) = pk4(acc[0], acc[1], acc[2], acc[3]); }
            }
        }
    }
#undef HG_LOAD
    __syncthreads();
}
}

__device__ __forceinline__ void ln_stats(const f32x4 (&x)[4], float& mu, float& rstd) {
    float s = 0.f;
#pragma unroll
    for (int j = 0; j < 4; ++j) s += (x[j][0] + x[j][1]) + (x[j][2] + x[j][3]);
    mu = wsum(s) * (1.f / 1024.f);
    float v = 0.f;
#pragma unroll
    for (int j = 0; j < 4; ++j) { const f32x4 dd = x[j] - mu; v += (dd[0] * dd[0] + dd[1] * dd[1]) + (dd[2] * dd[2] + dd[3] * dd[3]); }
    rstd = rsqrtf(wsum(v) * (1.f / 1024.f) + LN_EPS);
}
template <bool FIRST_LN>
__device__ __forceinline__ void ln_phase(const Frame& F, int r0, const float* src_c, const float* src_l, float* dst_c, float* dst_l,
                                         const float* lng, const float* lnb, bool do_mod, const float* modl, int ch_shift, int ch_scale) {
    u16* H = (u16*)(F.ws + WS_H);
    constexpr int NR = 4;
    for (int row0 = r0 + (F.blk * 8 + F.wave) * NR; row0 < TT; row0 += F.G * 8 * NR) {
        f32x4 x[NR][4];
#pragma unroll
        for (int k = 0; k < NR; ++k) { const int row = row0 + k; const float* sp = row < TC ? src_c + (size_t)row * 1024 : src_l + (size_t)(row - TC) * 1024;
#pragma unroll
            for (int j = 0; j < 4; ++j) x[k][j] = *(const f32x4*)(sp + j * 256 + F.lane * 4); }
        const int mi = row0 < TC ? 16 : ((row0 - TC) >> 11);
        if (FIRST_LN) {
            f32x4 gg[4], bb[4];
#pragma unroll
            for (int j = 0; j < 4; ++j) { gg[j] = *(const f32x4*)(lng + j * 256 + F.lane * 4); bb[j] = *(const f32x4*)(lnb + j * 256 + F.lane * 4); }
#pragma unroll
            for (int k = 0; k < NR; ++k) { const int row = row0 + k; float mu, rstd; ln_stats(x[k], mu, rstd);
                float* dp = row < TC ? dst_c + (size_t)row * 1024 : dst_l + (size_t)(row - TC) * 1024;
#pragma unroll
                for (int j = 0; j < 4; ++j) { x[k][j] = (x[k][j] - mu) * rstd * gg[j] + bb[j]; *(f32x4*)(dp + j * 256 + F.lane * 4) = x[k][j]; } }
        }
        if (do_mod) {
            const float* mp = modl + (size_t)mi * 6144;
            f32x4 sh[4], sc[4];
#pragma unroll
            for (int j = 0; j < 4; ++j) { sh[j] = *(const f32x4*)(mp + ch_shift * 1024 + j * 256 + F.lane * 4); sc[j] = *(const f32x4*)(mp + ch_scale * 1024 + j * 256 + F.lane * 4) + 1.f; }
#pragma unroll
            for (int k = 0; k < NR; ++k) { const int row = row0 + k; float mu, rstd; ln_stats(x[k], mu, rstd);
#pragma unroll
                for (int j = 0; j < 4; ++j) { const f32x4 hv = (x[k][j] - mu) * rstd * sc[j] + sh[j];
                    u32x2 w = {cvtpk(hv[0], hv[1]), cvtpk(hv[2], hv[3])};
                    *(u32x2*)(H + (size_t)row * 1024 + j * 256 + F.lane * 4) = w; } }
        }
    }
}

__device__ __forceinline__ void ln1_phase(const Frame& F, int r0, const float* lng, const float* lnb, const float* modl) {
    const u16* XB = (const u16*)(F.ws + WS_XB); u16* H = (u16*)(F.ws + WS_H);
    constexpr int NR = 4; const int co = F.lane * 16;
    for (int row0 = r0 + (F.blk * 8 + F.wave) * NR; row0 < TT; row0 += F.G * 8 * NR) {
        u32x4 raw[NR][2];
#pragma unroll
        for (int k = 0; k < NR; ++k) { raw[k][0] = *(const u32x4*)(XB + (size_t)(row0 + k) * 1024 + co); raw[k][1] = *(const u32x4*)(XB + (size_t)(row0 + k) * 1024 + co + 8); }
        const int mi = row0 < TC ? 16 : ((row0 - TC) >> 11);
        const float* mp = modl + (size_t)mi * 6144 + co;
        f32x4 gg[4], bb[4], sh[4], sc[4];
#pragma unroll
        for (int j = 0; j < 4; ++j) { gg[j] = *(const f32x4*)(lng + co + 4 * j); bb[j] = *(const f32x4*)(lnb + co + 4 * j); sh[j] = *(const f32x4*)(mp + 3 * 1024 + 4 * j); sc[j] = *(const f32x4*)(mp + 4 * 1024 + 4 * j) + 1.f; }
#pragma unroll
        for (int k = 0; k < NR; ++k) { float f0[8], f1[8]; unpack8(raw[k][0], f0); unpack8(raw[k][1], f1);
            f32x4 x[4] = {{f0[0], f0[1], f0[2], f0[3]}, {f0[4], f0[5], f0[6], f0[7]}, {f1[0], f1[1], f1[2], f1[3]}, {f1[4], f1[5], f1[6], f1[7]}};
            float mu, rstd; ln_stats(x, mu, rstd);
#pragma unroll
            for (int j = 0; j < 4; ++j) x[j] = (x[j] - mu) * rstd * gg[j] + bb[j];
            ln_stats(x, mu, rstd);
            f32x4 hv[4];
#pragma unroll
            for (int j = 0; j < 4; ++j) hv[j] = (x[j] - mu) * rstd * sc[j] + sh[j];
            st8bf(H + (size_t)(row0 + k) * 1024 + co, hv[0], hv[1]); st8bf(H + (size_t)(row0 + k) * 1024 + co + 8, hv[2], hv[3]); }
    }
}

__device__ __forceinline__ void readout_phase(const Frame& F, int l, int r0) {
    const float* lp = GIN(F, 9) + l * 256;
    float s1 = lp[F.lane] * lp[64 + F.lane], s2 = lp[128 + F.lane] * lp[192 + F.lane];
    s1 = wsum(s1); s2 = wsum(s2);
    const float lam_init = 0.8f - 0.6f * expf(-0.3f * (float)l);
    const float lam = expf(s1) - expf(s2) + lam_init;
    const int e0 = (F.lane & 15) * 8, c0 = F.lane * 8;
    float hgv[8], dav[8];
#pragma unroll
    for (int j = 0; j < 8; ++j) { hgv[j] = GIN(F, 8)[l * 128 + e0 + j]; dav[j] = GIN(F, 10)[l * 128 + e0 + j] * (1.f - lam_init); }
    const u16* OF = (const u16*)(F.ws + WS_OF); const u16* OB = (const u16*)(F.ws + WS_OB); const u16* SG = (const u16*)(F.ws + WS_P4);
    const u16* O1 = (const u16*)(F.ws + WS_ON1); const u16* O2 = (const u16*)(F.ws + WS_ON2);
    u16* Aa = (u16*)(F.ws + WS_P0); u16* Bb = (u16*)(F.ws + WS_P5);
    constexpr int NR = 4;
    for (int row0 = r0 + (F.blk * 8 + F.wave) * NR; row0 < TT; row0 += F.G * 8 * NR) {
        u32x4 ra_[NR], rb_[NR], rs_[NR], r1_[NR], r2_[NR];
#pragma unroll
        for (int k = 0; k < NR; ++k) { const size_t off = (size_t)(row0 + k) * 512 + c0;
            ra_[k] = *(const u32x4*)(OF + off); rb_[k] = *(const u32x4*)(OB + off); rs_[k] = *(const u32x4*)(SG + off); r1_[k] = *(const u32x4*)(O1 + off); r2_[k] = *(const u32x4*)(O2 + off); }
#pragma unroll
        for (int k = 0; k < NR; ++k) { const size_t off = (size_t)(row0 + k) * 512 + c0;
            float a[8], b2[8], sg[8], p1[8], p2[8];
            unpack8(ra_[k], a); unpack8(rb_[k], b2); unpack8(rs_[k], sg); unpack8(r1_[k], p1); unpack8(r2_[k], p2);
            float ssa = 0.f, ssb = 0.f;
#pragma unroll
            for (int j = 0; j < 8; ++j) { a[j] += b2[j]; ssa += a[j] * a[j]; p1[j] -= lam * p2[j]; ssb += p1[j] * p1[j]; }
#pragma unroll
            for (int m = 8; m >= 1; m >>= 1) { ssa += __shfl_xor(ssa, m); ssb += __shfl_xor(ssb, m); }
            const float ra = rsqrtf(ssa * (1.f / 128.f) + LN_EPS), rb = rsqrtf(ssb * (1.f / 128.f) + LN_EPS);
            f32x4 v0, v1, w0, w1;
#pragma unroll
            for (int j = 0; j < 4; ++j) { v0[j] = a[j] * ra * hgv[j] * siluf_(sg[j]); v1[j] = a[4 + j] * ra * hgv[4 + j] * siluf_(sg[4 + j]); w0[j] = p1[j] * rb * dav[j]; w1[j] = p1[4 + j] * rb * dav[4 + j]; }
            st8bf(Aa + off, v0, v1); st8bf(Bb + off, w0, w1); }
    }
}

__device__ __forceinline__ void adaln_phase(const Frame& F) {
    if (F.blk >= 192) return;
    LAS float* sT = (LAS float*)F.lds; LAS float* red = (LAS float*)(F.lds + 81920);
    const float* c = GIN(F, 1); const float* cc = GIN(F, 3); const float* wada = GIN(F, 4); const float* bada = GIN(F, 5);
    float* mod = (float*)(F.ws + WS_MOD);
    for (int idx = F.tid; idx < 17 * 1024; idx += 512) { const int j = idx >> 10, k = idx & 1023; const float v = j < 16 ? c[idx] : cc[k]; sT[k * 20 + j] = v / (1.f + __expf(-v)); }
    __syncthreads();
    for (int u = F.blk; u < 192; u += F.G) {
        const int l = u / 96, n0 = (u % 96) * 64;
        float acc[17];
#pragma unroll
        for (int j = 0; j < 17; ++j) acc[j] = 0.f;
        const float* wp = wada + (size_t)l * 1024 * 6144 + n0 + F.lane;
        for (int k = F.wave * 128; k < F.wave * 128 + 128; ++k) {
            const float wv = wp[(size_t)k * 6144];
            const f32x4 a0 = *(const LAS f32x4*)(sT + k * 20), a1 = *(const LAS f32x4*)(sT + k * 20 + 4), a2 = *(const LAS f32x4*)(sT + k * 20 + 8), a3 = *(const LAS f32x4*)(sT + k * 20 + 12);
            const float a4 = sT[k * 20 + 16];
#pragma unroll
            for (int j = 0; j < 4; ++j) { acc[j] += a0[j] * wv; acc[4 + j] += a1[j] * wv; acc[8 + j] += a2[j] * wv; acc[12 + j] += a3[j] * wv; }
            acc[16] += a4 * wv;
        }
#pragma unroll
        for (int j = 0; j < 17; ++j) red[(F.wave * 17 + j) * 64 + F.lane] = acc[j];
        __syncthreads();
        for (int idx = F.tid; idx < 17 * 64; idx += 512) { const int j = idx >> 6, ln = idx & 63; float s = bada[l * 6144 + n0 + ln];
#pragma unroll
            for (int w = 0; w < 8; ++w) s += red[(w * 17 + j) * 64 + ln];
            mod[(size_t)(l * 17 + j) * 6144 + n0 + ln] = s; }
        __syncthreads();
    }
}

__device__ __forceinline__ void fold_phase(const Frame& F) {
    u16* U = (u16*)(F.ws + WS_P8) + (size_t)TC * 512; float* ucm = (float*)(F.ws + WS_UCM);
    for (int it = F.blk * 8 + F.wave; it < NB * 512; it += F.G * 8) {
        const int b = it >> 9, l = (it & 511) + 1;
        u16* r0p = U + ((size_t)b * SEQ + l) * 512 + F.lane * 8; u16* r1p = U + ((size_t)b * SEQ + (SEQ - l)) * 512 + F.lane * 8;
        u16* r2p = U + ((size_t)b * SEQ + (1024 - l)) * 512 + F.lane * 8; u16* r3p = U + ((size_t)b * SEQ + (1024 + l)) * 512 + F.lane * 8;
        float a[8], bq[8], c2[8], d[8];
        unpack8(*(const u32x4*)r0p, a); unpack8(*(const u32x4*)r1p, bq);
        if (l < 512) { unpack8(*(const u32x4*)r2p, c2); unpack8(*(const u32x4*)r3p, d); }
        f32x4 e0, e1, o0, o1;
#pragma unroll
        for (int j = 0; j < 4; ++j) { e0[j] = a[j] + bq[j]; e1[j] = a[4 + j] + bq[4 + j]; o0[j] = a[j] - bq[j]; o1[j] = a[4 + j] - bq[4 + j]; }
        if (l < 512) {
            f32x4 f0, f1, p0, p1;
#pragma unroll
            for (int j = 0; j < 4; ++j) { f0[j] = c2[j] + d[j]; f1[j] = c2[4 + j] + d[4 + j]; p0[j] = c2[j] - d[j]; p1[j] = c2[4 + j] - d[4 + j]; }
            st8bf(r0p, e0, e1); st8bf(r2p, f0, f1); st8bf(r3p, o0, o1); st8bf(r1p, p0, p1);
        } else { st8bf(r0p, e0, e1); st8bf(r1p, o0, o1); }
    }
    for (int i = F.blk * 512 + F.tid; i < 8192; i += F.G * 512) { const int b = i >> 9, g = (i >> 7) & 3, n = i & 127;
        const u16* up = U + ((size_t)b * SEQ + 1024) * 512 + g * 128; float acc = 0.f;
        for (int k = 0; k < 128; ++k) acc += bf2f(up[k]) * cospif((float)((n * k) & 127) * (1.f / 64.f));
        ucm[i] = acc; }
}
__device__ __forceinline__ void tables_phase(const Frame& F) {
    const int gid = F.blk * 512 + F.tid, stride = F.G * 512;
    float* lbt = (float*)(F.ws + WS_LBT); float* rope = (float*)(F.ws + WS_ROPE);
    u16* w2t = (u16*)(F.ws + WS_W2T); u16* w2tl = (u16*)(F.ws + WS_W2TL); u16* dftc = (u16*)(F.ws + WS_DFTC); u16* dft = (u16*)(F.ws + WS_DFT);
    const float* lbl = GIN(F, 7);
    for (int i = gid; i < 2048; i += stride) { const int l = i >> 10, rem = i & 1023; const float a0 = lbl[rem], a1 = lbl[1024 + rem], mx = fmaxf(a0, a1);
        const float e0 = expf(a0 - mx), e1 = expf(a1 - mx); const float lb = l == 0 ? 0.f : e1 / (e0 + e1);
        lbt[i * 2] = fmaxf(lb, 1e-30f); lbt[i * 2 + 1] = 1.f - lb; }
    for (int i = gid; i < 65536; i += stride) { const int t = i >> 5, p = i & 31; const float pos = (float)(p < 16 ? (t >> 6) : (t & 63));
        const float inv = powf(10000.f, -(float)(p & 15) / 16.f); const float ang = pos * inv; rope[i] = cosf(ang); rope[65536 + i] = sinf(ang); }
    for (int i = gid; i < 65536; i += stride) { const int np = i >> 8, k = i & 255; float v = 0.f;
        if (k < 128) { const int idx = ((np & 127) * k) & 127; const float x = (float)idx * (1.f / 64.f); v = np < 128 ? cospif(x) : sinpif(x); }
        w2t[i] = f2bf(v);
        float vl = 0.f; if (np < 128 && k < 128) vl = cospif((float)((np * k) & 127) * (1.f / 64.f)); if (np >= 128 && k >= 128) vl = sinpif((float)(((np - 128) * (k - 128)) & 127) * (1.f / 64.f));
        w2tl[i] = f2bf(vl); }
    for (int i = gid; i < 131072; i += stride) { const int m = i >> 9, ci = i & 511, lq = ci & 255, idx = (m * lq) & 255; const float x = (float)idx * (1.f / 128.f);
        dftc[(size_t)m * 2048 + ci] = f2bf(ci < 256 ? cospif(x) : -sinpif(x)); }
    for (int i = gid; i < 2048 * 2048; i += stride) { const int m = i >> 11, ci = i & 2047, lq = ci & 1023, idx = (m * lq) & 2047; const float x = (float)idx * (1.f / 1024.f);
        dft[i] = f2bf(ci < 1024 ? cospif(x) : -sinpif(x)); }
}

__device__ __forceinline__ int rowmap(int map, int n) {
    if (map == 1) { const int sec = n >> 9; if (sec == 5 || sec == 6) { const int dd = n & 63; n = (n & ~63) + (dd < 32 ? 2 * dd : 2 * (dd - 32) + 1); } return n; }
    if (map == 2) return (n >> 7) * 256 + (n & 127);
    if (map == 3) return (n >> 7) * 256 + 128 + (n & 127);
    return n;
}
__device__ __forceinline__ void cvt_job(const Frame& F, const float* src, const float* src_last, size_t src_stride, int nmat, int K, int N, u16* dst, size_t dst_stride, int ldd, int map) {
    LAS float* tile = (LAS float*)F.lds;
    const int ntn = N / 64, per = (K / 64) * ntn, total = per * nmat;
    const int kk = F.tid >> 3, c8 = (F.tid & 7) * 8;
    constexpr int NTL = 4;
    for (int i4 = F.blk * NTL; i4 < total; i4 += F.G * NTL) {
        f32x4 a[NTL], b[NTL];
#pragma unroll
        for (int q = 0; q < NTL; ++q) { const int idx = i4 + q; if (idx < total) {
            const int e = idx / per, t = idx - e * per, kt = t / ntn, tn = t - kt * ntn;
            const float* sp = (src_last && e == nmat - 1) ? src_last : src + (size_t)e * src_stride;
            a[q] = *(const f32x4*)(sp + (size_t)(kt * 64 + kk) * N + tn * 64 + c8); b[q] = *(const f32x4*)(sp + (size_t)(kt * 64 + kk) * N + tn * 64 + c8 + 4); } }
#pragma unroll
        for (int q = 0; q < NTL; ++q) if (i4 + q < total) {
#pragma unroll
            for (int j = 0; j < 4; ++j) { tile[q * 4160 + kk * 65 + c8 + j] = a[q][j]; tile[q * 4160 + kk * 65 + c8 + 4 + j] = b[q][j]; } }
        __syncthreads();
#pragma unroll
        for (int q = 0; q < NTL; ++q) { const int idx = i4 + q; if (idx < total) {
            const int e = idx / per, t = idx - e * per, kt = t / ntn, tn = t - kt * ntn;
            f32x4 v0, v1;
#pragma unroll
            for (int j = 0; j < 4; ++j) { v0[j] = tile[q * 4160 + (c8 + j) * 65 + kk]; v1[j] = tile[q * 4160 + (c8 + 4 + j) * 65 + kk]; }
            const int drow = rowmap(map, tn * 64 + kk);
            st8bf(dst + (size_t)e * dst_stride + (size_t)drow * ldd + kt * 64 + c8, v0, v1); } }
        __syncthreads();
    }
}
__device__ __forceinline__ void cvt_layer_weights(const Frame& F, int l) {
    u16* wl = (u16*)(F.ws + WS_WL);
    cvt_job(F, GIN(F, 6) + (size_t)l * 1024 * INW, nullptr, 0, 1, 1024, INW, wl + WL_WIN / 2, 0, 1024, 1);
    cvt_job(F, GIN(F, 11) + (size_t)l * 524288, nullptr, 0, 1, 512, 1024, wl + WL_WPA / 2, 0, 512, 0);
    cvt_job(F, GIN(F, 12) + (size_t)l * 524288, nullptr, 0, 1, 512, 1024, wl + WL_WPB / 2, 0, 512, 0);
    cvt_job(F, GIN(F, 13) + (size_t)l * 524288, nullptr, 0, 1, 512, 1024, wl + WL_WPC / 2, 0, 512, 0);
    cvt_job(F, GIN(F, 14) + (size_t)l * 1048576, nullptr, 0, 1, 1024, 1024, wl + WL_WO / 2, 0, 1024, 0);
    cvt_job(F, GIN(F, 19) + (size_t)l * 65536, nullptr, 0, 1, 1024, 64, wl + WL_WR / 2, 0, 1024, 0);
    unsigned* z = (unsigned*)(F.ws + WS_WL + WL_WR + 64 * 2048);
    for (int i = F.blk * 512 + F.tid; i < 192 * 512; i += F.G * 512) z[i] = 0u;
}
__device__ __forceinline__ void cvt_expert_weights(const Frame& F, int l) {
    cvt_job(F, GIN(F, 21) + (size_t)l * 64 * 262144, GIN(F, 24) + (size_t)l * 262144, 262144, NEXP1, 1024, 256, (u16*)(F.ws + WS_WGU), 524288, 1024, 2);
    cvt_job(F, GIN(F, 22) + (size_t)l * 64 * 262144, GIN(F, 25) + (size_t)l * 262144, 262144, NEXP1, 1024, 256, (u16*)(F.ws + WS_WGU), 524288, 1024, 3);
    cvt_job(F, GIN(F, 23) + (size_t)l * 64 * 262144, GIN(F, 26) + (size_t)l * 262144, 262144, NEXP1, 256, 1024, (u16*)(F.ws + WS_WD), 262144, 256, 0);
}

__device__ __forceinline__ void route1_phase(const Frame& F, int l, int r0) {
    LAS int* lcnt = (LAS int*)F.lds;
    unsigned* ctl = (unsigned*)(F.ws + WS_CTL);
    const float* logits = (const float*)(F.ws + WS_LOGIT); int* eidx = (int*)(F.ws + WS_EIDX); float* wgt = (float*)(F.ws + WS_WGT);
    int* rtok = (int*)(F.ws + WS_RTOK); int* blkb = (int*)(F.ws + WS_BLKB);
    const float* bias = GIN(F, 20) + l * 64;
    const int t1 = pass_tile0(l, 1) * 256, t2 = pass_tile0(l, 2) * 256;
    if (F.tid < NPASS * 64) lcnt[F.tid] = 0;
    __syncthreads();
    for (int i = F.blk * 512 + F.tid; i < NPASS * MAXROWS; i += F.G * 512) rtok[i] = -1;
    for (int tl = F.blk; tl * 256 + r0 < TT; tl += F.G) {
        if (F.tid >= 256) break;
        const int tok = r0 + tl * 256 + F.tid;
        const int ps = (tok >= t1) + (tok >= t2);
        float s[64];
#pragma unroll
        for (int j = 0; j < 16; ++j) { const f32x4 v = __builtin_nontemporal_load((const f32x4*)(logits + (size_t)tok * 64 + j * 4));
#pragma unroll
            for (int k = 0; k < 4; ++k) s[4 * j + k] = 1.f / (1.f + expf(-v[k])); }
        float gs[8];
#pragma unroll
        for (int g = 0; g < 8; ++g) { float m1 = -3.0e38f, m2 = -3.0e38f;
#pragma unroll
            for (int j = 0; j < 8; ++j) { const float v = s[8 * g + j] + bias[8 * g + j]; if (v > m1) { m2 = m1; m1 = v; } else if (v > m2) m2 = v; }
            gs[g] = m1 + m2; }
        unsigned gmask = 0u;
#pragma unroll
        for (int it = 0; it < 4; ++it) { float best = -3.0e38f; int bi = 0;
#pragma unroll
            for (int g = 0; g < 8; ++g) { const bool ok = !((gmask >> g) & 1u) && gs[g] > best; best = ok ? gs[g] : best; bi = ok ? g : bi; }
            gmask |= 1u << bi; }
        unsigned long long chosen = 0ull; float tot = 0.f; int eid[8]; float ew[8];
#pragma unroll
        for (int it = 0; it < 8; ++it) { float best = -3.0e38f, bs = 0.f; int bi = 0;
#pragma unroll
            for (int e = 0; e < 64; ++e) { const float v = s[e] + bias[e]; const bool ok = ((gmask >> (e >> 3)) & 1u) && !((chosen >> e) & 1ull) && v > best;
                best = ok ? v : best; bi = ok ? e : bi; bs = ok ? s[e] : bs; }
            chosen |= 1ull << bi; eid[it] = bi; ew[it] = bs; tot += bs; }
        const float rs = 2.5f / tot;
#pragma unroll
        for (int it = 0; it < 8; ++it) { eidx[(size_t)tok * 8 + it] = eid[it]; wgt[(size_t)tok * 8 + it] = ew[it] * rs; __hip_atomic_fetch_add(&lcnt[ps * 64 + eid[it]], 1, __ATOMIC_RELAXED, __HIP_MEMORY_SCOPE_WORKGROUP); }
    }
    __syncthreads();
    if (F.tid < NPASS * 64) { const int cnt = lcnt[F.tid]; int base = 0; if (cnt) base = (int)atomicAdd(&ctl[CW_GCNT + l * NPASS * 64 + F.tid], (unsigned)cnt); blkb[F.blk * (NPASS * 64) + F.tid] = base; }
}
__device__ __forceinline__ void route2_phase(const Frame& F, int l, int r0) {
    LAS int* lcnt = (LAS int*)F.lds; LAS int* base = lcnt + NPASS * 64;
    unsigned* ctl = (unsigned*)(F.ws + WS_CTL);
    const int* eidx = (const int*)(F.ws + WS_EIDX); int* srow = (int*)(F.ws + WS_SROW);
    int* rtok = (int*)(F.ws + WS_RTOK); const int* blkb = (const int*)(F.ws + WS_BLKB); int* tile_e = (int*)(F.ws + WS_TILEE);
    const int t1 = pass_tile0(l, 1) * 256, t2 = pass_tile0(l, 2) * 256;
    if (F.tid < NPASS * 64) lcnt[F.tid] = 0;
    if (F.tid < NPASS) { const int ps = F.tid; int acc = 0;
        for (int e = 0; e < 64; ++e) { const int cnt = (int)__hip_atomic_load(&ctl[CW_GCNT + (l * NPASS + ps) * 64 + e], __ATOMIC_RELAXED, __HIP_MEMORY_SCOPE_AGENT); base[ps * 66 + e] = acc; acc += (cnt + 255) & ~255; }
        base[ps * 66 + 64] = acc; acc += (pass_tile0(l, ps + 1) - pass_tile0(l, ps)) * 256; base[ps * 66 + 65] = acc; }
    __syncthreads();
    if (F.blk < NPASS) { const int ps = F.blk; const int ntl = base[ps * 66 + 65] >> 8;
        for (int ti = F.tid; ti < ntl; ti += 512) { int e = 0; for (int k = 1; k <= 64; ++k) if (ti * 256 >= base[ps * 66 + k]) e = k; tile_e[ps * 1024 + ti] = e; }
        if (F.tid == 0) __hip_atomic_store(&ctl[CW_NTILES + l * NPASS + ps], (unsigned)ntl, __ATOMIC_RELAXED, __HIP_MEMORY_SCOPE_AGENT);
    }
    for (int tl = F.blk; tl * 256 + r0 < TT; tl += F.G) {
        if (F.tid >= 256) break;
        const int tok = r0 + tl * 256 + F.tid;
        const int ps = (tok >= t1) + (tok >= t2);
        int* rt = rtok + (size_t)ps * MAXROWS;
#pragma unroll
        for (int j = 0; j < 8; ++j) { const int e = eidx[(size_t)tok * 8 + j]; const int rank = __hip_atomic_fetch_add(&lcnt[ps * 64 + e], 1, __ATOMIC_RELAXED, __HIP_MEMORY_SCOPE_WORKGROUP);
            const int row = base[ps * 66 + e] + blkb[F.blk * (NPASS * 64) + ps * 64 + e] + rank;
            rt[row] = tok; srow[(size_t)tok * 9 + j] = row; }
        const int row = base[ps * 66 + 64] + (tok - pass_tile0(l, ps) * 256); rt[row] = tok; srow[(size_t)tok * 9 + 8] = row;
    }
    __syncthreads();
}
__device__ __forceinline__ void comb_ln2_phase(const Frame& F, int tok0, int tok1, float* dst_c, float* dst_l, const float* modl, const float* lng1, const float* lnb1, const float* lng, const float* lnb, bool do_mod, const float* modn) {
    const int* srow = (const int*)(F.ws + WS_SROW); const float* wgt = (const float*)(F.ws + WS_WGT); const unsigned char* so = F.ws + WS_SO;
    u16* H = (u16*)(F.ws + WS_H);
    const int co = F.lane * 16;
    for (int tok = tok0 + F.blk * 8 + F.wave; tok < tok1; tok += F.G * 8) {
        const int myrow = F.lane < 9 ? srow[(size_t)tok * 9 + F.lane] : 0; const float myw = (F.lane < 8 ? wgt[(size_t)tok * 8 + F.lane] : 1.f) * (1.f / 16.f);
        u32x4 sv[9];
#pragma unroll
        for (int j = 0; j < 9; ++j) { const int row = __shfl(myrow, j); sv[j] = *(const u32x4*)(so + (size_t)row * 1024 + co); }
        const int mi = tok < TC ? 16 : ((tok - TC) >> 11);
        float* xp = (tok < TC ? dst_c + (size_t)tok * 1024 : dst_l + (size_t)(tok - TC) * 1024) + co;
        f32x4 x[4];
        { const u16* xb = (const u16*)(F.ws + WS_XB) + (size_t)tok * 1024 + co; float f0[8], f1[8]; unpack8(*(const u32x4*)xb, f0); unpack8(*(const u32x4*)(xb + 8), f1);
          x[0] = (f32x4){f0[0], f0[1], f0[2], f0[3]}; x[1] = (f32x4){f0[4], f0[5], f0[6], f0[7]}; x[2] = (f32x4){f1[0], f1[1], f1[2], f1[3]}; x[3] = (f32x4){f1[4], f1[5], f1[6], f1[7]};
          float mu1, rs1; ln_stats(x, mu1, rs1);
#pragma unroll
          for (int k = 0; k < 4; ++k) x[k] = (x[k] - mu1) * rs1 * *(const f32x4*)(lng1 + co + 4 * k) + *(const f32x4*)(lnb1 + co + 4 * k); }
        f32x4 y[4];
#pragma unroll
        for (int k = 0; k < 4; ++k) y[k] = (f32x4){0.f, 0.f, 0.f, 0.f};
#pragma unroll
        for (int j = 0; j < 9; ++j) { const float w = __shfl(myw, j);
#pragma unroll
            for (int k = 0; k < 4; ++k) { const f32x2_ lo = __builtin_amdgcn_cvt_pk_f32_fp8((int)sv[j][k], false), hi = __builtin_amdgcn_cvt_pk_f32_fp8((int)sv[j][k], true);
                y[k][0] += w * lo[0]; y[k][1] += w * lo[1]; y[k][2] += w * hi[0]; y[k][3] += w * hi[1]; } }
#pragma unroll
        for (int k = 0; k < 4; ++k) { const f32x4 g2 = *(const f32x4*)(modl + (size_t)mi * 6144 + 5 * 1024 + co + 4 * k); x[k] = x[k] * ALPHA + g2 * y[k]; }
        float mu, rstd;
        ln_stats(x, mu, rstd);
#pragma unroll
        for (int k = 0; k < 4; ++k) { const f32x4 gg = *(const f32x4*)(lng + co + 4 * k), bb = *(const f32x4*)(lnb + co + 4 * k);
            x[k] = (x[k] - mu) * rstd * gg + bb; *(f32x4*)(xp + 4 * k) = x[k]; }
        if (do_mod) {
            ln_stats(x, mu, rstd);
            const float* mp = modn + (size_t)mi * 6144 + co;
            f32x4 hv[4];
#pragma unroll
            for (int k = 0; k < 4; ++k) { const f32x4 sh = *(const f32x4*)(mp + 4 * k), sc = *(const f32x4*)(mp + 1024 + 4 * k); hv[k] = (x[k] - mu) * rstd * (sc + 1.f) + sh; }
            st8bf(H + (size_t)tok * 1024 + co, hv[0], hv[1]); st8bf(H + (size_t)tok * 1024 + co + 8, hv[2], hv[3]);
        }
    }
}
__device__ __forceinline__ int opaque_int(int v) { asm volatile("" : "+s"(v)); return v; }
__device__ __forceinline__ const void* launder_ptr(const void* p) {
    unsigned lo = (unsigned)(uintptr_t)p, hi = (unsigned)((uintptr_t)p >> 32);
    asm volatile("" : "+v"(lo), "+v"(hi));
    lo = __builtin_amdgcn_readfirstlane(lo); hi = __builtin_amdgcn_readfirstlane(hi);
    return (const void*)(((uintptr_t)hi << 32) | (uintptr_t)lo);
}
constexpr int NPL = 16;
constexpr int NINT = 2 + (10 + 2 * npass_of(0)) + (10 + 2 * npass_of(1));
__global__ void __launch_bounds__(512, 2) mk_fwd(Args args) {
    extern __shared__ __attribute__((aligned(16))) unsigned char lds_raw[];
    Frame F0;
    F0.in = nullptr; F0.out = args.out; F0.ws = args.ws; F0.lds = (LAS unsigned char*)lds_raw;
    F0.tid = threadIdx.x; F0.lane = F0.tid & 63; F0.wave = __builtin_amdgcn_readfirstlane(F0.tid >> 6); F0.G = gridDim.x; F0.blk = blockIdx.x;
    const int lo = args.ph_lo, hi = args.ph_hi;
    unsigned* ctl = (unsigned*)(args.ws + WS_CTL);
    volatile LAS unsigned* misc = (volatile LAS unsigned*)(F0.lds + LDS_MISC);
    if (F0.tid < 16) misc[F0.tid] = 0u;
    __syncthreads();
    XcdBarrier bar; bar.bar = ctl + CW_BAR; bar.x = 0; bar.st = misc;
    if (hi - lo > 1) bar = xcd_barrier_post(ctl + CW_BAR, misc);
#define IN(k) (lo <= (k) && (k) < hi)
#ifndef DBL_BAR
#define DBL_BAR 0
#endif
#define SEAM(k) do { if (IN(k) && IN((k) + 1)) { xcd_barrier(bar); if (DBL_BAR) xcd_barrier(bar); } } while (0)
    const float* const* in0 = (const float* const*)__builtin_amdgcn_kernarg_segment_ptr(); float* out0 = args.out; unsigned char* ws0 = args.ws;
#define PH_BEGIN Frame F = F0; { const unsigned _z = (unsigned)opaque_int(0); F.in = in0 + _z; F.out = out0 + _z; F.ws = ws0 + _z; } F.G = opaque_int(F0.G); F.blk = opaque_int(F0.blk); F.vcu = (F.G % 8 == 0) ? (F.blk % 8) * (F.G / 8) + F.blk / 8 : F.blk; { int _t = F0.tid; asm volatile("" : "+v"(_t)); F.tid = _t; F.lane = _t & 63; F.wave = __builtin_amdgcn_readfirstlane(_t >> 6); } \
    unsigned char* ws = F.ws; float* xc = (float*)(ws + WS_XC); const float* modall = (const float*)(ws + WS_MOD); (void)xc; (void)modall;
#define PH_BEGIN_L PH_BEGIN const int l = opaque_int(lyr); const int r0 = l == 0 ? 0 : TC, rt0 = r0 / 256, nM = (TT - r0) / 256; (void)rt0; (void)nM;

    if (EN(0) && IN(0)) for (int rp = 0; rp < NREP(0); ++rp) { PH_BEGIN adaln_phase(F); __syncthreads(); tables_phase(F); cvt_layer_weights(F, 0); }
    SEAM(0);
    if (EN(1) && IN(1)) for (int rp = 0; rp < NREP(1); ++rp) { PH_BEGIN ln_phase<false>(F, 0, GIN(F, 2), GIN(F, 0), nullptr, nullptr, nullptr, nullptr, true, modall, 0, 1); }
    SEAM(1);

    for (int lyr = 0; lyr < DEPTH; ++lyr) {
        const int NP = npass_of(lyr), base = 2 + (lyr == 0 ? 0 : 10 + 2 * npass_of(0));
        if (hi <= base || lo >= base + 10 + 2 * NP) continue;

        if (EN(2) && IN(base + 0)) for (int rp = 0; rp < NREP(2); ++rp) {
            PH_BEGIN_L
            PIn p; p.A = (const char*)(ws + WS_H); p.B = (const char*)(ws + WS_WL + WL_WIN); p.nt = opaque_int(16); p.G = F.G; p.c = F.blk; p.nM = l == 0 ? TT / 256 : TL / 256; p.nN = 18; p.rt0 = l == 0 ? 0 : TC / 256; p.pn0 = 0; p.nctx = l == 0 ? 0 : 16 * 12;
            p.ws = ws; p.lbt = (const float*)(ws + WS_LBT) + (size_t)l * 2048; p.rope = (const float*)(ws + WS_ROPE);
            pg8::gemm_phase(F.lds, p);
        }
        SEAM(base + 0);
        if (IN(base + 1)) {
            if (EN(5)) { PH_BEGIN_L fold_phase(F); }
            if (EN(3)) for (int rp = 0; rp < NREP(3); ++rp) { PH_BEGIN_L for (int u = F.blk; u < 256; u += F.G) { if (rp == 0) hg::hgrn_unit<0>(ws, F.lds, l, u >> 4, (u >> 2) & 3, (u >> 1) & 1, u & 1); else hg::hgrn_unit<HG_DRY>(ws, F.lds, l, u >> 4, (u >> 2) & 3, (u >> 1) & 1, u & 1); } }
            if (EN(4)) for (int rp = 0; rp < NREP(4); ++rp) {
                PH_BEGIN_L
                const int nlat = NB * 4 * 8 * 2, nctx = l == 0 ? NB * 4 * 2 : 0;
                for (int u = F.vcu; u < nlat + nctx; u += F.G) {
                    int map, b, h, qrow0, NT;
                    if (u < nlat) { map = u & 1; const int qb = (u >> 1) & 7; h = (u >> 4) & 3; b = u >> 6; qrow0 = TC + b * SEQ + qb * 256; NT = 36; }
                    else { const int v = u - nlat; map = v & 1; h = (v >> 1) & 3; b = v >> 3; qrow0 = b * LC; NT = 4; }
                    if (rp == 0) att::attn_unit_dma<0>((const u16*)(ws + WS_P5), (const u16*)(ws + WS_P6), (const u16*)(ws + WS_P7), (u16*)(ws + (map ? WS_ON2 : WS_ON1)), qrow0, b, h, map, NT, (LAS char*)F.lds);
                    else att::attn_unit_dma<AT_DRY>((const u16*)(ws + WS_P5), (const u16*)(ws + WS_P6), (const u16*)(ws + WS_P7), (u16*)(ws + WS_TT), qrow0, b, h, map, NT, (LAS char*)F.lds);
                }
            }
        }
        SEAM(base + 1);
        if (IN(base + 2)) {
            if (EN(5)) for (int rp = 0; rp < NREP(5); ++rp) {
                PH_BEGIN_L
                PF1 p; p.nt = opaque_int(4); p.Alat = (const char*)(ws + WS_W2TL); p.Actx = (const char*)(ws + WS_W2T); p.B = (const char*)(ws + WS_P8); p.G = F.G; p.c = F.blk; p.nunits = l == 0 ? 320 : 256;
                p.Olat = (u16*)(ws + WS_TT); p.Octx = (u16*)F.out;
                pg8::gemm_phase(F.lds, p);
            }
            if (EN(6)) for (int rp = 0; rp < NREP(19); ++rp) { PH_BEGIN_L readout_phase(F, l, r0); }
        }
        SEAM(base + 2);
        if (IN(base + 3)) {
            if (EN(6)) for (int rp = 0; rp < NREP(6); ++rp) {
                PH_BEGIN_L
                PF2 p; p.ucm = (const float*)(ws + WS_UCM); p.nt_lat = opaque_int(32); p.nt_ctx = opaque_int(8); p.Alat = (const char*)(ws + WS_DFT); p.Blat = (const char*)(ws + WS_TT); p.Actx = (const char*)(ws + WS_DFTC); p.Bctx = (const char*)F.out; p.G = F.G; p.c = F.blk;
                p.nunits = l == 0 ? 288 : 256; p.O = (u16*)(ws + WS_P3);
                pg8::gemm_phase(F.lds, p);
            }
            if (EN(7)) for (int rp = 0; rp < NREP(7); ++rp) {
                PH_BEGIN_L
                PIn p; p.A = (const char*)(ws + WS_H); p.B = (const char*)(ws + WS_WL + WL_WIN); p.nt = opaque_int(16); p.G = F.G; p.c = F.blk; p.nM = nM; p.nN = 12; p.rt0 = rt0; p.pn0 = 18; p.nctx = 0; p.dry = rp ? DRY_MODE : 0;
                p.ws = ws; p.lbt = nullptr; p.rope = nullptr;
                pg8::gemm_phase(F.lds, p);
            }
        }
        SEAM(base + 3);
        if (EN(8) && IN(base + 4)) for (int rp = 0; rp < NREP(8); ++rp) { PH_BEGIN_L PMerge p; p.dry = rp ? DRY_MODE : 0; p.ws = ws; p.nt = opaque_int(24); p.G = F.G; p.c = F.blk; p.nM = nM; p.rt0 = rt0; pg8::gemm_phase(F.lds, p); }
        SEAM(base + 4);
        if (EN(9) && IN(base + 5)) for (int rp = 0; rp < NREP(9); ++rp) {
            PH_BEGIN_L
            POut p; p.A = (const char*)(ws + WS_H); p.B = (const char*)(ws + WS_WL + WL_WO); p.nt = opaque_int(16); p.G = F.G; p.c = F.blk; p.nM = nM; p.rt0 = rt0;
            p.src_c = l == 0 ? GIN(F, 2) : xc; p.src_l = l == 0 ? GIN(F, 0) : F.out; p.xb = (u16*)(ws + WS_XB); p.mod = modall + (size_t)l * 17 * 6144;
            pg8::gemm_phase(F.lds, p);
        }
        SEAM(base + 5);
        if (EN(10) && IN(base + 6)) {
            for (int rp = 0; rp < NREP(10); ++rp) { PH_BEGIN_L ln1_phase(F, r0, GIN(F, 15) + l * 1024, GIN(F, 16) + l * 1024, modall + (size_t)l * 17 * 6144); }
            for (int rp = 0; rp < NREP(18); ++rp) { PH_BEGIN_L cvt_expert_weights(F, l); }
        }
        SEAM(base + 6);
        if (IN(base + 7)) {
            if (EN(11)) for (int rp = 0; rp < NREP(11); ++rp) {
                PH_BEGIN_L
                PRouter p; p.A = (const char*)(ws + WS_H); p.B = (const char*)(ws + WS_WL + WL_WR); p.nt = opaque_int(16); p.G = F.G; p.c = F.blk; p.nM = nM; p.rt0 = rt0; p.logits = (float*)(ws + WS_LOGIT);
                pg8::gemm_phase(F.lds, p);
            }
            asm volatile("s_waitcnt vmcnt(0)" ::: "memory"); __syncthreads();
            if (EN(12)) { { PH_BEGIN_L route1_phase(F, l, r0); } if (lyr + 1 < DEPTH) { PH_BEGIN_L __syncthreads(); cvt_layer_weights(F, l + 1); } }
        }
        SEAM(base + 7);
        if (EN(13) && IN(base + 8)) { PH_BEGIN_L route2_phase(F, l, r0); }
        SEAM(base + 8);
        for (int ps = 0; ps < NP; ++ps) {
            if (EN(14) && IN(base + 9 + 2 * ps)) for (int rp = 0; rp < NREP(14); ++rp) {
                PH_BEGIN_L
                PUpGate p; p.A = (const char*)(ws + WS_H); p.B = (const char*)(ws + WS_WGU); p.nt = opaque_int(16); p.G = F.G; p.c = F.vcu;
                p.ntiles = (int)__builtin_amdgcn_readfirstlane(__hip_atomic_load((unsigned*)(ws + WS_CTL) + CW_NTILES + l * NPASS + ps, __ATOMIC_RELAXED, __HIP_MEMORY_SCOPE_AGENT));
                p.hb = (u16*)(ws + WS_HB);
                {
                    LAS int* lte = (LAS int*)(F.lds + 131072); LAS int* lrt = (LAS int*)(F.lds + 131072 + 8192);
                    const int* te = (const int*)(ws + WS_TILEE) + ps * 1024; const int* rt = (const int*)(ws + WS_RTOK) + (size_t)ps * MAXROWS;
                    for (int i = F.tid; i < p.ntiles; i += 512) lte[i] = te[i];
                    for (int i = 0; i < 11; ++i) { const long L = (long)i * F.G + F.vcu; if (L >= 2L * p.ntiles) break; if (F.tid < 256) lrt[i * 256 + F.tid] = rt[(size_t)(L >> 1) * 256 + F.tid]; }
                    __syncthreads();
                    p.lte = lte; p.lrt = lrt;
                }
                pg8::gemm_phase(F.lds, p);
            }
            if (EN(16) && ps > 0 && IN(base + 9 + 2 * ps)) for (int rp = 0; rp < NREP(16); ++rp) {
                PH_BEGIN_L
                const bool more = l + 1 < DEPTH;
                comb_ln2_phase(F, pass_tile0(l, ps - 1) * 256, pass_tile0(l, ps) * 256, xc, F.out, modall + (size_t)l * 17 * 6144, GIN(F, 15) + l * 1024, GIN(F, 16) + l * 1024, GIN(F, 17) + l * 1024, GIN(F, 18) + l * 1024, more, modall + (size_t)(more ? l + 1 : l) * 17 * 6144);
            }
            SEAM(base + 9 + 2 * ps);
            if (EN(15) && IN(base + 10 + 2 * ps)) for (int rp = 0; rp < NREP(15); ++rp) {
                PH_BEGIN_L
                PDown p; p.A = (const char*)(ws + WS_HB); p.B = (const char*)(ws + WS_WD); p.nt = opaque_int(4); p.G = F.G; p.c = F.vcu;
                p.ntiles = (int)__builtin_amdgcn_readfirstlane(__hip_atomic_load((unsigned*)(ws + WS_CTL) + CW_NTILES + l * NPASS + ps, __ATOMIC_RELAXED, __HIP_MEMORY_SCOPE_AGENT));
                p.so = ws + WS_SO;
                { LAS int* lte = (LAS int*)(F.lds + 131072); const int* te = (const int*)(ws + WS_TILEE) + ps * 1024; for (int i = F.tid; i < p.ntiles; i += 512) lte[i] = te[i]; __syncthreads(); p.lte = lte; }
                pg8::gemm_phase(F.lds, p);
            }
            SEAM(base + 10 + 2 * ps);
        }
        if (EN(16) && IN(base + 9 + 2 * NP)) for (int rp = 0; rp < NREP(16); ++rp) {
            PH_BEGIN_L
            const bool more = l + 1 < DEPTH;
            comb_ln2_phase(F, pass_tile0(l, NP - 1) * 256, pass_tile0(l, NP) * 256, xc, F.out, modall + (size_t)l * 17 * 6144, GIN(F, 15) + l * 1024, GIN(F, 16) + l * 1024, GIN(F, 17) + l * 1024, GIN(F, 18) + l * 1024, more, modall + (size_t)(more ? l + 1 : l) * 17 * 6144);
        }
        SEAM(base + 9 + 2 * NP);
    }
}


#ifndef DBG_STOP
#define DBG_STOP -1
#endif
struct DbgRegs { unsigned long long off[8]; unsigned long long len[8]; int n; int keep_out; };
__global__ void dbg_dump(unsigned char* ws, float* out, DbgRegs r) {
    const size_t OUT_N = (size_t)TL * DM;
    for (size_t i = (size_t)blockIdx.x * blockDim.x + threadIdx.x; i < OUT_N; i += (size_t)gridDim.x * blockDim.x) {
        unsigned h = 0;
        for (int k = 0; k < r.n; ++k) { const unsigned* p = (const unsigned*)(ws + r.off[k]); const size_t words = r.len[k] / 4;
            for (size_t w = i; w < words; w += OUT_N) { const unsigned v = p[w]; h = h * 31u + (v ^ (v >> 15)); } }
        const float b = r.keep_out ? out[i] : 0.f;
        out[i] = b + (float)(h & 0xffffu) * (1.f / 65536.f);
    }
}
extern "C" void kernel_launch(void* const* d_in, const int* in_sizes, int n_in, void* d_out, int out_size, void* d_ws, size_t ws_size, hipStream_t stream) {
    static int grid = 0;
    if (grid == 0) {
        if (n_in != 27 || out_size != TL * DM || ws_size < WS_END) { fprintf(stderr, "kernel_launch: unexpected shapes (n_in %d, out %d, ws %zu < %zu)\n", n_in, out_size, ws_size, (size_t)WS_END); grid = -1; return; }
        int dev = 0, cus = 0, per_cu = 0;
        if (hipGetDevice(&dev) != hipSuccess || hipDeviceGetAttribute(&cus, hipDeviceAttributeMultiprocessorCount, dev) != hipSuccess) { grid = -1; return; }
        if (hipFuncSetAttribute((const void*)mk_fwd, hipFuncAttributeMaxDynamicSharedMemorySize, LDS_BYTES) != hipSuccess) { fprintf(stderr, "kernel_launch: hipFuncSetAttribute failed\n"); grid = -1; return; }
        if (hipOccupancyMaxActiveBlocksPerMultiprocessor(&per_cu, (const void*)mk_fwd, 512, LDS_BYTES) != hipSuccess || per_cu < 1) { fprintf(stderr, "kernel_launch: occupancy query says %d\n", per_cu); }
        (void)hipGetLastError();
        grid = cus;
    }
    if (grid < 0) return;
    (void)hipMemsetAsync((char*)d_ws + WS_CTL, 0, 65536, stream);
    Args a{};
    for (int i = 0; i < 27; ++i) a.in[i] = (const float*)d_in[i];
    a.out = (float*)d_out; a.ws = (unsigned char*)d_ws;
#if DBG_STOP >= 0
    for (int k = 0; k <= DBG_STOP; ++k) { a.ph_lo = k; a.ph_hi = k + 1; hipLaunchKernelGGL(mk_fwd, dim3(grid), dim3(512), LDS_BYTES, stream, a); }
    { DbgRegs r{}; DBG_REGS; hipLaunchKernelGGL(dbg_dump, dim3(2048), dim3(256), 0, stream, (unsigned char*)d_ws, (float*)d_out, r); }
#elif MK_ONE_LAUNCH
    a.ph_lo = 0; a.ph_hi = NINT;
    hipLaunchKernelGGL(mk_fwd, dim3(grid), dim3(512), LDS_BYTES, stream, a);
#else
    for (int k = 0; k < NINT; ++k) { a.ph_lo = k; a.ph_hi = k + 1; hipLaunchKernelGGL(mk_fwd, dim3(grid), dim3(512), LDS_BYTES, stream, a); }
#endif
}
```

```cpp
#include <hip/hip_runtime.h>
#include <cstdio>
#include <cstdint>

#define LAS __attribute__((address_space(3)))
typedef unsigned short u16;
typedef short bf16x8 __attribute__((ext_vector_type(8)));
typedef short s16x4 __attribute__((ext_vector_type(4)));
typedef float f32x4 __attribute__((ext_vector_type(4)));
typedef float f32x16 __attribute__((ext_vector_type(16)));
typedef unsigned u32x4 __attribute__((ext_vector_type(4)));
typedef unsigned u32x2 __attribute__((ext_vector_type(2)));

constexpr size_t XG_OFF = 40u * 1048576u;
constexpr int XG_ROWS = 112;
#ifndef LNR
#define LNR 1
#endif
#ifndef LNR_NR
#define LNR_NR 8
#endif
#ifndef XG_ON
#define XG_ON 1
#endif
#ifndef MK_ONE_LAUNCH
#define MK_ONE_LAUNCH 1
#endif
#ifndef PH_MASK
#define PH_MASK 0xFFFFFFFFu
#endif
constexpr bool EN(int k) { return ((PH_MASK) >> k) & 1u; }
#ifndef NT_GATES
#define NT_GATES 0
#endif
#if NT_GATES == 2
#define ST8G st8bf_wt
#elif NT_GATES
#define ST8G st8bf_nt
#else
#define ST8G st8bf
#endif
#ifndef DRY_MODE
#define DRY_MODE 0
#endif
#ifndef AT_DRY
#define AT_DRY 0
#endif
#ifndef HG_DRY
#define HG_DRY 0
#endif
#ifndef REP_MASK
#define REP_MASK 0u
#endif
constexpr int NREP(int k) { return (((REP_MASK) >> k) & 1u) ? 2 : 1; }

constexpr int DM = 1024, NB = 16, SEQ = 2048, DEPTH = 2, LC = 256;
constexpr int TC = NB * LC;
constexpr int TL = NB * SEQ;
constexpr int TT = TC + TL;
constexpr int INW = 7680;
constexpr int NEXP = 64, NEXP1 = 65;
constexpr int NSLOT = 9;
constexpr int NPASS = 3;
__host__ __device__ constexpr int npass_of(int l) { return l == 0 ? 3 : 2; }
constexpr int MAXTILES = 641;
constexpr int MAXROWS = MAXTILES * 256;
constexpr float LN_EPS = 1e-5f;
constexpr float ALPHA = 1.4142135623730951f;
constexpr float QK_LOG2_SCALE = 0.125f * 1.4426950408889634f;

constexpr size_t MiB = 1048576;
constexpr size_t WS_CTL = 0;
constexpr size_t WS_MOD = 65536;
constexpr size_t WS_LBT = WS_MOD + 1 * MiB;
constexpr size_t WS_ROPE = WS_LBT + 16384;
constexpr size_t WS_W2T = WS_ROPE + 524288;
constexpr size_t WS_W2TL = WS_W2T + 131072;
constexpr size_t WS_DFTC = WS_W2TL + 131072;
constexpr size_t WS_DFT = WS_DFTC + 1 * MiB;
constexpr size_t WS_XC = WS_DFT + 8 * MiB;
constexpr size_t WS_UCM = WS_MOD + 851968;
constexpr size_t WS_WL = WS_XC + 16 * MiB;
constexpr size_t WL_WIN = 0;
constexpr size_t WL_WPA = WL_WIN + (size_t)INW * DM * 2;
constexpr size_t WL_WPB = WL_WPA + 1 * MiB;
constexpr size_t WL_WPC = WL_WPB + 1 * MiB;
constexpr size_t WL_WO = WL_WPC + 1 * MiB;
constexpr size_t WL_WR = WL_WO + 2 * MiB;
constexpr size_t WL_SIZE = WL_WR + 524288;
constexpr size_t WS_DYN = (WS_WL + WL_SIZE + 255) / 256 * 256;
constexpr size_t PU = 36 * MiB;
constexpr size_t WS_H = WS_DYN;
constexpr size_t WS_P0 = WS_H + 72 * MiB;
constexpr size_t WS_P1 = WS_P0 + PU;
constexpr size_t WS_P2 = WS_P1 + PU;
constexpr size_t WS_P3 = WS_P2 + PU;
constexpr size_t WS_P4 = WS_P3 + PU;
constexpr size_t WS_P5 = WS_P4 + PU;
constexpr size_t WS_P6 = WS_P5 + PU;
constexpr size_t WS_P7 = WS_P6 + PU;
constexpr size_t WS_P8 = WS_P7 + PU;
constexpr size_t WS_OF = WS_P8 + PU;
constexpr size_t WS_OB = WS_OF + PU;
constexpr size_t WS_ON1 = WS_OB + PU;
constexpr size_t WS_ON2 = WS_ON1 + PU;
constexpr size_t WS_TT = WS_ON2 + PU;
constexpr size_t WS_END = WS_TT + 64 * MiB;
constexpr size_t WS_XB = WS_ON1;
constexpr size_t WS_GATES = WS_P6;
constexpr size_t WS_WGU = WS_P0;
constexpr size_t WS_WD = WS_WGU + (size_t)NEXP1 * 512 * 1024 * 2;
constexpr size_t WS_HB = WS_P3;
constexpr size_t WS_SO = WS_P3 + 84 * MiB;
constexpr size_t WS_LOGIT = WS_TT;
constexpr size_t WS_EIDX = WS_LOGIT + (size_t)TT * 64 * 4;
constexpr size_t WS_WGT = WS_EIDX + (size_t)TT * 8 * 4;
constexpr size_t WS_SROW = WS_WGT + (size_t)TT * 8 * 4;
constexpr size_t WS_RTOK = WS_SROW + (size_t)TT * 9 * 4;
constexpr size_t WS_TILEE = WS_RTOK + (size_t)NPASS * MAXROWS * 4;
constexpr size_t WS_BLKB = WS_TILEE + 16384;
static_assert(WS_WD + (size_t)NEXP1 * 1024 * 256 * 2 <= WS_P3, "expert weights vs hb");
static_assert(WS_HB + (size_t)MAXROWS * 512 <= WS_SO, "hb vs slotout");
static_assert(WS_BLKB + 1024 * 192 * 4 <= WS_END, "tables");
static_assert(WS_SO + (size_t)MAXROWS * 1024 <= WS_XB, "fp8 slot buffer vs the bf16 pre-norm residual (ON1+ON2)");
static_assert(WS_END <= 694845952ull, "workspace budget");
constexpr int CW_BAR = 0;
constexpr int CW_GCNT = 4096;
constexpr int CW_NTILES = 4096 + 512;
#ifndef P0A
#define P0A 53
#define P0B 106
#endif
__host__ __device__ constexpr int pass_tile0(int l, int p) { return l == 0 ? (p == 0 ? 0 : (p == 1 ? P0A : (p == 2 ? P0B : 144))) : (p == 0 ? 16 : (p == 1 ? 80 : 144)); }
__device__ __forceinline__ float bf2f(unsigned b) { return __uint_as_float(b << 16); }
typedef float f32x2_ __attribute__((ext_vector_type(2)));
typedef __bf16 bf16x2_ __attribute__((ext_vector_type(2)));
__device__ __forceinline__ unsigned cvtpk(float lo, float hi) { const f32x2_ v = {lo, hi}; const bf16x2_ b = __builtin_convertvector(v, bf16x2_); return __builtin_bit_cast(unsigned, b); }
__device__ __forceinline__ u16 f2bf(float f) { return (u16)(cvtpk(f, 0.f) & 0xffffu); }
__device__ __forceinline__ float wsum(float v) {
#pragma unroll
    for (int m = 32; m >= 1; m >>= 1) v += __shfl_xor(v, m);
    return v;
}
__device__ __forceinline__ float exp2_poly(float x) {
    const float f = __builtin_amdgcn_fractf(x), n = x - f;
    const float m = fmaf(f, fmaf(f, 0.3371894f, 0.657636f), 1.00172476f);
    return __builtin_amdgcn_ldexpf(m, (int)n);
}
__device__ __forceinline__ float sigmoidf_(float x) { return __builtin_amdgcn_rcpf(1.f + __expf(-x)); }
__device__ __forceinline__ float siluf_(float x) { return x * __builtin_amdgcn_rcpf(1.f + __expf(-x)); }
__device__ __forceinline__ int crow(int r, int hi) { return (r & 3) + 8 * (r >> 2) + 4 * hi; }

#define GLD(T, p) (*(const __attribute__((address_space(1))) T*)(p))
template <class T> __device__ __forceinline__ T* as_global(T* p) { return (T*)(__attribute__((address_space(1))) T*)p; }
#define GIN(F, i) as_global((F).in[i])
#define XB_TMO      128
#define XB_XCNT(j)  (256  + 64 * (j))
#define XB_XSUB(j)  (1280 + 64 * (j))
#define XB_XGEN(j)  (2304 + 64 * (j))
#define XB_TOP      3328
#define XB_TOPGEN   3392
#define XCD_BAR_WORDS 3456
#define XB_SPIN_CAP (1u << 18)
__device__ __forceinline__ unsigned xb_ld(unsigned* p)              { return __hip_atomic_load(p, __ATOMIC_RELAXED, __HIP_MEMORY_SCOPE_AGENT); }
__device__ __forceinline__ unsigned xb_add(unsigned* p, unsigned v) { return __hip_atomic_fetch_add(p, v, __ATOMIC_RELAXED, __HIP_MEMORY_SCOPE_AGENT); }
__device__ __forceinline__ unsigned xb_xcc_id() { return (unsigned)__builtin_amdgcn_s_getreg((3 << 11) | 20) & 0xFu; }
#define XB_SPIN(cond, bar) do { unsigned _sp = 0; while (cond) { __builtin_amdgcn_s_sleep(1); \
    if ((++_sp & 255u) == 0u) { if (xb_ld(&(bar)[XB_TMO])) break; if (_sp > XB_SPIN_CAP) { atomicAdd(&(bar)[XB_TMO], 1u); break; } } } } while (0)
struct XcdBarrier { unsigned* bar; unsigned x; volatile LAS unsigned* st; };
__device__ __forceinline__ XcdBarrier xcd_barrier_post(unsigned* bar, volatile LAS unsigned* st) {
    XcdBarrier b; b.bar = bar; b.x = xb_xcc_id(); b.st = st;
    if (threadIdx.x == 0) (void)xb_add(&bar[XB_XCNT(b.x)], 1u);
    return b;
}
__device__ __forceinline__ void xcd_barrier_complete(unsigned* bar, unsigned x, unsigned& nloc, unsigned& nx) {
    const unsigned G = gridDim.x * gridDim.y * gridDim.z;
    unsigned sum, cnt, mine, sp = 0u;
    for (;;) {
        sum = 0u; cnt = 0u; mine = 0u;
#pragma unroll
        for (unsigned j = 0; j < 16; ++j) { const unsigned c = xb_ld(&bar[XB_XCNT(j)]); sum += c; cnt += (c > 0u) ? 1u : 0u; mine = (j == x) ? c : mine; }
        if (sum == G) break;
        __builtin_amdgcn_s_sleep(1);
        if ((++sp & 255u) == 0u) { if (xb_ld(&bar[XB_TMO])) break; if (sp > XB_SPIN_CAP) { atomicAdd(&bar[XB_TMO], 1u); break; } }
    }
    nloc = mine > 0u ? mine : 1u; nx = cnt > 0u ? cnt : 1u;
}
__device__ __forceinline__ void xcd_barrier(const XcdBarrier& b) {
    asm volatile("s_waitcnt vmcnt(0)" ::: "memory");
    __syncthreads();
    if (threadIdx.x == 0) {
        unsigned* bar = b.bar;
        __builtin_amdgcn_s_waitcnt(0);
        unsigned nloc = b.st[0], nx = b.st[1];
        if (nloc == 0u) { xcd_barrier_complete(bar, b.x, nloc, nx); b.st[0] = nloc; b.st[1] = nx; }
        const unsigned old = xb_add(&bar[XB_XSUB(b.x)], 1u);
        const unsigned gen = old / nloc;
        if (old + 1u == (gen + 1u) * nloc) {
            __builtin_amdgcn_fence(__ATOMIC_RELEASE, "agent");
            asm volatile("s_waitcnt vmcnt(0)" ::: "memory");
            const unsigned og = xb_add(&bar[XB_TOP], 1u);
            const unsigned tg = og / nx;
            if (og + 1u == (tg + 1u) * nx) xb_add(&bar[XB_TOPGEN], 1u);
            else XB_SPIN(xb_ld(&bar[XB_TOPGEN]) == tg, bar);
            __builtin_amdgcn_fence(__ATOMIC_ACQUIRE, "agent");
            xb_add(&bar[XB_XGEN(b.x)], 1u);
            asm volatile("s_waitcnt vmcnt(0)" ::: "memory");
        } else {
            XB_SPIN(xb_ld(&bar[XB_XGEN(b.x)]) == gen, bar);
            __builtin_amdgcn_fence(__ATOMIC_ACQUIRE, "agent");
            asm volatile("s_waitcnt vmcnt(0)" ::: "memory");
        }
    }
    __syncthreads();
}

struct Args { const float* in[27]; float* out; unsigned char* ws; int ph_lo, ph_hi; };
struct Frame {
    const float* const* in; float* out; unsigned char* ws; LAS unsigned char* lds;
    int tid, lane, wave, G, blk, vcu;
};
constexpr int LDS_BYTES = 160 * 1024 - 64;
constexpr int LDS_MISC = LDS_BYTES - 64;

namespace pg8 {
constexpr int BM = 256, BK = 64, HALF = 128, HTB = HALF * BK * 2, STAGE_BYTES = 8 * HTB, NXCD = 8, WGM = 8;
__device__ __forceinline__ int lds_byte(int r, int c) { const int st = (r >> 4) * 2 + (c >> 5), rr = r & 15, cc = c & 31, ob = rr * 64 + cc * 2; return st * 1024 + (ob ^ (((ob >> 9) & 1) << 5)); }
__device__ __forceinline__ void stage_rc(int b, int& R, int& C) { const int st = b / 1024, sb = b % 1024, swz = sb ^ (((sb >> 9) & 1) << 5); R = (st >> 1) * 16 + swz / 64; C = (st & 1) * 32 + (swz % 64) / 2; }
__device__ __forceinline__ int perm32(int rho) { const int n = rho >> 4, i = rho & 15; return 8 * (i >> 2) + 4 * n + (i & 3); }
struct Unit { int pm, pn, aux, ord; };
typedef f32x4 Acc[2][2][4][2];

__device__ __forceinline__ bool static_tile(long L, int nM, int nN, int& pm, int& pn) {
    const int nwg = nM * nN; if (L >= nwg) return false;
    int wgid = (int)L; { const int q = nwg / NXCD, r = nwg % NXCD, xcd = wgid % NXCD, off = wgid / NXCD; wgid = (xcd < r ? xcd * (q + 1) : r * (q + 1) + (xcd - r) * q) + off; }
    const int nig = WGM * nN, gid = wgid / nig, fm = gid * WGM, gsz = (nM - fm) < WGM ? (nM - fm) : WGM;
    pm = fm + ((wgid % nig) % gsz); pn = (wgid % nig) / gsz; return true;
}

template <class P>
__device__ __forceinline__ void gemm_phase(LAS unsigned char* lds, const P& p) {
    int tid_ = threadIdx.x; asm volatile("" : "+v"(tid_));
    const int tid = tid_, wid = __builtin_amdgcn_readfirstlane(tid >> 6), lane = tid & 63, wr = wid >> 2, wc = wid & 3, fr = lane & 15, fq = lane >> 4;
    int R[2], C[2], Rb[2];
    unsigned lA[2], lB[2];
#pragma unroll
    for (int i = 0; i < 2; ++i) { stage_rc(tid * 16 + i * 8192, R[i], C[i]); Rb[i] = P::PERM ? ((R[i] & ~31) + perm32(R[i] & 31)) : R[i];
        lA[i] = P::GATHER ? 0u : p.laneA(R[i], C[i]); lB[i] = p.laneB(Rb[i], C[i]); }
    const unsigned ldsw = (unsigned)wid * 1024u;
    const int aoff = lds_byte(wr * 64 + fr, fq * 8), boff = lds_byte(wc * 32 + fr, fq * 8);
#define PG8_SA(b, h) (((b) * 2 + (h)) * HTB)
#define PG8_SB(b, h) ((4 + (b) * 2 + (h)) * HTB)
#define PG8_STAGE(bufoff, gbase, voff) do { _Pragma("unroll") for (int _i = 0; _i < 2; ++_i) \
        __builtin_amdgcn_global_load_lds((const unsigned*)((const char*)(gbase) + (voff)[_i]), (LAS unsigned*)(lds + (bufoff) + ldsw + _i * 8192), 16, 0, 0); } while (0)
#define PG8_LDA(dst, b, h) do { _Pragma("unroll") for (int m = 0; m < 4; ++m) _Pragma("unroll") for (int k = 0; k < 2; ++k) dst[m][k] = *(const LAS bf16x8*)(lds + PG8_SA(b, h) + aoff + m * 2048 + k * 1024); } while (0)
#define PG8_LDB(dst, b, h) do { _Pragma("unroll") for (int n = 0; n < 2; ++n) _Pragma("unroll") for (int k = 0; k < 2; ++k) dst[n][k] = *(const LAS bf16x8*)(lds + PG8_SB(b, h) + boff + n * 2048 + k * 1024); } while (0)
#define PG8_MMA(ai, bj, At, Bt) do { __builtin_amdgcn_s_setprio(1); _Pragma("unroll") for (int m = 0; m < 4; ++m) _Pragma("unroll") for (int n = 0; n < 2; ++n) _Pragma("unroll") for (int k = 0; k < 2; ++k) \
        acc[ai][bj][m][n] = __builtin_amdgcn_mfma_f32_16x16x32_bf16(Bt[n][k], At[m][k], acc[ai][bj][m][n], 0, 0, 0); __builtin_amdgcn_s_setprio(0); } while (0)
#define PG8_WAIT_V(n) asm volatile("s_waitcnt vmcnt(" #n ")" ::: "memory")
#define PG8_WAIT_L(n) asm volatile("s_waitcnt lgkmcnt(" #n ")" ::: "memory")
#define PG8_BAR __builtin_amdgcn_s_barrier()
#define PG8_SCHED __builtin_amdgcn_sched_barrier(0)
    Unit cur, nxt; int ui = 0;
    if (!p.next(0, cur)) return;
    Acc acc;
#pragma unroll
    for (int a = 0; a < 2; ++a)
#pragma unroll
        for (int b = 0; b < 2; ++b)
#pragma unroll
            for (int m = 0; m < 4; ++m)
#pragma unroll
                for (int n = 0; n < 2; ++n) acc[a][b][m][n] = (f32x4){0.f, 0.f, 0.f, 0.f};
    bf16x8 At[4][2], B0[2][2], B1[2][2];
    const char* cA0 = p.uA(cur, 0); const char* cA1 = P::GATHER ? cA0 : p.uA(cur, 1);
    const char* cB0 = p.uB(cur, 0); const char* cB1 = p.uB(cur, 1);
    unsigned gc[2][2] = {{0u, 0u}, {0u, 0u}}, gn[2][2] = {{0u, 0u}, {0u, 0u}};
    if constexpr (P::GATHER) p.gatherA(cur, R, C, gc);
#define A_OFF(sel, h) (P::GATHER ? sel[h] : lA)
#define KA(u, base, h, kt) (P::SEGT ? p.kA(u, h, kt) : (base) + (size_t)(kt) * 128)
#define KB(u, base, h, kt) (P::SEGT ? p.kB(u, h, kt) : (base) + (size_t)(kt) * 128)
    PG8_STAGE(PG8_SB(0, 0), cB0, lB); PG8_STAGE(PG8_SA(0, 0), cA0, A_OFF(gc, 0)); PG8_STAGE(PG8_SB(0, 1), cB1, lB); PG8_STAGE(PG8_SA(0, 1), cA1, A_OFF(gc, 1));
    if (wr == 1) PG8_BAR;
    PG8_WAIT_V(4); PG8_BAR;
    PG8_STAGE(PG8_SB(1, 0), KB(cur, cB0, 0, 1), lB); PG8_STAGE(PG8_SA(1, 0), KA(cur, cA0, 0, 1), A_OFF(gc, 0)); PG8_STAGE(PG8_SB(1, 1), KB(cur, cB1, 1, 1), lB);
    PG8_WAIT_V(6); PG8_BAR;
    for (;;) {
        const int nt = p.nt_of(cur);
        const bool has_next = p.next(ui + 1, nxt);
        const char* nA0 = cA0; const char* nA1 = cA1; const char* nB0 = cB0; const char* nB1 = cB1;
        if (!has_next) nxt = cur;
        if (has_next) { nA0 = p.uA(nxt, 0); nA1 = P::GATHER ? nA0 : p.uA(nxt, 1); nB0 = p.uB(nxt, 0); nB1 = p.uB(nxt, 1); }
        if constexpr (P::GATHER) { if (has_next) p.gatherA(nxt, R, C, gn); else { gn[0][0] = gc[0][0]; gn[0][1] = gc[0][1]; gn[1][0] = gc[1][0]; gn[1][1] = gc[1][1]; } }
        for (int t = 0; t < nt; t += 2) {
            const bool last = (t == nt - 2);
            if constexpr (P::SEGT > 0) { if (t > 0 && (t % (P::SEGT > 0 ? P::SEGT : 1)) == 0) p.seg_hook(acc, cur, t / (P::SEGT > 0 ? P::SEGT : 1), wr, wc, fr, fq); }
            const int kt2 = last ? 0 : t + 2, kt3 = kt2 + 1;
            const char* a1_1 = KA(cur, cA1, 1, t + 1);
            const char* a2_0 = last ? KA(nxt, nA0, 0, kt2) : KA(cur, cA0, 0, kt2); const char* a2_1 = last ? KA(nxt, nA1, 1, kt2) : KA(cur, cA1, 1, kt2);
            const char* b2_0 = last ? KB(nxt, nB0, 0, kt2) : KB(cur, cB0, 0, kt2); const char* b2_1 = last ? KB(nxt, nB1, 1, kt2) : KB(cur, cB1, 1, kt2);
            const char* a3_0 = last ? KA(nxt, nA0, 0, kt3) : KA(cur, cA0, 0, kt3); const char* a3_1 = last ? KA(nxt, nA1, 1, kt3) : KA(cur, cA1, 1, kt3);
            const char* b3_0 = last ? KB(nxt, nB0, 0, kt3) : KB(cur, cB0, 0, kt3); const char* b3_1 = last ? KB(nxt, nB1, 1, kt3) : KB(cur, cB1, 1, kt3);
            unsigned g2[2][2];
            if constexpr (P::GATHER) { g2[0][0] = last ? gn[0][0] : gc[0][0]; g2[0][1] = last ? gn[0][1] : gc[0][1]; g2[1][0] = last ? gn[1][0] : gc[1][0]; g2[1][1] = last ? gn[1][1] : gc[1][1]; }
            PG8_LDB(B0, 0, 0); PG8_SCHED; PG8_LDA(At, 0, 0); PG8_STAGE(PG8_SA(1, 1), a1_1, A_OFF(gc, 1));
            PG8_WAIT_L(8); PG8_BAR; PG8_WAIT_L(0); PG8_MMA(0, 0, At, B0); PG8_BAR; PG8_SCHED;
            PG8_LDB(B1, 0, 1); PG8_STAGE(PG8_SB(0, 0), b2_0, lB);
            PG8_BAR; PG8_WAIT_L(0); PG8_MMA(0, 1, At, B1); PG8_BAR;
            PG8_LDA(At, 0, 1); PG8_STAGE(PG8_SA(0, 0), a2_0, A_OFF(g2, 0));
            PG8_BAR; PG8_WAIT_L(0); PG8_MMA(1, 0, At, B0); PG8_BAR; PG8_SCHED;
            PG8_STAGE(PG8_SB(0, 1), b2_1, lB);
            PG8_WAIT_V(6); PG8_BAR; PG8_MMA(1, 1, At, B1); PG8_BAR;
            PG8_LDB(B0, 1, 0); PG8_SCHED; PG8_LDA(At, 1, 0); PG8_STAGE(PG8_SA(0, 1), a2_1, A_OFF(g2, 1));
            PG8_WAIT_L(8); PG8_BAR; PG8_WAIT_L(0); PG8_MMA(0, 0, At, B0); PG8_BAR; PG8_SCHED;
            PG8_LDB(B1, 1, 1); PG8_STAGE(PG8_SB(1, 0), b3_0, lB);
            PG8_BAR; PG8_WAIT_L(0); PG8_MMA(0, 1, At, B1); PG8_BAR;
            PG8_LDA(At, 1, 1); PG8_STAGE(PG8_SA(1, 0), a3_0, A_OFF(g2, 0));
            PG8_BAR; PG8_WAIT_L(0); PG8_MMA(1, 0, At, B0); PG8_BAR; PG8_SCHED;
            PG8_STAGE(PG8_SB(1, 1), b3_1, lB);
            PG8_WAIT_V(6); PG8_BAR; PG8_MMA(1, 1, At, B1); PG8_BAR;
        }
        p.epi(acc, cur, wr, wc, fr, fq);
        if (!has_next) break;
#pragma unroll
        for (int a = 0; a < 2; ++a)
#pragma unroll
            for (int b = 0; b < 2; ++b)
#pragma unroll
                for (int m = 0; m < 4; ++m)
#pragma unroll
                    for (int n = 0; n < 2; ++n) acc[a][b][m][n] = (f32x4){0.f, 0.f, 0.f, 0.f};
        cur = nxt; cA0 = nA0; cA1 = nA1; cB0 = nB0; cB1 = nB1; ++ui;
        if constexpr (P::GATHER) { gc[0][0] = gn[0][0]; gc[0][1] = gn[0][1]; gc[1][0] = gn[1][0]; gc[1][1] = gn[1][1]; }
    }
    PG8_WAIT_V(0);
    if (wr == 0) PG8_BAR;
    PG8_BAR;
#undef A_OFF
#undef KA
#undef KB
#undef PG8_SA
#undef PG8_SB
#undef PG8_STAGE
#undef PG8_LDA
#undef PG8_LDB
#undef PG8_MMA
#undef PG8_WAIT_V
#undef PG8_WAIT_L
#undef PG8_BAR
#undef PG8_SCHED
}
}
using pg8::Unit; using pg8::Acc;

__device__ __forceinline__ void unpack8(const u32x4& w, float (&f)[8]) {
#pragma unroll
    for (int j = 0; j < 4; ++j) { f[2 * j] = bf2f(w[j] & 0xffffu); f[2 * j + 1] = bf2f(w[j] >> 16); }
}
__device__ __forceinline__ void st8bf_nt(u16* p, const f32x4& v0, const f32x4& v1) {
    u32x4 w = {cvtpk(v0[0], v0[1]), cvtpk(v0[2], v0[3]), cvtpk(v1[0], v1[1]), cvtpk(v1[2], v1[3])};
    __builtin_nontemporal_store(w, (u32x4*)p);
}
__device__ __forceinline__ void st8bf_wt(u16* p, const f32x4& v0, const f32x4& v1) {
    u32x4 w = {cvtpk(v0[0], v0[1]), cvtpk(v0[2], v0[3]), cvtpk(v1[0], v1[1]), cvtpk(v1[2], v1[3])};
    asm volatile("global_store_dwordx4 %0, %1, off sc0 sc1\n\ts_nop 2" :: "v"(p), "v"(w) : "memory");
}
__device__ __forceinline__ void st8bf(u16* p, const f32x4& v0, const f32x4& v1) {
    u32x4 w = {cvtpk(v0[0], v0[1]), cvtpk(v0[2], v0[3]), cvtpk(v1[0], v1[1]), cvtpk(v1[2], v1[3])};
    *(u32x4*)p = w;
}
__device__ __forceinline__ unsigned pkh2(float a, float b) { const _Float16 x = (_Float16)a, y = (_Float16)b; return (unsigned)__builtin_bit_cast(u16, x) | ((unsigned)__builtin_bit_cast(u16, y) << 16); }
__device__ __forceinline__ float logf_gate(float v, float lbf, float oml) {
    return __builtin_amdgcn_logf(fmaf(oml, __builtin_amdgcn_rcpf(1.f + __expf(-v)), lbf));
}

struct PIn {
    static constexpr int SEGT = 0; __device__ __forceinline__ const char* kA(const Unit&, int, int) const { return nullptr; } __device__ __forceinline__ const char* kB(const Unit&, int, int) const { return nullptr; }
    __device__ __forceinline__ int nt_of(const Unit&) const { return nt; }
    static constexpr bool PERM = true, GATHER = false;
    const char* A; const char* B; int nt, G, c, nM, nN, rt0, pn0, nctx;
    unsigned char* ws; const float* lbt; const float* rope; int dry = 0;
    int xr0 = 0, xnr = 0; u16* xg = nullptr;
    __device__ __forceinline__ bool next(int i, Unit& u) const { int pm, pn; const long L = (long)i * G + c; u.aux = 0;
        if (pg8::static_tile(L, nM, nN, pm, pn)) { u.pm = rt0 + pm; u.pn = pn0 + pn; return true; }
        const long L2 = L - (long)nM * nN; if (L2 < nctx) { const int k = (int)(L2 % 12); u.pm = (int)(L2 / 12); u.pn = k < 8 ? k : k + 4; return true; }
        const long L3 = L2 - nctx; if (L3 >= 2L * xnr) return false; u.pm = xr0 + (int)(L3 >> 1); u.pn = 28 + (int)(L3 & 1); return true; }
    __device__ __forceinline__ const char* uA(const Unit& u, int h) const { return A + (size_t)(u.pm * 256 + h * 128) * 2048; }
    __device__ __forceinline__ const char* uB(const Unit& u, int h) const { return B + (size_t)(u.pn * 256 + h * 128) * 2048; }
    __device__ __forceinline__ unsigned laneA(int R, int C) const { return (unsigned)(R * 2048 + C * 2); }
    __device__ __forceinline__ unsigned laneB(int R, int C) const { return (unsigned)(R * 2048 + C * 2); }
    template <int BJ> __device__ __forceinline__ void logf_part(const Acc& acc, const Unit& u, u16* O, const float* lb, int cs0, int wr, int fr) const {
        const int cs = cs0 + BJ * 128;
        const f32x4 t0 = GLD(f32x4, lb + cs * 2), t1 = GLD(f32x4, lb + cs * 2 + 4), t2 = GLD(f32x4, lb + cs * 2 + 8), t3 = GLD(f32x4, lb + cs * 2 + 12);
#pragma unroll
        for (int ai = 0; ai < 2; ++ai)
#pragma unroll
            for (int m = 0; m < 4; ++m) { const size_t row = (size_t)(u.pm * 256 + ai * 128 + wr * 64 + m * 16 + fr);
                const f32x4 v0 = acc[ai][BJ][m][0], v1 = acc[ai][BJ][m][1];
                u32x4 w;
                w[0] = pkh2(logf_gate(v0[0], t0[0], t0[1]), logf_gate(v0[1], t0[2], t0[3]));
                w[1] = pkh2(logf_gate(v0[2], t1[0], t1[1]), logf_gate(v0[3], t1[2], t1[3]));
                w[2] = pkh2(logf_gate(v1[0], t2[0], t2[1]), logf_gate(v1[1], t2[2], t2[3]));
                w[3] = pkh2(logf_gate(v1[2], t3[0], t3[1]), logf_gate(v1[3], t3[2], t3[3]));
                *(u32x4*)(O + row * 512 + cs) = w; __builtin_amdgcn_sched_barrier(0); }
    }
    __device__ __forceinline__ void epi(const Acc& acc, const Unit& u, int wr, int wc, int fr, int fq) const {
        const int sec = u.pn >> 1;
        if (sec >= 9) {
            u16* G_ = (u16*)(ws + WS_GATES);
            const int col0 = (u.pn - 18) * 256 + wc * 32 + 8 * fq;
            if (dry) {
                u16* D_ = (u16*)(ws + WS_TT);
#pragma unroll
                for (int ai = 0; ai < 2; ++ai)
#pragma unroll
                    for (int m = 0; m < 4; ++m) { const size_t row = (size_t)(u.pm * 256 + ai * 128 + wr * 64 + m * 16 + fr);
#pragma unroll
                        for (int bj = 0; bj < 2; ++bj) { f32x4 v0 = acc[ai][bj][m][0], v1 = acc[ai][bj][m][1];
                            if (dry == 1) {
#pragma unroll
                                for (int j = 0; j < 4; ++j) { v0[j] = sigmoidf_(v0[j]); v1[j] = sigmoidf_(v1[j]); } }
                            if (dry == 4) {
#pragma unroll
                                for (int j = 0; j < 4; ++j) { v0[j] = 1.f + __builtin_amdgcn_exp2f(v0[j] * -1.44269504f); v1[j] = 1.f + __builtin_amdgcn_exp2f(v1[j] * -1.44269504f); } }
                            if (dry == 6) {
#pragma unroll
                                for (int j = 0; j < 4; ++j) { float a = v0[j], b = v1[j];
#pragma unroll
                                    for (int k = 0; k < 4; ++k) { a = __builtin_amdgcn_exp2f(a) - 1.5f; b = __builtin_amdgcn_exp2f(b) - 1.5f; } v0[j] = a; v1[j] = b; } }
                            if (dry == 7) {
#pragma unroll
                                for (int j = 0; j < 4; ++j) { float a = v0[j], b = v1[j];
#pragma unroll
                                    for (int k = 0; k < 4; ++k) { a = __builtin_amdgcn_rcpf(a) - 1.5f; b = __builtin_amdgcn_rcpf(b) - 1.5f; } v0[j] = a; v1[j] = b; } }
                            if (dry == 8) {
#pragma unroll
                                for (int j = 0; j < 4; ++j) { float a = v0[j], b = v1[j];
#pragma unroll
                                    for (int k = 0; k < 4; ++k) { a = fmaf(a, a, -1.5f) - 1.5f; b = fmaf(b, b, -1.5f) - 1.5f; } v0[j] = a; v1[j] = b; } }
                            if (dry == 5) {
#pragma unroll
                                for (int j = 0; j < 4; ++j) { v0[j] = 1.f + exp2_poly(v0[j] * -1.44269504f); v1[j] = 1.f + exp2_poly(v1[j] * -1.44269504f); } }
                            if (dry != 3 || (ai == 0 && m == 0 && bj == 0)) st8bf(D_ + ((row * 3072 + col0 + bj * 128) & (size_t)(16 * MiB - 1)), v0, v1);
                            else asm volatile("" :: "v"(v0[0] + v1[3])); } __builtin_amdgcn_sched_barrier(0); }
                return;
            }
            { const int gt = u.pn - 18, tidf = (wr * 4 + wc) * 64 + fq * 16 + fr;
              u16* Gb = G_ + ((size_t)(u.pm * 3 + (gt >> 2)) * 4 + (gt & 3)) * 65536 + tidf * 8;
              if (xg && gt >= 10 && u.pm < XG_ROWS) Gb = xg + (size_t)(u.pm * 2 + (gt - 10)) * 65536 + tidf * 8;
#pragma unroll
              for (int ai = 0; ai < 2; ++ai)
#pragma unroll
                for (int m = 0; m < 4; ++m) {
#pragma unroll
                    for (int bj = 0; bj < 2; ++bj) { f32x4 v0 = acc[ai][bj][m][0], v1 = acc[ai][bj][m][1];
#pragma unroll
                        for (int j = 0; j < 4; ++j) { v0[j] = 1.f + __expf(-v0[j]); v1[j] = 1.f + __expf(-v1[j]); }
                        ST8G(Gb + ((ai * 4 + m) * 2 + bj) * 4096, v0, v1); } __builtin_amdgcn_sched_barrier(0); } }
            return;
        }
        u16* O = (u16*)(ws + WS_P0 + (size_t)sec * PU);
        const int cs0 = (u.pn & 1) * 256 + wc * 32 + 8 * fq;
        if (sec == 1 || sec == 2) {
            const float* lb = as_global(lbt) + (size_t)(sec - 1) * 1024;
            logf_part<0>(acc, u, O, lb, cs0, wr, fr); logf_part<1>(acc, u, O, lb, cs0, wr, fr);
            return;
        }
        const bool rope_sec = (sec == 5 || sec == 6), silu_sec = (sec == 0);
        if (rope_sec && u.pm * 256 >= TC) {
            const int p0 = (wc & 1) * 16 + 4 * fq;
#pragma unroll
            for (int ai = 0; ai < 2; ++ai) {
                f32x4 cs4[4], sn4[4];
#pragma unroll
                for (int m = 0; m < 4; ++m) { const int t = (u.pm * 256 + ai * 128 + wr * 64 + m * 16 + fr - TC) & (SEQ - 1);
                    cs4[m] = GLD(f32x4, rope + (size_t)t * 32 + p0); sn4[m] = GLD(f32x4, rope + 65536 + (size_t)t * 32 + p0); }
#pragma unroll
                for (int m = 0; m < 4; ++m) { const size_t row = (size_t)(u.pm * 256 + ai * 128 + wr * 64 + m * 16 + fr);
#pragma unroll
                    for (int bj = 0; bj < 2; ++bj) { const f32x4 v0 = acc[ai][bj][m][0], v1 = acc[ai][bj][m][1]; f32x4 r0, r1;
                        r0[0] = v0[0] * cs4[m][0] - v0[1] * sn4[m][0]; r0[1] = v0[1] * cs4[m][0] + v0[0] * sn4[m][0];
                        r0[2] = v0[2] * cs4[m][1] - v0[3] * sn4[m][1]; r0[3] = v0[3] * cs4[m][1] + v0[2] * sn4[m][1];
                        r1[0] = v1[0] * cs4[m][2] - v1[1] * sn4[m][2]; r1[1] = v1[1] * cs4[m][2] + v1[0] * sn4[m][2];
                        r1[2] = v1[2] * cs4[m][3] - v1[3] * sn4[m][3]; r1[3] = v1[3] * cs4[m][3] + v1[2] * sn4[m][3];
                        if (sec == 5) { r0 *= QK_LOG2_SCALE; r1 *= QK_LOG2_SCALE; }
                        st8bf(O + row * 512 + cs0 + bj * 128, r0, r1); } }
                __builtin_amdgcn_sched_barrier(0); }
            return;
        }
#pragma unroll
        for (int ai = 0; ai < 2; ++ai)
#pragma unroll
            for (int m = 0; m < 4; ++m) { const size_t row = (size_t)(u.pm * 256 + ai * 128 + wr * 64 + m * 16 + fr);
#pragma unroll
                for (int bj = 0; bj < 2; ++bj) { f32x4 v0 = acc[ai][bj][m][0], v1 = acc[ai][bj][m][1]; const int cs = cs0 + bj * 128;
                    if (silu_sec) {
#pragma unroll
                        for (int j = 0; j < 4; ++j) { v0[j] = siluf_(v0[j]); v1[j] = siluf_(v1[j]); }
                    }
                    if (sec == 5) { v0 *= QK_LOG2_SCALE; v1 *= QK_LOG2_SCALE; }
                    st8bf(O + row * 512 + cs, v0, v1); } __builtin_amdgcn_sched_barrier(0); }
    }
};

struct PF1 {
    int skew_ticks = 0;
    static constexpr int SEGT = 2;
    int nt; __device__ __forceinline__ int nt_of(const Unit&) const { return nt; }
    static constexpr bool PERM = true, GATHER = false;
    const char* Alat; const char* Actx; const char* B; int G, c, nunits; u16* Olat; u16* Octx;
    __device__ __forceinline__ bool next(int i, Unit& u) const { const int L = i * G + c; if (L >= nunits) return false;
        if (L < 256) { u.aux = L >> 2; u.pn = L & 3; u.pm = 0; } else { u.aux = L - 256; u.pn = 0; u.pm = 1; } return true; }
    __device__ __forceinline__ const char* kA(const Unit& u, int h, int kt) const { return (u.pm ? Actx : Alat) + (size_t)h * 128 * 512 + (size_t)kt * 128; }
    __device__ __forceinline__ const char* kB(const Unit& u, int h, int kt) const { const int b = u.aux >> 2, g = u.aux & 3;
        if (u.pm) return B + ((size_t)(b * LC + h * 128) * 512 + g * 128) * 2 + (size_t)kt * 128;
        return B + ((size_t)(TC + b * SEQ + (kt >> 1) * 1024 + u.pn * 256 + h * 128) * 512 + g * 128 + (kt & 1) * 64) * 2; }
    __device__ __forceinline__ const char* uA(const Unit& u, int h) const { return kA(u, h, 0); }
    __device__ __forceinline__ const char* uB(const Unit& u, int h) const { return kB(u, h, 0); }
    __device__ __forceinline__ unsigned laneA(int R, int C) const { return (unsigned)(R * 512 + C * 2); }
    __device__ __forceinline__ unsigned laneB(int R, int C) const { return (unsigned)(R * 1024 + C * 2); }
    __device__ __forceinline__ void seg_hook(Acc&, const Unit&, int, int, int, int, int) const {}
    __device__ __forceinline__ void epi(const Acc& acc, const Unit& u, int wr, int wc, int fr, int fq) const {
        u16* Ob = (u.pm ? Octx : Olat) + (size_t)(u.aux * 128 + wr * 64 + fr) * 2048 + u.pn * 256 + wc * 32 + 8 * fq;
        const int half_off = u.pm ? 256 : 1024;
#pragma unroll
        for (int ai = 0; ai < 2; ++ai)
#pragma unroll
            for (int m = 0; m < 4; ++m) {
#pragma unroll
                for (int bj = 0; bj < 2; ++bj)
                    st8bf(Ob + (size_t)m * 16 * 2048 + ai * half_off + bj * 128, acc[ai][bj][m][0], acc[ai][bj][m][1]);
                __builtin_amdgcn_sched_barrier(0); }
    }
};
struct PF2 {
    int skew_ticks = 0;
    static constexpr int SEGT = 0; __device__ __forceinline__ const char* kA(const Unit&, int, int) const { return nullptr; } __device__ __forceinline__ const char* kB(const Unit&, int, int) const { return nullptr; }
    static constexpr bool PERM = true, GATHER = false;
    const char* Alat; const char* Blat; const char* Actx; const char* Bctx; int G, c, nunits; u16* O; const float* ucm;
    int nt_lat, nt_ctx; __device__ __forceinline__ int nt_of(const Unit& u) const { return u.aux ? nt_ctx : nt_lat; }
    __device__ __forceinline__ bool next(int i, Unit& u) const { const int L = i * G + c; if (L >= nunits) return false;
        if (L < 256) { int pm, pn; pg8::static_tile(L, 8, 32, pm, pn); u.pm = pm; u.pn = pn; u.aux = 0; } else { u.pm = 0; u.pn = L - 256; u.aux = 1; } return true; }
    __device__ __forceinline__ const char* uA(const Unit& u, int h) const { return (u.aux ? Actx : Alat) + (size_t)(u.pm * 256 + h * 128) * 4096; }
    __device__ __forceinline__ const char* uB(const Unit& u, int h) const { return (u.aux ? Bctx : Blat) + (size_t)(u.pn * 256 + h * 128) * 4096; }
    __device__ __forceinline__ unsigned laneA(int R, int C) const { return (unsigned)(R * 4096 + C * 2); }
    __device__ __forceinline__ unsigned laneB(int R, int C) const { return (unsigned)(R * 4096 + C * 2); }
    __device__ __forceinline__ void epi(const Acc& acc, const Unit& u, int wr, int wc, int fr, int fq) const {
        const float scale = u.aux ? 0.005524271728019903f : (1.f / 512.f);
        const int lseg = u.aux ? LC : SEQ, rowbase = u.aux ? 0 : TC;
        const int ci0 = u.pn * 256 + wc * 32 + 8 * fq, b = ci0 >> 9, rem = ci0 & 511;
        u16* Ob = O + (size_t)(rowbase + b * lseg + u.pm * 256 + wr * 64 + fr) * 512 + rem;
        f32x4 mid[2][2];
        const float sg = u.aux ? 0.f : ((fr & 1) ? -1.f : 1.f);
#pragma unroll
        for (int bj = 0; bj < 2; ++bj)
#pragma unroll
            for (int n = 0; n < 2; ++n) mid[bj][n] = GLD(f32x4, ucm + ci0 + bj * 128 + n * 4) * sg;
#pragma unroll
        for (int ai = 0; ai < 2; ++ai)
#pragma unroll
            for (int m = 0; m < 4; ++m) {
#pragma unroll
                for (int bj = 0; bj < 2; ++bj)
                    st8bf(Ob + (size_t)(ai * 128 + m * 16) * 512 + bj * 128, (acc[ai][bj][m][0] + mid[bj][0]) * scale, (acc[ai][bj][m][1] + mid[bj][1]) * scale);
                __builtin_amdgcn_sched_barrier(0); }
    }
};
struct PMerge {
    static constexpr int SEGT = 8;
    __device__ __forceinline__ int nt_of(const Unit&) const { return nt; }
    static constexpr bool PERM = true, GATHER = false;
    unsigned char* ws; int nt, G, c, nM, rt0; int dry = 0;
    const u16* xg = nullptr;
    __device__ __forceinline__ bool next(int i, Unit& u) const { int pm, pn; if (!pg8::static_tile((long)i * G + c, nM, 4, pm, pn)) return false; u.pm = rt0 + pm; u.pn = pn; u.aux = 0; return true; }
    __device__ __forceinline__ const char* kA(const Unit& u, int h, int kt) const { const int sg = kt >> 3; const size_t off = sg == 0 ? WS_P0 : (sg == 1 ? WS_P5 : WS_P3);
        return (const char*)ws + off + (size_t)(u.pm * 256 + h * 128) * 1024 + (size_t)(kt & 7) * 128; }
    __device__ __forceinline__ const char* kB(const Unit& u, int h, int kt) const { const int sg = kt >> 3;
        return (const char*)ws + WS_WL + WL_WPA + (size_t)sg * MiB + (size_t)(u.pn * 256 + h * 128) * 1024 + (size_t)(kt & 7) * 128; }
    __device__ __forceinline__ const char* uA(const Unit& u, int h) const { return kA(u, h, 0); }
    __device__ __forceinline__ const char* uB(const Unit& u, int h) const { return kB(u, h, 0); }
    __device__ __forceinline__ unsigned laneA(int R, int C) const { return (unsigned)(R * 1024 + C * 2); }
    __device__ __forceinline__ unsigned laneB(int R, int C) const { return (unsigned)(R * 1024 + C * 2); }
    __device__ __forceinline__ void seg_hook(Acc& acc, const Unit& u, int sg, int wr, int wc, int fr, int fq) const {
        if (dry == 2) return;
        const int tidf = (wr * 4 + wc) * 64 + fq * 16 + fr;
        const u16* Gp = (const u16*)(ws + WS_GATES) + ((size_t)(u.pm * 3 + (sg - 1)) * 4 + u.pn) * 65536 + tidf * 8;
        const u16* Gn = Gp + 4 * 65536;
        if (xg && sg == 2 && u.pm < XG_ROWS && u.pn >= 2) Gn = xg + (size_t)(u.pm * 2 + (u.pn - 2)) * 65536 + tidf * 8;
        u32x4 bp[2][2][2], bn[2][2][2];
#define HK_LOAD(buf, q) do { _Pragma("unroll") for (int mm = 0; mm < 2; ++mm) _Pragma("unroll") for (int bj = 0; bj < 2; ++bj) { \
            const int fo = ((((q) >> 1) * 4 + ((q) & 1) * 2 + mm) * 2 + bj) * 4096; bp[buf][mm][bj] = *(const u32x4*)(Gp + fo); bn[buf][mm][bj] = *(const u32x4*)(Gn + fo); } } while (0)
#define HK_APPLY(buf, q) do { _Pragma("unroll") for (int mm = 0; mm < 2; ++mm) _Pragma("unroll") for (int bj = 0; bj < 2; ++bj) { float fp[8], fn[8]; unpack8(bp[buf][mm][bj], fp); unpack8(bn[buf][mm][bj], fn); \
            const int ai = (q) >> 1, m = ((q) & 1) * 2 + mm; \
            _Pragma("unroll") for (int j = 0; j < 4; ++j) { acc[ai][bj][m][0][j] *= fn[j] * __builtin_amdgcn_rcpf(fp[j]); acc[ai][bj][m][1][j] *= fn[4 + j] * __builtin_amdgcn_rcpf(fp[4 + j]); } } } while (0)
        HK_LOAD(0, 0); HK_LOAD(1, 1); __builtin_amdgcn_sched_barrier(0);
        HK_APPLY(0, 0); __builtin_amdgcn_sched_barrier(0); HK_LOAD(0, 2); __builtin_amdgcn_sched_barrier(0);
        HK_APPLY(1, 1); __builtin_amdgcn_sched_barrier(0); HK_LOAD(1, 3); __builtin_amdgcn_sched_barrier(0);
        HK_APPLY(0, 2); __builtin_amdgcn_sched_barrier(0);
        HK_APPLY(1, 3); __builtin_amdgcn_sched_barrier(0);
#undef HK_LOAD
#undef HK_APPLY
    }
    __device__ __forceinline__ void epi(const Acc& acc, const Unit& u, int wr, int wc, int fr, int fq) const {
        const int tidf = (wr * 4 + wc) * 64 + fq * 16 + fr;
        const u16* Gt = (const u16*)(ws + WS_GATES) + ((size_t)(u.pm * 3 + 2) * 4 + u.pn) * 65536 + tidf * 8;
        if (xg && u.pm < XG_ROWS && u.pn >= 2) Gt = xg + (size_t)(u.pm * 2 + (u.pn - 2)) * 65536 + tidf * 8;
        u16* M = (u16*)(ws + (dry ? WS_P1 : WS_H)) + (size_t)(u.pm * 256 + wr * 64 + fr) * 1024 + u.pn * 256 + wc * 32 + 8 * fq;
#pragma unroll
        for (int ai = 0; ai < 2; ++ai) {
            u32x4 g[4][2];
#pragma unroll
            for (int m = 0; m < 4; ++m)
#pragma unroll
                for (int bj = 0; bj < 2; ++bj) g[m][bj] = *(const u32x4*)(Gt + ((ai * 4 + m) * 2 + bj) * 4096);
#pragma unroll
            for (int m = 0; m < 4; ++m)
#pragma unroll
                for (int bj = 0; bj < 2; ++bj) { float fg[8]; unpack8(g[m][bj], fg);
                    f32x4 v0 = acc[ai][bj][m][0], v1 = acc[ai][bj][m][1];
#pragma unroll
                    for (int j = 0; j < 4; ++j) { v0[j] *= __builtin_amdgcn_rcpf(fg[j]); v1[j] *= __builtin_amdgcn_rcpf(fg[4 + j]); }
                    st8bf(M + (size_t)(ai * 128 + m * 16) * 1024 + bj * 128, v0, v1); }
            __builtin_amdgcn_sched_barrier(0); }
    }
};
struct POut {
    static constexpr int SEGT = 0; __device__ __forceinline__ const char* kA(const Unit&, int, int) const { return nullptr; } __device__ __forceinline__ const char* kB(const Unit&, int, int) const { return nullptr; }
    __device__ __forceinline__ int nt_of(const Unit&) const { return nt; }
    static constexpr bool PERM = true, GATHER = false;
    const char* A; const char* B; int nt, G, c, nM, rt0;
    const float* src_c; const float* src_l; u16* xb; const float* mod;
    __device__ __forceinline__ bool next(int i, Unit& u) const { int pm, pn; if (!pg8::static_tile((long)i * G + c, nM, 4, pm, pn)) return false; u.pm = rt0 + pm; u.pn = pn; u.aux = 0; return true; }
    __device__ __forceinline__ const char* uA(const Unit& u, int h) const { return A + (size_t)(u.pm * 256 + h * 128) * 2048; }
    __device__ __forceinline__ const char* uB(const Unit& u, int h) const { return B + (size_t)(u.pn * 256 + h * 128) * 2048; }
    __device__ __forceinline__ unsigned laneA(int R, int C) const { return (unsigned)(R * 2048 + C * 2); }
    __device__ __forceinline__ unsigned laneB(int R, int C) const { return (unsigned)(R * 2048 + C * 2); }
    __device__ __forceinline__ void epi(const Acc& acc, const Unit& u, int wr, int wc, int fr, int fq) const {
        const int row0 = u.pm * 256;
        const int mi = row0 < TC ? 16 : ((row0 - TC) >> 11);
        const int col0 = u.pn * 256 + wc * 32 + 8 * fq;
        const float* g1 = mod + (size_t)mi * 6144 + 2048 + col0;
        f32x4 gv[2][2];
#pragma unroll
        for (int bj = 0; bj < 2; ++bj)
#pragma unroll
            for (int n = 0; n < 2; ++n) gv[bj][n] = *(const f32x4*)(g1 + bj * 128 + n * 4);
        const int rb = row0 + wr * 64 + fr;
        const float* sp0 = (row0 < TC ? src_c + (size_t)rb * 1024 : src_l + (size_t)(rb - TC) * 1024) + col0;
        u16* dp0 = xb + (size_t)rb * 1024 + col0;
#pragma unroll
        for (int ai = 0; ai < 2; ++ai)
#pragma unroll
            for (int mp = 0; mp < 2; ++mp) {
                f32x4 xv[2][2][2];
#pragma unroll
                for (int mm = 0; mm < 2; ++mm)
#pragma unroll
                    for (int bj = 0; bj < 2; ++bj)
#pragma unroll
                        for (int n = 0; n < 2; ++n) xv[mm][bj][n] = *(const f32x4*)(sp0 + (size_t)(ai * 128 + (2 * mp + mm) * 16) * 1024 + bj * 128 + n * 4);
#pragma unroll
                for (int mm = 0; mm < 2; ++mm)
#pragma unroll
                    for (int bj = 0; bj < 2; ++bj)
                        st8bf(dp0 + (size_t)(ai * 128 + (2 * mp + mm) * 16) * 1024 + bj * 128, xv[mm][bj][0] * ALPHA + gv[bj][0] * acc[ai][bj][2 * mp + mm][0], xv[mm][bj][1] * ALPHA + gv[bj][1] * acc[ai][bj][2 * mp + mm][1]);
                __builtin_amdgcn_sched_barrier(0); }
    }
};
struct PRouter {
    static constexpr int SEGT = 0; __device__ __forceinline__ const char* kA(const Unit&, int, int) const { return nullptr; } __device__ __forceinline__ const char* kB(const Unit&, int, int) const { return nullptr; }
    __device__ __forceinline__ int nt_of(const Unit&) const { return nt; }
    static constexpr bool PERM = false, GATHER = false;
    const char* A; const char* B; int nt, G, c, nM, rt0; float* logits;
    __device__ __forceinline__ bool next(int i, Unit& u) const { const long L = (long)i * G + c; if (L >= nM) return false; u.pm = rt0 + (int)L; u.pn = 0; u.aux = 0; return true; }
    __device__ __forceinline__ const char* uA(const Unit& u, int h) const { return A + (size_t)(u.pm * 256 + h * 128) * 2048; }
    __device__ __forceinline__ const char* uB(const Unit&, int h) const { return B + (size_t)(h * 128) * 2048; }
    __device__ __forceinline__ unsigned laneA(int R, int C) const { return (unsigned)(R * 2048 + C * 2); }
    __device__ __forceinline__ unsigned laneB(int R, int C) const { return (unsigned)(R * 2048 + C * 2); }
    __device__ __forceinline__ void epi(const Acc& acc, const Unit& u, int wr, int wc, int fr, int fq) const {
        if (wc >= 2) return;
#pragma unroll
        for (int ai = 0; ai < 2; ++ai)
#pragma unroll
            for (int m = 0; m < 4; ++m) { const size_t row = (size_t)(u.pm * 256 + ai * 128 + wr * 64 + m * 16 + fr);
#pragma unroll
                for (int n = 0; n < 2; ++n) *(f32x4*)(logits + row * 64 + wc * 32 + n * 16 + 4 * fq) = acc[ai][0][m][n]; }
    }
};
__device__ __forceinline__ int ld_agent_i(const int* p) { return (int)__hip_atomic_load((const unsigned*)p, __ATOMIC_RELAXED, __HIP_MEMORY_SCOPE_AGENT); }
struct PUpGate {
    static constexpr int SEGT = 0; __device__ __forceinline__ const char* kA(const Unit&, int, int) const { return nullptr; } __device__ __forceinline__ const char* kB(const Unit&, int, int) const { return nullptr; }
    __device__ __forceinline__ int nt_of(const Unit&) const { return nt; }
    static constexpr bool PERM = true, GATHER = true;
    const char* A; const char* B; int nt, G, c, ntiles; const LAS int* lrt; const LAS int* lte; u16* hb;
    __device__ __forceinline__ bool next(int i, Unit& u) const { const long L = (long)i * G + c; if (L >= 2L * ntiles) return false; u.pm = (int)(L >> 1); u.pn = (int)(L & 1); u.ord = i;
        u.aux = __builtin_amdgcn_readfirstlane(lte[u.pm]); return true; }
    __device__ __forceinline__ const char* uA(const Unit&, int) const { return A; }
    __device__ __forceinline__ const char* uB(const Unit& u, int h) const { return B + (size_t)u.aux * MiB + (size_t)(u.pn * 256 + h * 128) * 2048; }
    __device__ __forceinline__ unsigned laneA(int, int) const { return 0u; }
    __device__ __forceinline__ unsigned laneB(int R, int C) const { return (unsigned)(R * 2048 + C * 2); }
    __device__ __forceinline__ void gatherA(const Unit& u, const int (&R)[2], const int (&C)[2], unsigned (&vo)[2][2]) const {
#pragma unroll
        for (int h = 0; h < 2; ++h)
#pragma unroll
            for (int i = 0; i < 2; ++i) { int tok = lrt[u.ord * 256 + h * 128 + R[i]]; tok = tok < 0 ? 0 : tok; vo[h][i] = (unsigned)tok * 2048u + (unsigned)(C[i] * 2); }
    }
    __device__ __forceinline__ void epi(const Acc& acc, const Unit& u, int wr, int wc, int fr, int fq) const {
#pragma unroll
        for (int ai = 0; ai < 2; ++ai)
#pragma unroll
            for (int m = 0; m < 4; ++m) { const size_t row = (size_t)u.pm * 256 + ai * 128 + wr * 64 + m * 16 + fr;
                f32x4 v0, v1;
#pragma unroll
                for (int j = 0; j < 4; ++j) { v0[j] = siluf_(acc[ai][0][m][0][j]) * acc[ai][1][m][0][j]; v1[j] = siluf_(acc[ai][0][m][1][j]) * acc[ai][1][m][1][j]; }
                st8bf(hb + row * 256 + u.pn * 128 + wc * 32 + 8 * fq, v0, v1); __builtin_amdgcn_sched_barrier(0); }
    }
};
struct PDown {
    static constexpr int SEGT = 0; __device__ __forceinline__ const char* kA(const Unit&, int, int) const { return nullptr; } __device__ __forceinline__ const char* kB(const Unit&, int, int) const { return nullptr; }
    __device__ __forceinline__ int nt_of(const Unit&) const { return nt; }
    static constexpr bool PERM = true, GATHER = false;
    const char* A; const char* B; int nt, G, c, ntiles; const LAS int* lte; unsigned char* so;
    __device__ __forceinline__ bool next(int i, Unit& u) const { const long L = (long)i * G + c; if (L >= 4L * ntiles) return false; u.pm = (int)(L >> 2); u.pn = (int)(L & 3); u.ord = i;
        u.aux = __builtin_amdgcn_readfirstlane(lte[u.pm]); return true; }
    __device__ __forceinline__ const char* uA(const Unit& u, int h) const { return A + (size_t)(u.pm * 256 + h * 128) * 512; }
    __device__ __forceinline__ const char* uB(const Unit& u, int h) const { return B + (size_t)u.aux * 524288 + (size_t)(u.pn * 256 + h * 128) * 512; }
    __device__ __forceinline__ unsigned laneA(int R, int C) const { return (unsigned)(R * 512 + C * 2); }
    __device__ __forceinline__ unsigned laneB(int R, int C) const { return (unsigned)(R * 512 + C * 2); }
    __device__ __forceinline__ void epi(const Acc& acc, const Unit& u, int wr, int wc, int fr, int fq) const {
#pragma unroll
        for (int ai = 0; ai < 2; ++ai)
#pragma unroll
            for (int m = 0; m < 4; ++m) { const size_t row = (size_t)u.pm * 256 + ai * 128 + wr * 64 + m * 16 + fr;
                {
                    int w[2][2];
#pragma unroll
                    for (int bj = 0; bj < 2; ++bj) { const f32x4 v0 = acc[ai][bj][m][0], v1 = acc[ai][bj][m][1]; int w0 = 0, w1 = 0;
                        w0 = __builtin_amdgcn_cvt_pk_fp8_f32(v0[0], v0[1], w0, false); w0 = __builtin_amdgcn_cvt_pk_fp8_f32(v0[2], v0[3], w0, true);
                        w1 = __builtin_amdgcn_cvt_pk_fp8_f32(v1[0], v1[1], w1, false); w1 = __builtin_amdgcn_cvt_pk_fp8_f32(v1[2], v1[3], w1, true);
                        w[bj][0] = w0; w[bj][1] = w1; }
                    const auto r0 = __builtin_amdgcn_permlane16_swap((unsigned)w[0][0], (unsigned)w[1][0], false, false);
                    const auto r1 = __builtin_amdgcn_permlane16_swap((unsigned)w[0][1], (unsigned)w[1][1], false, false);
                    const u32x4 q = {r0[0], r1[0], r0[1], r1[1]};
                    const int colo = (fq & 1) ? 128 + 8 * (fq - 1) : 8 * fq;
                    *(u32x4*)(so + row * 1024 + u.pn * 256 + wc * 32 + colo) = q; }
                __builtin_amdgcn_sched_barrier(0); }
    }
};
namespace att {
constexpr int NW = 8, QBLK = 32, KVBLK = 64;
constexpr float SCALE = 0.125f;
constexpr float THR = 8.f;
constexpr int SHM_V = KVBLK * 128 * 2, SHM_K = KVBLK * 64 * 2, SHM_ATTN = 2 * SHM_V + 2 * SHM_K + NW * 64 * 4;
#define KSWZ64(row, colB) ((row) * 128 + ((colB) ^ (((row) & 7) << 4)))
#ifndef ATT_SGB
#define ATT_SGB 2
#endif
#ifndef ATT_DMAPOS
#define ATT_DMAPOS 1
#endif
#ifndef ATT_PRIO
#define ATT_PRIO 0
#endif
#ifndef ATT_VG
#define ATT_VG 0
#endif
#ifndef ATT_TRB
#define ATT_TRB 1
#endif
#ifndef ATT_ONES
#define ATT_ONES 0
#endif
#ifndef ATT_FIXMAX
#define ATT_FIXMAX 1
#endif
#ifndef ATT_NOSBAR
#define ATT_NOSBAR 0
#endif
#if ATT_NOSBAR
#define SBAR() do {} while (0)
#else
#define SBAR() __builtin_amdgcn_sched_barrier(0)
#endif
template <bool NOEXP = false, bool NOMAX = false>
__device__ __forceinline__ void partialSM(f32x16& p0, f32x16& p1, float& m_reg, float& mn, float& alpha) {
  constexpr float C = SCALE * 1.4426950408889634f;
  if (NOMAX) { mn = m_reg; alpha = 1.f; } else {
  float pm4[4];
#pragma unroll
  for (int k = 0; k < 4; ++k) pm4[k] = fmaxf(fmaxf(p0[k], p0[4 + k]), fmaxf(p0[8 + k], p0[12 + k]));
#pragma unroll
  for (int k = 0; k < 4; ++k) pm4[k] = fmaxf(pm4[k], fmaxf(fmaxf(p1[k], p1[4 + k]), fmaxf(p1[8 + k], p1[12 + k])));
  float pmax = fmaxf(fmaxf(pm4[0], pm4[1]), fmaxf(pm4[2], pm4[3]));
  { auto rr = __builtin_amdgcn_permlane32_swap(__float_as_uint(pmax), __float_as_uint(pmax), false, false);
    pmax = fmaxf(__uint_as_float(rr[0]), __uint_as_float(rr[1])); }
  if (__builtin_expect(__all(pmax - m_reg <= THR / SCALE), 1)) { mn = m_reg; alpha = 1.f; }
  else { mn = fmaxf(m_reg, pmax); alpha = __builtin_amdgcn_exp2f((m_reg - mn) * C); m_reg = mn; }
  }
  float mnC = -mn * C;
#pragma unroll
  for (int r = 0; r < 16; ++r) p0[r] = fmaf(p0[r], C, mnC);
#pragma unroll
  for (int r = 0; r < 16; ++r) p1[r] = fmaf(p1[r], C, mnC);
#pragma unroll
  for (int r = 0; r < 16; ++r) p0[r] = NOEXP ? p0[r] : __builtin_amdgcn_exp2f(p0[r]);
}
template <bool NOEXP = false>
__device__ __forceinline__ void finishSM(f32x16& p0, f32x16& p1, float alpha, float& l_reg, bf16x8& pa0, bf16x8& pa1, bf16x8& pa2, bf16x8& pa3) {
#pragma unroll
  for (int r = 0; r < 16; ++r) p1[r] = NOEXP ? p1[r] : __builtin_amdgcn_exp2f(p1[r]);
  float ps4[4];
#pragma unroll
  for (int k = 0; k < 4; ++k) ps4[k] = (p0[k] + p0[4 + k]) + (p0[8 + k] + p0[12 + k]);
#pragma unroll
  for (int k = 0; k < 4; ++k) ps4[k] += (p1[k] + p1[4 + k]) + (p1[8 + k] + p1[12 + k]);
  float ps = (ps4[0] + ps4[1]) + (ps4[2] + ps4[3]);
  { auto rr = __builtin_amdgcn_permlane32_swap(__float_as_uint(ps), __float_as_uint(ps), false, false);
    ps = __uint_as_float(rr[0]) + __uint_as_float(rr[1]); }
  l_reg = l_reg * alpha + ps;
#define PK4(P, BASE, OUT) do { unsigned a0 = cvtpk(P[BASE + 0], P[BASE + 1]), a1 = cvtpk(P[BASE + 2], P[BASE + 3]);   \
    unsigned b0 = cvtpk(P[BASE + 4], P[BASE + 5]), b1 = cvtpk(P[BASE + 6], P[BASE + 7]);                              \
    auto r0 = __builtin_amdgcn_permlane32_swap(a0, b0, false, false); auto r1 = __builtin_amdgcn_permlane32_swap(a1, b1, false, false); \
    u32x4 w = {r0[0], r1[0], r0[1], r1[1]}; OUT = *reinterpret_cast<bf16x8*>(&w); } while (0)
  PK4(p0, 0, pa0); PK4(p0, 8, pa1); PK4(p1, 0, pa2); PK4(p1, 8, pa3);
#undef PK4
}
__device__ __forceinline__ void qkt(f32x16& p0, f32x16& p1, const LAS char* Ks, const bf16x8* qr, int r32, int hi) {
  p0 = f32x16{}; p1 = f32x16{};
#pragma unroll
  for (int d0 = 0; d0 < 4; ++d0) { int cb = (d0 * 16 + hi * 8) * 2;
    bf16x8 b0 = *(const LAS bf16x8*)(Ks + KSWZ64(r32, cb));
    bf16x8 b1 = *(const LAS bf16x8*)(Ks + KSWZ64(32 + r32, cb));
    p0 = __builtin_amdgcn_mfma_f32_32x32x16_bf16(b0, qr[d0], p0, 0, 0, 0);
    p1 = __builtin_amdgcn_mfma_f32_32x32x16_bf16(b1, qr[d0], p1, 0, 0, 0); }
}
__device__ __forceinline__ int v_st(int k, int c) { const int kk = (k & ~0xC) | ((k & 4) << 1) | ((k & 8) >> 1); return ((kk >> 3) * 4 + (c >> 5)) * 512 + ((kk & 7) * 32 + (c & 31)) * 2; }
__device__ __forceinline__ int v_rd_base(int lane) { return ((lane & 3) << 3) | (((lane >> 2) & 3) << 6) | (((lane >> 4) & 1) << 5) | (((lane >> 5) & 1) << 8); }
constexpr int v_rd_off(int d0, int ks, int half) { return d0 * 512 + ks * 4096 + half * 2048; }
template <int OFF> __device__ __forceinline__ s16x4 tr_read(int vb) {
#if ATT_TRB
  return __builtin_bit_cast(s16x4, __builtin_amdgcn_ds_read_tr16_b64_v4i16((LAS s16x4*)(unsigned)(vb + OFF)));
#else
  s16x4 r; asm volatile("ds_read_b64_tr_b16 %0, %1 offset:%2" : "=&v"(r) : "v"(vb), "i"(OFF) : "memory"); return r;
#endif
}
template <int D0> __device__ __forceinline__ void pv_one(f32x16& od, int vb, bf16x8 pa0, bf16x8 pa1, bf16x8 pa2, bf16x8 pa3) {
  const s16x4 l0 = tr_read<v_rd_off(D0, 0, 0)>(vb), h0 = tr_read<v_rd_off(D0, 0, 1)>(vb), l1 = tr_read<v_rd_off(D0, 1, 0)>(vb), h1 = tr_read<v_rd_off(D0, 1, 1)>(vb);
  const s16x4 l2 = tr_read<v_rd_off(D0, 2, 0)>(vb), h2 = tr_read<v_rd_off(D0, 2, 1)>(vb), l3 = tr_read<v_rd_off(D0, 3, 0)>(vb), h3 = tr_read<v_rd_off(D0, 3, 1)>(vb);
  asm volatile("s_waitcnt lgkmcnt(0)" ::: "memory"); SBAR();
#define PK(L, H) (bf16x8){L[0], L[1], L[2], L[3], H[0], H[1], H[2], H[3]}
  od = __builtin_amdgcn_mfma_f32_32x32x16_bf16(pa0, PK(l0, h0), od, 0, 0, 0);
  od = __builtin_amdgcn_mfma_f32_32x32x16_bf16(pa1, PK(l1, h1), od, 0, 0, 0);
  od = __builtin_amdgcn_mfma_f32_32x32x16_bf16(pa2, PK(l2, h2), od, 0, 0, 0);
  od = __builtin_amdgcn_mfma_f32_32x32x16_bf16(pa3, PK(l3, h3), od, 0, 0, 0);
#undef PK
}
template <int D0, bool FILL> __device__ __forceinline__ void pv_fill(f32x16& od, int vb, bf16x8 pa0, bf16x8 pa1, bf16x8 pa2, bf16x8 pa3, f32x16& q0, f32x16& q1) {
  const s16x4 l0 = tr_read<v_rd_off(D0, 0, 0)>(vb), h0 = tr_read<v_rd_off(D0, 0, 1)>(vb), l1 = tr_read<v_rd_off(D0, 1, 0)>(vb), h1 = tr_read<v_rd_off(D0, 1, 1)>(vb);
  const s16x4 l2 = tr_read<v_rd_off(D0, 2, 0)>(vb), h2 = tr_read<v_rd_off(D0, 2, 1)>(vb), l3 = tr_read<v_rd_off(D0, 3, 0)>(vb), h3 = tr_read<v_rd_off(D0, 3, 1)>(vb);
  if (FILL) { if (!ATT_TRB) SBAR();
#pragma unroll
    for (int r = 4 * D0; r < 4 * D0 + 4; ++r) { q0[r] = __builtin_amdgcn_exp2f(q0[r]); q1[r] = __builtin_amdgcn_exp2f(q1[r]); }
    if (!ATT_TRB) SBAR(); }
#if !ATT_TRB
  asm volatile("s_waitcnt lgkmcnt(0)" ::: "memory"); SBAR();
#endif
#define PK(L, H) (bf16x8){L[0], L[1], L[2], L[3], H[0], H[1], H[2], H[3]}
  od = __builtin_amdgcn_mfma_f32_32x32x16_bf16(pa0, PK(l0, h0), od, 0, 0, 0);
  od = __builtin_amdgcn_mfma_f32_32x32x16_bf16(pa1, PK(l1, h1), od, 0, 0, 0);
  od = __builtin_amdgcn_mfma_f32_32x32x16_bf16(pa2, PK(l2, h2), od, 0, 0, 0);
  od = __builtin_amdgcn_mfma_f32_32x32x16_bf16(pa3, PK(l3, h3), od, 0, 0, 0);
#undef PK
}
#define SGB(mask, n) __builtin_amdgcn_sched_group_barrier(mask, n, 0)
__device__ __forceinline__ float fadd_s(float a, float b) { float r; asm("v_add_f32_e32 %0, %1, %2" : "=v"(r) : "v"(a), "v"(b)); return r; }
template <bool FILL> __device__ __forceinline__ void pv_all_sgb(f32x16* o, int vb, bf16x8 pa0, bf16x8 pa1, bf16x8 pa2, bf16x8 pa3, f32x16& q0, f32x16& q1, const f32x16& s0, const f32x16& s1, float& l_reg) {
#define PK(L, H) (bf16x8){L[0], L[1], L[2], L[3], H[0], H[1], H[2], H[3]}
#define PVB(D0) { const s16x4 l0 = tr_read<v_rd_off(D0, 0, 0)>(vb), h0 = tr_read<v_rd_off(D0, 0, 1)>(vb), l1 = tr_read<v_rd_off(D0, 1, 0)>(vb), h1 = tr_read<v_rd_off(D0, 1, 1)>(vb); \
    const s16x4 l2 = tr_read<v_rd_off(D0, 2, 0)>(vb), h2 = tr_read<v_rd_off(D0, 2, 1)>(vb), l3 = tr_read<v_rd_off(D0, 3, 0)>(vb), h3 = tr_read<v_rd_off(D0, 3, 1)>(vb); \
    if (FILL) { _Pragma("unroll") for (int r = 4 * D0; r < 4 * D0 + 4; ++r) { q0[r] = __builtin_amdgcn_exp2f(q0[r]); q1[r] = __builtin_amdgcn_exp2f(q1[r]); } } \
    o[D0] = __builtin_amdgcn_mfma_f32_32x32x16_bf16(pa0, PK(l0, h0), o[D0], 0, 0, 0); o[D0] = __builtin_amdgcn_mfma_f32_32x32x16_bf16(pa1, PK(l1, h1), o[D0], 0, 0, 0); \
    o[D0] = __builtin_amdgcn_mfma_f32_32x32x16_bf16(pa2, PK(l2, h2), o[D0], 0, 0, 0); o[D0] = __builtin_amdgcn_mfma_f32_32x32x16_bf16(pa3, PK(l3, h3), o[D0], 0, 0, 0); }
  PVB(0) PVB(1) PVB(2) PVB(3)
#undef PVB
#undef PK
  SGB(0x100, 8);
#pragma unroll
  for (int i = 0; i < 16; ++i) { SGB(0x008, 1); if (FILL) SGB(0x400, 2); SGB(0x100, 2); }
  asm volatile("" : "+v"(o[0]), "+v"(o[1]), "+v"(o[2]), "+v"(o[3]));
  SBAR();
}
__device__ __forceinline__ void pv_d0(f32x16* o, int vb, bf16x8 pa0, bf16x8 pa1, bf16x8 pa2, bf16x8 pa3) {
  pv_one<0>(o[0], vb, pa0, pa1, pa2, pa3); pv_one<1>(o[1], vb, pa0, pa1, pa2, pa3); pv_one<2>(o[2], vb, pa0, pa1, pa2, pa3); pv_one<3>(o[3], vb, pa0, pa1, pa2, pa3);
}
__device__ __forceinline__ void attn_unit(const u16* __restrict__ Q, const u16* __restrict__ K, const u16* __restrict__ V, u16* __restrict__ On,
                                          int qrow0, int b, int h, int map, int NT, LAS char* lds) {
  int tid_ = threadIdx.x; asm volatile("" : "+v"(tid_));
  const int tid = tid_, wid = tid >> 6, lane = tid & 63, r32 = lane & 31, hi = lane >> 5;
  LAS char* V_lds = lds; LAS char* K_lds = lds + 2 * SHM_V;
  LAS float* ws = (LAS float*)(lds + 2 * SHM_V + 2 * SHM_K) + wid * 64; LAS float* li_l = ws; LAS float* al_l = ws + 32;
  float m_reg = -1e30f, l_reg = 0; f32x16 o[4] = {}; bf16x8 qr[4];
  const u16* Qw = Q + (size_t)(qrow0 + wid * QBLK + r32) * 512 + h * 128 + map * 64 + hi * 8;
#pragma unroll
  for (int d0 = 0; d0 < 4; ++d0) qr[d0] = *reinterpret_cast<const bf16x8*>(Qw + d0 * 16);
  const int sr = tid >> 4, sc = (tid & 15) * 8, vst0 = v_st(sr, sc), vst1 = v_st(32 + sr, sc);
  const int kr = tid >> 3, kc = (tid & 7) * 8, kst = KSWZ64(kr, kc * 2);
  const int vb0 = (int)(uintptr_t)V_lds + v_rd_base(lane);
  const u16* Kc = K + h * 128 + map * 64 + kc; const u16* Vc = V + h * 128 + sc;
  struct { bf16x8 vs0, vs1, ks0; } sr_[2];
#define KROW(k0) ((k0) < LC ? b * LC + (k0) : TC + b * SEQ + (k0) - LC)
#define SLOAD(i, k0) do { const size_t _r = (size_t)KROW(k0); sr_[i].vs0 = *reinterpret_cast<const bf16x8*>(Vc + (_r + sr) * 512); sr_[i].vs1 = *reinterpret_cast<const bf16x8*>(Vc + (_r + 32 + sr) * 512); \
    sr_[i].ks0 = *reinterpret_cast<const bf16x8*>(Kc + (_r + kr) * 512); } while (0)
#define SWRITE(bb, i) do { *(LAS bf16x8*)(V_lds + (bb) * SHM_V + vst0) = sr_[i].vs0; *(LAS bf16x8*)(V_lds + (bb) * SHM_V + vst1) = sr_[i].vs1; \
    *(LAS bf16x8*)(K_lds + (bb) * SHM_K + kst) = sr_[i].ks0; } while (0)
#define SWAIT() asm volatile("s_waitcnt vmcnt(3)" ::: "memory")
#define RESC(a) do { if (__any((a) < 1.f)) { if (hi == 0) al_l[r32] = (a); asm volatile("s_waitcnt lgkmcnt(0)" ::: "memory"); \
    _Pragma("unroll") for (int d = 0; d < 4; ++d) _Pragma("unroll") for (int r = 0; r < 16; ++r) o[d][r] *= al_l[crow(r, hi)]; } } while (0)
  f32x16 pA0, pA1, pB0, pB1; float mnA, mnB, alA, alB; bf16x8 pa0, pa1, pa2, pa3;
  constexpr int SE = 0, SO = 1;
  SLOAD(SE, 0); asm volatile("s_waitcnt vmcnt(0)" ::: "memory"); SWRITE(0, SE); __syncthreads();
  qkt(pA0, pA1, K_lds, qr, r32, hi); partialSM(pA0, pA1, m_reg, mnA, alA);
  SLOAD(SO, KVBLK); if (2 < NT) SLOAD(SE, 2 * KVBLK);
  SWAIT(); SWRITE(1, SO); __syncthreads();
  for (int j = 1; j + 1 < NT; j += 2) {
    SBAR(); qkt(pB0, pB1, K_lds + SHM_K, qr, r32, hi);
    finishSM(pA0, pA1, alA, l_reg, pa0, pa1, pa2, pa3); SBAR();
    SLOAD(SO, (j + 2) * KVBLK); SBAR();
    pv_d0(o, vb0, pa0, pa1, pa2, pa3); partialSM(pB0, pB1, m_reg, mnB, alB);
    __syncthreads(); SWAIT(); SWRITE(0, SE);
    RESC(alB); __syncthreads();
    SBAR(); qkt(pA0, pA1, K_lds, qr, r32, hi);
    finishSM(pB0, pB1, alB, l_reg, pa0, pa1, pa2, pa3); SBAR();
    if (j + 3 < NT) SLOAD(SE, (j + 3) * KVBLK); SBAR();
    pv_d0(o, vb0 + SHM_V, pa0, pa1, pa2, pa3); partialSM(pA0, pA1, m_reg, mnA, alA);
    __syncthreads(); SWAIT(); SWRITE(1, SO);
    RESC(alA); __syncthreads();
  }
  SBAR(); qkt(pB0, pB1, K_lds + SHM_K, qr, r32, hi);
  finishSM(pA0, pA1, alA, l_reg, pa0, pa1, pa2, pa3); SBAR();
  pv_d0(o, vb0, pa0, pa1, pa2, pa3); partialSM(pB0, pB1, m_reg, mnB, alB);
  __syncthreads(); RESC(alB);
  finishSM(pB0, pB1, alB, l_reg, pa0, pa1, pa2, pa3); SBAR();
  pv_d0(o, vb0 + SHM_V, pa0, pa1, pa2, pa3);
  if (hi == 0) li_l[r32] = l_reg; asm volatile("s_waitcnt lgkmcnt(0)" ::: "memory");
  float rli[16];
#pragma unroll
  for (int r = 0; r < 16; ++r) rli[r] = __builtin_amdgcn_rcpf(li_l[crow(r, hi)]);
  u16* Ow = On + (size_t)(qrow0 + wid * QBLK) * 512 + h * 128;
#pragma unroll
  for (int r = 0; r < 16; ++r) { int orow = crow(r, hi);
#pragma unroll
    for (int d0 = 0; d0 < 4; ++d0) Ow[(size_t)orow * 512 + d0 * 32 + r32] = f2bf(o[d0][r] * rli[r]); }
  __syncthreads();
#undef KROW
#undef SLOAD
#undef SWRITE
#undef SWAIT
#undef RESC
}
template <int AD = 0>
__device__ __forceinline__ void attn_unit_dma(const u16* __restrict__ Q, const u16* __restrict__ K, const u16* __restrict__ V, u16* __restrict__ On,
                                              int qrow0, int b, int h, int map, int NT, LAS char* lds) {
  int tid_ = threadIdx.x; asm volatile("" : "+v"(tid_));
  const int tid = tid_, wid = __builtin_amdgcn_readfirstlane(tid >> 6), lane = tid & 63, r32 = lane & 31, hi = lane >> 5;
  LAS char* V_lds = lds; LAS char* K_lds = lds + 4 * SHM_V;
  f32x16 o[4] = {}; f32x16 o5 = {}; bf16x8 qr[4];
  const bf16x8 ONES = {(short)0x3F80, (short)0x3F80, (short)0x3F80, (short)0x3F80, (short)0x3F80, (short)0x3F80, (short)0x3F80, (short)0x3F80};
  const u16* Qw = Q + (size_t)(qrow0 + wid * QBLK + r32) * 512 + h * 128 + map * 64 + hi * 8;
#pragma unroll
  for (int d0 = 0; d0 < 4; ++d0) qr[d0] = *reinterpret_cast<const bf16x8*>(Qw + d0 * 16);
  const int vb0 = (int)(uintptr_t)V_lds + v_rd_base(lane);
  unsigned vsrc[2], ksrc;
#pragma unroll
  for (int i = 0; i < 2; ++i) { const int B = (tid + 512 * i) * 16, st = B >> 9, off = B & 511, kk = (st >> 2) * 8 + (off >> 6), c = (st & 3) * 32 + ((off & 63) >> 1);
    const int k = (kk & ~0xC) | ((kk & 4) << 1) | ((kk & 8) >> 1);
    vsrc[i] = (unsigned)(k * 512 + h * 128 + c); }
  { const int row = tid >> 3, colB = ((tid & 7) * 16) ^ ((row & 7) << 4); ksrc = (unsigned)(row * 512 + h * 128 + map * 64 + (colB >> 1)); }
#define KROW(k0) ((k0) < LC ? b * LC + (k0) : TC + b * SEQ + (k0) - LC)
#define DMA_TILE(t) do { const size_t _r = (size_t)KROW((t) * KVBLK) * 512; const int _s = (t) & 3; \
    __builtin_amdgcn_global_load_lds((const unsigned*)(V + _r + vsrc[0]), (LAS unsigned*)(V_lds + _s * SHM_V + wid * 1024), 16, 0, 0); \
    __builtin_amdgcn_global_load_lds((const unsigned*)(V + _r + vsrc[1]), (LAS unsigned*)(V_lds + _s * SHM_V + 8192 + wid * 1024), 16, 0, 0); \
    __builtin_amdgcn_global_load_lds((const unsigned*)(K + _r + ksrc), (LAS unsigned*)(K_lds + _s * SHM_K + wid * 1024), 16, 0, 0); } while (0)
#define DMA_TILE_C(t) do { const int _tc = (t) < NT ? (t) : NT - 1; const size_t _r = (size_t)KROW(_tc * KVBLK) * 512; const int _s = (t) & 3; \
    __builtin_amdgcn_global_load_lds((const unsigned*)(V + _r + vsrc[0]), (LAS unsigned*)(V_lds + _s * SHM_V + wid * 1024), 16, 0, 0); \
    __builtin_amdgcn_global_load_lds((const unsigned*)(V + _r + vsrc[1]), (LAS unsigned*)(V_lds + _s * SHM_V + 8192 + wid * 1024), 16, 0, 0); \
    __builtin_amdgcn_global_load_lds((const unsigned*)(K + _r + ksrc), (LAS unsigned*)(K_lds + _s * SHM_K + wid * 1024), 16, 0, 0); } while (0)
#define TILE_READY_U() do { asm volatile("s_waitcnt vmcnt(3)" ::: "memory"); __builtin_amdgcn_s_barrier(); asm volatile("" ::: "memory"); } while (0)
#define TILE_READY(t) do { if ((t) + 1 < NT) asm volatile("s_waitcnt vmcnt(3)" ::: "memory"); else asm volatile("s_waitcnt vmcnt(0)" ::: "memory"); \
    __builtin_amdgcn_s_barrier(); asm volatile("" ::: "memory"); } while (0)
#define SM_EXP(P0, P1) do { if (AD != 5) { _Pragma("unroll") for (int r = 0; r < 16; ++r) { P0[r] = __builtin_amdgcn_exp2f(P0[r]); P1[r] = __builtin_amdgcn_exp2f(P1[r]); } } } while (0)
#define PK4(P, BASE, OUT) do { unsigned a0 = cvtpk(P[BASE + 0], P[BASE + 1]), a1 = cvtpk(P[BASE + 2], P[BASE + 3]);   \
    unsigned b0 = cvtpk(P[BASE + 4], P[BASE + 5]), b1 = cvtpk(P[BASE + 6], P[BASE + 7]);                              \
    auto r0 = __builtin_amdgcn_permlane32_swap(a0, b0, false, false); auto r1 = __builtin_amdgcn_permlane32_swap(a1, b1, false, false); \
    u32x4 w = {r0[0], r1[0], r0[1], r1[1]}; OUT = *reinterpret_cast<bf16x8*>(&w); } while (0)
#define SM_PACK(P0, P1) do { if (AD != 5) { if (ATT_SGB) { float t[8]; _Pragma("unroll") for (int k = 0; k < 4; ++k) { t[k] = fadd_s(fadd_s(P0[k], P0[4 + k]), fadd_s(P0[8 + k], P0[12 + k])); t[4 + k] = fadd_s(fadd_s(P1[k], P1[4 + k]), fadd_s(P1[8 + k], P1[12 + k])); } \
        l_reg = fadd_s(l_reg, fadd_s(fadd_s(fadd_s(t[0], t[1]), fadd_s(t[2], t[3])), fadd_s(fadd_s(t[4], t[5]), fadd_s(t[6], t[7])))); } \
        else if (!ATT_ONES) { float ps4[4]; _Pragma("unroll") for (int k = 0; k < 4; ++k) ps4[k] = ((P0[k] + P0[4 + k]) + (P0[8 + k] + P0[12 + k])) + ((P1[k] + P1[4 + k]) + (P1[8 + k] + P1[12 + k])); \
        l_reg += (ps4[0] + ps4[1]) + (ps4[2] + ps4[3]); } \
        PK4(P0, 0, pa0); PK4(P0, 8, pa1); PK4(P1, 0, pa2); PK4(P1, 8, pa3); } } while (0)
#define PV_ALL(vb, Q0, Q1, S0, S1) do { if (ATT_SGB) { if (AD != 3) pv_all_sgb<AD != 5>(o, (vb), pa0, pa1, pa2, pa3, Q0, Q1, S0, S1, l_reg); } else if (AD != 3) { pv_fill<0, AD != 5>(o[0], (vb), pa0, pa1, pa2, pa3, Q0, Q1); pv_fill<1, AD != 5>(o[1], (vb), pa0, pa1, pa2, pa3, Q0, Q1); \
        pv_fill<2, AD != 5>(o[2], (vb), pa0, pa1, pa2, pa3, Q0, Q1); pv_fill<3, AD != 5>(o[3], (vb), pa0, pa1, pa2, pa3, Q0, Q1); } \
    if (ATT_ONES) { o5 = __builtin_amdgcn_mfma_f32_32x32x16_bf16(pa0, ONES, o5, 0, 0, 0); o5 = __builtin_amdgcn_mfma_f32_32x32x16_bf16(pa1, ONES, o5, 0, 0, 0); \
    o5 = __builtin_amdgcn_mfma_f32_32x32x16_bf16(pa2, ONES, o5, 0, 0, 0); o5 = __builtin_amdgcn_mfma_f32_32x32x16_bf16(pa3, ONES, o5, 0, 0, 0); } } while (0)
  float l_reg = 0.f;
  f32x16 pA0 = {}, pA1 = {}, pB0 = {}, pB1 = {}; bf16x8 pa0 = {}, pa1 = {}, pa2 = {}, pa3 = {};
  DMA_TILE(0); DMA_TILE(1); DMA_TILE(2);
  asm volatile("s_waitcnt vmcnt(6)" ::: "memory"); __builtin_amdgcn_s_barrier(); asm volatile("" ::: "memory");
  if (AD != 4) qkt(pA0, pA1, K_lds, qr, r32, hi); SM_EXP(pA0, pA1);
  TILE_READY(1); DMA_TILE(3);
  for (int j = 1; j + 1 < NT; j += 2) {
    SBAR(); if (AD != 4) qkt(pB0, pB1, K_lds + (j & 3) * SHM_K, qr, r32, hi);
    SM_PACK(pA0, pA1); SBAR();
    PV_ALL(vb0 + ((j - 1) & 3) * SHM_V, pB0, pB1, pA0, pA1);
    if (ATT_SGB) { TILE_READY_U(); DMA_TILE_C(j + 3); } else { TILE_READY(j + 1); if (j + 3 < NT) DMA_TILE(j + 3); }
    SBAR(); if (AD != 4) qkt(pA0, pA1, K_lds + ((j + 1) & 3) * SHM_K, qr, r32, hi);
    SM_PACK(pB0, pB1); SBAR();
    PV_ALL(vb0 + (j & 3) * SHM_V, pA0, pA1, pB0, pB1);
    if (ATT_SGB) { TILE_READY_U(); DMA_TILE_C(j + 4); } else { TILE_READY(j + 2); if (j + 4 < NT) DMA_TILE(j + 4); }
  }
  if (ATT_SGB) asm volatile("s_waitcnt vmcnt(0)" ::: "memory");
  SBAR(); if (AD != 4) qkt(pB0, pB1, K_lds + ((NT - 1) & 3) * SHM_K, qr, r32, hi);
  SM_PACK(pA0, pA1); SBAR();
  PV_ALL(vb0 + ((NT - 2) & 3) * SHM_V, pB0, pB1, pA0, pA1);
  SM_PACK(pB0, pB1); SBAR();
  { f32x16 d0_ = {}, d1_ = {}; PV_ALL(vb0 + ((NT - 1) & 3) * SHM_V, d0_, d1_, pB0, pB1); }
  float rli[16];
  if (ATT_ONES) {
#pragma unroll
    for (int r = 0; r < 16; ++r) rli[r] = __builtin_amdgcn_rcpf(o5[r]);
  } else {
    { auto rr = __builtin_amdgcn_permlane32_swap(__float_as_uint(l_reg), __float_as_uint(l_reg), false, false); l_reg = __uint_as_float(rr[0]) + __uint_as_float(rr[1]); }
    LAS float* li_l = (LAS float*)(lds + 4 * SHM_V + 4 * SHM_K) + wid * 64;
    if (hi == 0) li_l[r32] = l_reg; asm volatile("s_waitcnt lgkmcnt(0)" ::: "memory");
#pragma unroll
    for (int r = 0; r < 16; ++r) rli[r] = __builtin_amdgcn_rcpf(li_l[crow(r, hi)]);
  }
  u16* Ow = On + (size_t)(qrow0 + wid * QBLK) * 512 + h * 128;
#pragma unroll
  for (int r = 0; r < 16; ++r) { int orow = crow(r, hi);
#pragma unroll
    for (int d0 = 0; d0 < 4; ++d0) Ow[(size_t)orow * 512 + d0 * 32 + r32] = f2bf(o[d0][r] * rli[r]); }
  __syncthreads();
#undef KROW
#undef DMA_TILE
#undef TILE_READY
#undef TILE_READY_U
#undef DMA_TILE_C
#undef SM_EXP
#undef PK4
#undef SM_PACK
#undef PV_ALL
}
__device__ __forceinline__ void pk4_(const f32x16& P, int BASE, bf16x8& OUT) {
  const unsigned a0 = cvtpk(P[BASE + 0], P[BASE + 1]), a1 = cvtpk(P[BASE + 2], P[BASE + 3]), b0 = cvtpk(P[BASE + 4], P[BASE + 5]), b1 = cvtpk(P[BASE + 6], P[BASE + 7]);
  auto r0 = __builtin_amdgcn_permlane32_swap(a0, b0, false, false); auto r1 = __builtin_amdgcn_permlane32_swap(a1, b1, false, false);
  u32x4 w = {r0[0], r1[0], r0[1], r1[1]}; OUT = *reinterpret_cast<bf16x8*>(&w);
}
template <int FILL> __device__ __forceinline__ void pv_seg(f32x16* o, int vb, const bf16x8* pc, f32x16& q0, f32x16& q1, bf16x8* pn) {
  if (ATT_PRIO == 1) __builtin_amdgcn_s_setprio(1);
#define PK(L, H) (bf16x8){L[0], L[1], L[2], L[3], H[0], H[1], H[2], H[3]}
#define PVB(D0) { const s16x4 l0 = tr_read<v_rd_off(D0, 0, 0)>(vb), h0 = tr_read<v_rd_off(D0, 0, 1)>(vb), l1 = tr_read<v_rd_off(D0, 1, 0)>(vb), h1 = tr_read<v_rd_off(D0, 1, 1)>(vb); \
    const s16x4 l2 = tr_read<v_rd_off(D0, 2, 0)>(vb), h2 = tr_read<v_rd_off(D0, 2, 1)>(vb), l3 = tr_read<v_rd_off(D0, 3, 0)>(vb), h3 = tr_read<v_rd_off(D0, 3, 1)>(vb); \
    o[D0] = __builtin_amdgcn_mfma_f32_32x32x16_bf16(pc[0], PK(l0, h0), o[D0], 0, 0, 0); o[D0] = __builtin_amdgcn_mfma_f32_32x32x16_bf16(pc[1], PK(l1, h1), o[D0], 0, 0, 0); \
    o[D0] = __builtin_amdgcn_mfma_f32_32x32x16_bf16(pc[2], PK(l2, h2), o[D0], 0, 0, 0); o[D0] = __builtin_amdgcn_mfma_f32_32x32x16_bf16(pc[3], PK(l3, h3), o[D0], 0, 0, 0); }
  PVB(0) PVB(1) PVB(2) PVB(3)
#undef PVB
#undef PK
  if (FILL) {
#pragma unroll
    for (int r = 0; r < 16; ++r) q0[r] = __builtin_amdgcn_exp2f(q0[r]);
#pragma unroll
    for (int r = 0; r < 16; ++r) q1[r] = __builtin_amdgcn_exp2f(q1[r]);
    pk4_(q0, 0, pn[0]); pk4_(q0, 8, pn[1]); pk4_(q1, 0, pn[2]); pk4_(q1, 8, pn[3]);
  }
  SGB(0x100, 8);
#pragma unroll
  for (int i = 0; i < 16; ++i) { SGB(0x008, 1); if (FILL) { SGB(0x400, 2); if (ATT_VG) SGB(0x002, ATT_VG); } SGB(0x100, 2); }
  if (FILL) asm volatile("" : "+v"(o[0]), "+v"(o[1]), "+v"(o[2]), "+v"(o[3]), "+v"(pn[0]), "+v"(pn[1]), "+v"(pn[2]), "+v"(pn[3]));
  else asm volatile("" : "+v"(o[0]), "+v"(o[1]), "+v"(o[2]), "+v"(o[3]));
  if (ATT_PRIO == 1) __builtin_amdgcn_s_setprio(0);
  SBAR();
}
__device__ __forceinline__ void row_sums(const f32x16& P0, const f32x16& P1, float& l_reg) {
  float t[8];
#pragma unroll
  for (int k = 0; k < 4; ++k) { t[k] = fadd_s(fadd_s(P0[k], P0[4 + k]), fadd_s(P0[8 + k], P0[12 + k])); t[4 + k] = fadd_s(fadd_s(P1[k], P1[4 + k]), fadd_s(P1[8 + k], P1[12 + k])); }
  l_reg = fadd_s(l_reg, fadd_s(fadd_s(fadd_s(t[0], t[1]), fadd_s(t[2], t[3])), fadd_s(fadd_s(t[4], t[5]), fadd_s(t[6], t[7]))));
}
__device__ __forceinline__ void attn_unit_sgb(const u16* __restrict__ Q, const u16* __restrict__ K, const u16* __restrict__ V, u16* __restrict__ On,
                                              int qrow0, int b, int h, int map, int NT, LAS char* lds) {
  int tid_ = threadIdx.x; asm volatile("" : "+v"(tid_));
  const int tid = tid_, wid = __builtin_amdgcn_readfirstlane(tid >> 6), lane = tid & 63, r32 = lane & 31, hi = lane >> 5;
  LAS char* V_lds = lds; LAS char* K_lds = lds + 4 * SHM_V;
  f32x16 o[4] = {}; bf16x8 qr[4];
  const u16* Qw = Q + (size_t)(qrow0 + wid * QBLK + r32) * 512 + h * 128 + map * 64 + hi * 8;
#pragma unroll
  for (int d0 = 0; d0 < 4; ++d0) qr[d0] = *reinterpret_cast<const bf16x8*>(Qw + d0 * 16);
  const int vb0 = (int)(uintptr_t)V_lds + v_rd_base(lane);
  unsigned vsrc[2], ksrc;
#pragma unroll
  for (int i = 0; i < 2; ++i) { const int B = (tid + 512 * i) * 16, st = B >> 9, off = B & 511, kk = (st >> 2) * 8 + (off >> 6), c = (st & 3) * 32 + ((off & 63) >> 1);
    const int k = (kk & ~0xC) | ((kk & 4) << 1) | ((kk & 8) >> 1);
    vsrc[i] = (unsigned)(k * 512 + h * 128 + c); }
  { const int row = tid >> 3, colB = ((tid & 7) * 16) ^ ((row & 7) << 4); ksrc = (unsigned)(row * 512 + h * 128 + map * 64 + (colB >> 1)); }
#define KROW(k0) ((k0) < LC ? b * LC + (k0) : TC + b * SEQ + (k0) - LC)
#define DMA_TILE_C(t) do { const int _tc = (t) < NT ? (t) : NT - 1; const size_t _r = (size_t)KROW(_tc * KVBLK) * 512; const int _s = (t) & 3; \
    __builtin_amdgcn_global_load_lds((const unsigned*)(V + _r + vsrc[0]), (LAS unsigned*)(V_lds + _s * SHM_V + wid * 1024), 16, 0, 0); \
    __builtin_amdgcn_global_load_lds((const unsigned*)(V + _r + vsrc[1]), (LAS unsigned*)(V_lds + _s * SHM_V + 8192 + wid * 1024), 16, 0, 0); \
    __builtin_amdgcn_global_load_lds((const unsigned*)(K + _r + ksrc), (LAS unsigned*)(K_lds + _s * SHM_K + wid * 1024), 16, 0, 0); } while (0)
#define TILE_READY_U() do { asm volatile("s_waitcnt vmcnt(3)" ::: "memory"); __builtin_amdgcn_s_barrier(); asm volatile("" ::: "memory"); } while (0)
  float l_reg = 0.f;
  if (ATT_PRIO == 2 && wid >= 4) __builtin_amdgcn_s_setprio(1);
  f32x16 pA0 = {}, pA1 = {}, pB0 = {}, pB1 = {}; bf16x8 paA[4] = {}, paB[4] = {};
  DMA_TILE_C(0); DMA_TILE_C(1); DMA_TILE_C(2);
  asm volatile("s_waitcnt vmcnt(6)" ::: "memory"); __builtin_amdgcn_s_barrier(); asm volatile("" ::: "memory");
  qkt(pA0, pA1, K_lds, qr, r32, hi);
#pragma unroll
  for (int r = 0; r < 16; ++r) { pA0[r] = __builtin_amdgcn_exp2f(pA0[r]); pA1[r] = __builtin_amdgcn_exp2f(pA1[r]); }
  pk4_(pA0, 0, paA[0]); pk4_(pA0, 8, paA[1]); pk4_(pA1, 0, paA[2]); pk4_(pA1, 8, paA[3]);
  TILE_READY_U(); if (ATT_DMAPOS == 0) DMA_TILE_C(3);
  for (int j = 1; j + 1 < NT; j += 2) {
    SBAR(); qkt(pB0, pB1, K_lds + (j & 3) * SHM_K, qr, r32, hi); row_sums(pA0, pA1, l_reg); SBAR();
    if (ATT_DMAPOS == 1) { DMA_TILE_C(j + 2); SBAR(); }
    pv_seg<1>(o, vb0 + ((j - 1) & 3) * SHM_V, paA, pB0, pB1, paB);
    TILE_READY_U(); if (ATT_DMAPOS == 0) DMA_TILE_C(j + 3);
    SBAR(); qkt(pA0, pA1, K_lds + ((j + 1) & 3) * SHM_K, qr, r32, hi); row_sums(pB0, pB1, l_reg); SBAR();
    if (ATT_DMAPOS == 1) { DMA_TILE_C(j + 3); SBAR(); }
    pv_seg<1>(o, vb0 + (j & 3) * SHM_V, paB, pA0, pA1, paA);
    TILE_READY_U(); if (ATT_DMAPOS == 0) DMA_TILE_C(j + 4);
  }
  asm volatile("s_waitcnt vmcnt(0)" ::: "memory");
  SBAR(); qkt(pB0, pB1, K_lds + ((NT - 1) & 3) * SHM_K, qr, r32, hi); row_sums(pA0, pA1, l_reg); SBAR();
  pv_seg<1>(o, vb0 + ((NT - 2) & 3) * SHM_V, paA, pB0, pB1, paB);
  row_sums(pB0, pB1, l_reg); SBAR();
  pv_seg<0>(o, vb0 + ((NT - 1) & 3) * SHM_V, paB, pA0, pA1, paA);
  float rli[16];
  { auto rr = __builtin_amdgcn_permlane32_swap(__float_as_uint(l_reg), __float_as_uint(l_reg), false, false); l_reg = __uint_as_float(rr[0]) + __uint_as_float(rr[1]); }
  LAS float* li_l = (LAS float*)(lds + 4 * SHM_V + 4 * SHM_K) + wid * 64;
  if (hi == 0) li_l[r32] = l_reg; asm volatile("s_waitcnt lgkmcnt(0)" ::: "memory");
#pragma unroll
  for (int r = 0; r < 16; ++r) rli[r] = __builtin_amdgcn_rcpf(li_l[crow(r, hi)]);
  u16* Ow = On + (size_t)(qrow0 + wid * QBLK) * 512 + h * 128;
#pragma unroll
  for (int r = 0; r < 16; ++r) { int orow = crow(r, hi);
#pragma unroll
    for (int d0 = 0; d0 < 4; ++d0) Ow[(size_t)orow * 512 + d0 * 32 + r32] = f2bf(o[d0][r] * rli[r]); }
  if (ATT_PRIO == 2) __builtin_amdgcn_s_setprio(0);
  __syncthreads();
#undef KROW
#undef DMA_TILE_C
#undef TILE_READY_U
}
}

namespace hg {
constexpr int RS = 136, RS2 = 72;
constexpr int O_QH = 0, O_KH = 17408, O_KB = 35840, O_QQ = 48896, O_QD = 75008, O_KD = 92416, O_VT = 109824, O_PP = 119040, O_ST = 128256, O_TOT = 145664, O_DEC = 153856, O_END = 154368;
__device__ __forceinline__ void h4(const u32x2& w, float (&f)[4]) {
    f[0] = (float)__builtin_bit_cast(_Float16, (u16)(w[0] & 0xffffu)); f[1] = (float)__builtin_bit_cast(_Float16, (u16)(w[0] >> 16));
    f[2] = (float)__builtin_bit_cast(_Float16, (u16)(w[1] & 0xffffu)); f[3] = (float)__builtin_bit_cast(_Float16, (u16)(w[1] >> 16));
}
__device__ __forceinline__ void b4(const u32x2& w, float (&f)[4]) { f[0] = bf2f(w[0] & 0xffffu); f[1] = bf2f(w[0] >> 16); f[2] = bf2f(w[1] & 0xffffu); f[3] = bf2f(w[1] >> 16); }
__device__ __forceinline__ u32x2 pk4(float a, float b, float c, float d) { u32x2 w = {cvtpk(a, b), cvtpk(c, d)}; return w; }
template <int HD = 0>
__device__ __forceinline__ void hgrn_unit(unsigned char* ws, LAS unsigned char* lds, int layer, int b, int h, int dir, int eh) {
    int tid_ = threadIdx.x; asm volatile("" : "+v"(tid_));
    const int tid = tid_, wid = __builtin_amdgcn_readfirstlane(tid >> 6), lane = tid & 63;
    const u16* QHg = (const u16*)(ws + WS_P0);
    const u16* LFg = (const u16*)(ws + (dir ? WS_P2 : WS_P1));
    const u16* VVg = (const u16*)(ws + WS_P3);
    u16* OOg = (u16*)(ws + (HD ? WS_TT : (dir ? WS_OB : WS_OF)));
    LAS u16* sQH = (LAS u16*)(lds + O_QH); LAS u16* sKH = (LAS u16*)(lds + O_KH); LAS u16* sKB = (LAS u16*)(lds + O_KB); LAS u16* sQQ = (LAS u16*)(lds + O_QQ);
    LAS u16* sQD = (LAS u16*)(lds + O_QD); LAS u16* sKD = (LAS u16*)(lds + O_KD); LAS u16* sVT = (LAS u16*)(lds + O_VT); LAS u16* sPP = (LAS u16*)(lds + O_PP);
    LAS u16* sST = (LAS u16*)(lds + O_ST); LAS float* sTOT = (LAS float*)(lds + O_TOT); LAS float* sDEC = (LAS float*)(lds + O_DEC);
    for (int i = tid; i < (O_TOT - O_PP) / 4; i += 512) ((LAS unsigned*)(lds + O_PP))[i] = 0u;
    f32x16 S = {};
    __syncthreads();
    const int cq = tid & 31, rg = tid >> 5, d0 = 4 * cq, sb = wid >> 1;
    const int e4 = tid & 15, s2 = tid >> 4;
    const int l15 = lane & 15, q4 = lane >> 4, l32 = lane & 31, hi = lane >> 5;
    const int dt = wid >> 1, et = wid & 1;
    u32x2 pg[4], pq[4], pv[2];
#define HG_LOAD(c_) do { const bool ic_ = (c_) < 4; const int cc_ = ic_ ? (c_) : (c_) - 4, ls_ = ic_ ? LC : SEQ, rb_ = ic_ ? b * LC : TC + b * SEQ; \
        _Pragma("unroll") for (int r = 0; r < 4; ++r) { int pos = 64 * cc_ + 4 * rg + r; if (dir) pos = ls_ - 1 - pos; const size_t row = (size_t)(rb_ + pos); \
            pg[r] = *(const u32x2*)(LFg + row * 512 + h * 128 + d0); pq[r] = *(const u32x2*)(QHg + row * 512 + h * 128 + d0); } \
        _Pragma("unroll") for (int r = 0; r < 2; ++r) { int pos = 64 * cc_ + 2 * s2 + r; if (dir) pos = ls_ - 1 - pos; \
            pv[r] = *(const u32x2*)(VVg + (size_t)(rb_ + pos) * 512 + h * 128 + eh * 64 + 4 * e4); } } while (0)
    if (wid >= 4 || wid < 2) __builtin_amdgcn_s_setprio(1);
    HG_LOAD(0);
    for (int c = 0; c < 36; ++c) {
        const bool isctx = c < 4; const int cc = isctx ? c : c - 4, lseg = isctx ? LC : SEQ, rowbase = isctx ? b * LC : TC + b * SEQ;
        const bool need_o = !(layer == DEPTH - 1 && isctx);
        float g[4][4], q[4][4], bl[4][4];
#pragma unroll
        for (int r = 0; r < 4; ++r) { h4(pg[r], g[r]); b4(pq[r], q[r]); }
#pragma unroll
        for (int cl = 0; cl < 4; ++cl) { float run = 0.f;
#pragma unroll
            for (int r = 0; r < 4; ++r) { run += g[r][cl]; bl[r][cl] = run; } }
        *(LAS f32x4*)(sTOT + rg * 128 + d0) = (f32x4){bl[3][0], bl[3][1], bl[3][2], bl[3][3]};
        const u32x2 v0 = pv[0], v1 = pv[1];
        __syncthreads();
        if (c > 0) {
#pragma unroll
            for (int rg4 = 0; rg4 < 4; ++rg4) { u32x2 w = {cvtpk(S[4 * rg4], S[4 * rg4 + 1]), cvtpk(S[4 * rg4 + 2], S[4 * rg4 + 3])};
                *(LAS u32x2*)(sST + (32 * et + l32) * RS + 32 * dt + 8 * rg4 + 4 * hi) = w; }
        }
#define EXPF(x) (HD == 2 ? (x) : __builtin_amdgcn_exp2f(x))
        if (HD != 4) {
            f32x4 Sb[4];
#pragma unroll
            for (int k4 = 0; k4 < 4; ++k4) Sb[k4] = (*(const LAS f32x4*)(sTOT + (4 * k4) * 128 + d0) + *(const LAS f32x4*)(sTOT + (4 * k4 + 1) * 128 + d0)) + (*(const LAS f32x4*)(sTOT + (4 * k4 + 2) * 128 + d0) + *(const LAS f32x4*)(sTOT + (4 * k4 + 3) * 128 + d0));
            const f32x4 zero4 = {0.f, 0.f, 0.f, 0.f}, c3 = Sb[0], c7 = c3 + Sb[1], c11 = c7 + Sb[2], bend = c11 + Sb[3];
            const f32x4 br_i = sb == 0 ? zero4 : (sb == 1 ? c3 : (sb == 2 ? c7 : c11));
            const LAS float* tb = sTOT + (4 * sb) * 128 + d0;
            const f32x4 tb0 = *(const LAS f32x4*)(tb), tb1 = *(const LAS f32x4*)(tb + 128), tb2 = *(const LAS f32x4*)(tb + 256), tb3 = *(const LAS f32x4*)(tb + 384);
            const f32x4 bm_i = br_i + (tb0 + tb1), br_n = bm_i + (tb2 + tb3);
            f32x4 P;
            if (wid & 1) P = bm_i + ((lane >> 5) ? tb2 : zero4); else P = br_i + ((lane >> 5) ? tb0 : zero4);
            if (rg == 0) { f32x4 dv;
#pragma unroll
                for (int cl = 0; cl < 4; ++cl) dv[cl] = EXPF(bend[cl]);
                *(LAS f32x4*)(sDEC + d0) = dv; }
            float cP[4], cE[4], cq0[4], cq1[4], cq2[4], pr[4], wn[4], wm[4];
#pragma unroll
            for (int cl = 0; cl < 4; ++cl) { cP[cl] = EXPF(br_i[cl]); cE[cl] = EXPF(bend[cl] - br_n[cl]);
                cq0[cl] = EXPF(br_i[cl] - c3[cl]); cq1[cl] = EXPF(br_i[cl] - c7[cl]); cq2[cl] = EXPF(br_i[cl] - c11[cl]);
                pr[cl] = P[cl] - br_i[cl]; wn[cl] = br_n[cl] - br_i[cl]; wm[cl] = bm_i[cl] - br_i[cl]; }
            const int pbase = sb * (sb - 1) / 2;
            float kh[4][4];
#pragma unroll
            for (int r = 0; r < 4; ++r) { const int t = 4 * rg + r, tk = t & 15;
                float vq[4], vk[4], vkb[4], vqq0[4], vqq1[4], vqq2[4], vqd[4], vkd[4];
#pragma unroll
                for (int cl = 0; cl < 4; ++cl) { const float brel = pr[cl] + bl[r][cl];
                    const float e1 = EXPF(brel), e2 = EXPF(wn[cl] - brel), kk = 1.f - EXPF(g[r][cl]);
                    const float qe = q[r][cl] * e1, ke = kk * e2, dm = brel - wm[cl];
                    vq[cl] = qe * cP[cl]; kh[r][cl] = ke * cE[cl]; vkb[cl] = ke;
                    vqq0[cl] = qe * cq0[cl]; vqq1[cl] = qe * cq1[cl]; vqq2[cl] = qe * cq2[cl];
                    vqd[cl] = q[r][cl] * EXPF(dm); vkd[cl] = kk * EXPF(-dm); }
                *(LAS u32x2*)(sQH + t * RS + d0) = pk4(vq[0], vq[1], vq[2], vq[3]);
                if (sb < 3) *(LAS u32x2*)(sKB + t * RS + d0) = pk4(vkb[0], vkb[1], vkb[2], vkb[3]);
                if (sb >= 1) *(LAS u32x2*)(sQQ + ((pbase + 0) * 16 + tk) * RS + d0) = pk4(vqq0[0], vqq0[1], vqq0[2], vqq0[3]);
                if (sb >= 2) *(LAS u32x2*)(sQQ + ((pbase + 1) * 16 + tk) * RS + d0) = pk4(vqq1[0], vqq1[1], vqq1[2], vqq1[3]);
                if (sb >= 3) *(LAS u32x2*)(sQQ + ((pbase + 2) * 16 + tk) * RS + d0) = pk4(vqq2[0], vqq2[1], vqq2[2], vqq2[3]);
                *(LAS u32x2*)(sQD + t * RS + d0) = pk4(vqd[0], vqd[1], vqd[2], vqd[3]);
                *(LAS u32x2*)(sKD + t * RS + d0) = pk4(vkd[0], vkd[1], vkd[2], vkd[3]); }
#pragma unroll
            for (int cl = 0; cl < 4; ++cl) *(LAS u32x2*)(sKH + (d0 + cl) * RS2 + 4 * rg) = pk4(kh[0][cl], kh[1][cl], kh[2][cl], kh[3][cl]);
            *(LAS unsigned*)(sVT + (4 * e4 + 0) * RS2 + 2 * s2) = (v0[0] & 0xffffu) | (v1[0] << 16);
            *(LAS unsigned*)(sVT + (4 * e4 + 1) * RS2 + 2 * s2) = (v0[0] >> 16) | (v1[0] & 0xffff0000u);
            *(LAS unsigned*)(sVT + (4 * e4 + 2) * RS2 + 2 * s2) = (v0[1] & 0xffffu) | (v1[1] << 16);
            *(LAS unsigned*)(sVT + (4 * e4 + 3) * RS2 + 2 * s2) = (v0[1] >> 16) | (v1[1] & 0xffff0000u);
        }
        if (c + 1 < 36) HG_LOAD(c + 1);
        __syncthreads();
        if (need_o && HD != 3) {
            for (int bi = wid; bi < 10; bi += 8) {
                int i, j, p = 0;
                if (bi < 4) { i = bi; j = bi; } else { p = bi - 4; i = p < 1 ? 1 : (p < 3 ? 2 : 3); j = p - i * (i - 1) / 2; }
                const LAS u16* Ab = (i == j ? sQD + (16 * i + l15) * RS : sQQ + (p * 16 + l15) * RS) + 8 * q4;
                const LAS u16* Bb = (i == j ? sKD + (16 * i + l15) * RS : sKB + (16 * j + l15) * RS) + 8 * q4;
                f32x4 acc = {0.f, 0.f, 0.f, 0.f};
#pragma unroll
                for (int ks = 0; ks < 4; ++ks) acc = __builtin_amdgcn_mfma_f32_16x16x32_bf16(*(const LAS bf16x8*)(Ab + ks * 32), *(const LAS bf16x8*)(Bb + ks * 32), acc, 0, 0, 0);
#pragma unroll
                for (int r = 0; r < 4; ++r) { const int t = 4 * q4 + r; float v = acc[r]; if (i == j && l15 > t) v = 0.f; sPP[(16 * i + t) * RS2 + 16 * j + l15] = f2bf(v); }
            }
        }
        if (HD != 3) {
#pragma unroll
            for (int r = 0; r < 16; ++r) S[r] *= sDEC[32 * dt + crow(r, hi)];
#pragma unroll
            for (int ks = 0; ks < 4; ++ks)
                S = __builtin_amdgcn_mfma_f32_32x32x16_bf16(*(const LAS bf16x8*)(sKH + (32 * dt + l32) * RS2 + ks * 16 + 8 * hi), *(const LAS bf16x8*)(sVT + (32 * et + l32) * RS2 + ks * 16 + 8 * hi), S, 0, 0, 0);
        }
        __syncthreads();
        if (need_o && HD != 3) {
            const int tt = wid >> 1;
#pragma unroll
            for (int e2i = 0; e2i < 2; ++e2i) { const int et2 = (wid & 1) * 2 + e2i;
                f32x4 acc = {0.f, 0.f, 0.f, 0.f};
#pragma unroll
                for (int ks = 0; ks < 2; ++ks) acc = __builtin_amdgcn_mfma_f32_16x16x32_bf16(*(const LAS bf16x8*)(sVT + (16 * et2 + l15) * RS2 + ks * 32 + 8 * q4), *(const LAS bf16x8*)(sPP + (16 * tt + l15) * RS2 + ks * 32 + 8 * q4), acc, 0, 0, 0);
#pragma unroll
                for (int ks = 0; ks < 4; ++ks) acc = __builtin_amdgcn_mfma_f32_16x16x32_bf16(*(const LAS bf16x8*)(sST + (16 * et2 + l15) * RS + ks * 32 + 8 * q4), *(const LAS bf16x8*)(sQH + (16 * tt + l15) * RS + ks * 32 + 8 * q4), acc, 0, 0, 0);
                { int pos = 64 * cc + 16 * tt + l15; if (dir) pos = lseg - 1 - pos;
                  *(u32x2*)(OOg + (size_t)(rowbase + pos) * 512 + h * 128 + eh * 64 + 16 * et2 + 4 * q4) = pk4(acc[0], acc[1], acc[2], acc[3]); }
            }
        }
    }
#undef HG_LOAD
    __builtin_amdgcn_s_setprio(0);
    __syncthreads();
}
}

__device__ __forceinline__ void ln_stats(const f32x4 (&x)[4], float& mu, float& rstd) {
    float s = 0.f;
#pragma unroll
    for (int j = 0; j < 4; ++j) s += (x[j][0] + x[j][1]) + (x[j][2] + x[j][3]);
    mu = wsum(s) * (1.f / 1024.f);
    float v = 0.f;
#pragma unroll
    for (int j = 0; j < 4; ++j) { const f32x4 dd = x[j] - mu; v += (dd[0] * dd[0] + dd[1] * dd[1]) + (dd[2] * dd[2] + dd[3] * dd[3]); }
    rstd = rsqrtf(wsum(v) * (1.f / 1024.f) + LN_EPS);
}
template <bool FIRST_LN>
__device__ __forceinline__ void ln_phase(const Frame& F, int r0, const float* src_c, const float* src_l, float* dst_c, float* dst_l,
                                         const float* lng, const float* lnb, bool do_mod, const float* modl, int ch_shift, int ch_scale) {
    u16* H = (u16*)(F.ws + WS_H);
    constexpr int NR = 4;
    for (int row0 = r0 + (F.blk * 8 + F.wave) * NR; row0 < TT; row0 += F.G * 8 * NR) {
        f32x4 x[NR][4];
#pragma unroll
        for (int k = 0; k < NR; ++k) { const int row = row0 + k; const float* sp = row < TC ? src_c + (size_t)row * 1024 : src_l + (size_t)(row - TC) * 1024;
#pragma unroll
            for (int j = 0; j < 4; ++j) x[k][j] = *(const f32x4*)(sp + j * 256 + F.lane * 4); }
        const int mi = row0 < TC ? 16 : ((row0 - TC) >> 11);
        if (FIRST_LN) {
            f32x4 gg[4], bb[4];
#pragma unroll
            for (int j = 0; j < 4; ++j) { gg[j] = *(const f32x4*)(lng + j * 256 + F.lane * 4); bb[j] = *(const f32x4*)(lnb + j * 256 + F.lane * 4); }
#pragma unroll
            for (int k = 0; k < NR; ++k) { const int row = row0 + k; float mu, rstd; ln_stats(x[k], mu, rstd);
                float* dp = row < TC ? dst_c + (size_t)row * 1024 : dst_l + (size_t)(row - TC) * 1024;
#pragma unroll
                for (int j = 0; j < 4; ++j) { x[k][j] = (x[k][j] - mu) * rstd * gg[j] + bb[j]; *(f32x4*)(dp + j * 256 + F.lane * 4) = x[k][j]; } }
        }
        if (do_mod) {
            const float* mp = modl + (size_t)mi * 6144;
            f32x4 sh[4], sc[4];
#pragma unroll
            for (int j = 0; j < 4; ++j) { sh[j] = *(const f32x4*)(mp + ch_shift * 1024 + j * 256 + F.lane * 4); sc[j] = *(const f32x4*)(mp + ch_scale * 1024 + j * 256 + F.lane * 4) + 1.f; }
#pragma unroll
            for (int k = 0; k < NR; ++k) { const int row = row0 + k; float mu, rstd; ln_stats(x[k], mu, rstd);
#pragma unroll
                for (int j = 0; j < 4; ++j) { const f32x4 hv = (x[k][j] - mu) * rstd * sc[j] + sh[j];
                    u32x2 w = {cvtpk(hv[0], hv[1]), cvtpk(hv[2], hv[3])};
                    *(u32x2*)(H + (size_t)row * 1024 + j * 256 + F.lane * 4) = w; } }
        }
    }
}

template <int NR = 4> __device__ __forceinline__ void ln1_phase(const Frame& F, int r0, const float* lng, const float* lnb, const float* modl, int rend = TT) {
    const u16* XB = (const u16*)(F.ws + WS_XB); u16* H = (u16*)(F.ws + WS_H);
    const int co = F.lane * 16;
    for (int row0 = r0 + (F.blk * 8 + F.wave) * NR; row0 < rend; row0 += F.G * 8 * NR) {
        u32x4 raw[NR][2];
#pragma unroll
        for (int k = 0; k < NR; ++k) { raw[k][0] = *(const u32x4*)(XB + (size_t)(row0 + k) * 1024 + co); raw[k][1] = *(const u32x4*)(XB + (size_t)(row0 + k) * 1024 + co + 8); }
        const int mi = row0 < TC ? 16 : ((row0 - TC) >> 11);
        const float* mp = modl + (size_t)mi * 6144 + co;
        f32x4 gg[4], bb[4], sh[4], sc[4];
#pragma unroll
        for (int j = 0; j < 4; ++j) { gg[j] = *(const f32x4*)(lng + co + 4 * j); bb[j] = *(const f32x4*)(lnb + co + 4 * j); sh[j] = *(const f32x4*)(mp + 3 * 1024 + 4 * j); sc[j] = *(const f32x4*)(mp + 4 * 1024 + 4 * j) + 1.f; }
#pragma unroll
        for (int k = 0; k < NR; ++k) { float f0[8], f1[8]; unpack8(raw[k][0], f0); unpack8(raw[k][1], f1);
            f32x4 x[4] = {{f0[0], f0[1], f0[2], f0[3]}, {f0[4], f0[5], f0[6], f0[7]}, {f1[0], f1[1], f1[2], f1[3]}, {f1[4], f1[5], f1[6], f1[7]}};
            float mu, rstd; ln_stats(x, mu, rstd);
#pragma unroll
            for (int j = 0; j < 4; ++j) x[j] = (x[j] - mu) * rstd * gg[j] + bb[j];
            ln_stats(x, mu, rstd);
            f32x4 hv[4];
#pragma unroll
            for (int j = 0; j < 4; ++j) hv[j] = (x[j] - mu) * rstd * sc[j] + sh[j];
            st8bf(H + (size_t)(row0 + k) * 1024 + co, hv[0], hv[1]); st8bf(H + (size_t)(row0 + k) * 1024 + co + 8, hv[2], hv[3]); }
    }
}

__device__ __forceinline__ void readout_phase(const Frame& F, int l, int r0) {
    const float* lp = GIN(F, 9) + l * 256;
    float s1 = lp[F.lane] * lp[64 + F.lane], s2 = lp[128 + F.lane] * lp[192 + F.lane];
    s1 = wsum(s1); s2 = wsum(s2);
    const float lam_init = 0.8f - 0.6f * expf(-0.3f * (float)l);
    const float lam = expf(s1) - expf(s2) + lam_init;
    const int e0 = (F.lane & 15) * 8, c0 = F.lane * 8;
    float hgv[8], dav[8];
#pragma unroll
    for (int j = 0; j < 8; ++j) { hgv[j] = GIN(F, 8)[l * 128 + e0 + j]; dav[j] = GIN(F, 10)[l * 128 + e0 + j] * (1.f - lam_init); }
    const u16* OF = (const u16*)(F.ws + WS_OF); const u16* OB = (const u16*)(F.ws + WS_OB); const u16* SG = (const u16*)(F.ws + WS_P4);
    const u16* O1 = (const u16*)(F.ws + WS_ON1); const u16* O2 = (const u16*)(F.ws + WS_ON2);
    u16* Aa = (u16*)(F.ws + WS_P0); u16* Bb = (u16*)(F.ws + WS_P5);
    constexpr int NR = 4;
    for (int row0 = r0 + (F.blk * 8 + F.wave) * NR; row0 < TT; row0 += F.G * 8 * NR) {
        u32x4 ra_[NR], rb_[NR], rs_[NR], r1_[NR], r2_[NR];
#pragma unroll
        for (int k = 0; k < NR; ++k) { const size_t off = (size_t)(row0 + k) * 512 + c0;
            ra_[k] = *(const u32x4*)(OF + off); rb_[k] = *(const u32x4*)(OB + off); rs_[k] = *(const u32x4*)(SG + off); r1_[k] = *(const u32x4*)(O1 + off); r2_[k] = *(const u32x4*)(O2 + off); }
#pragma unroll
        for (int k = 0; k < NR; ++k) { const size_t off = (size_t)(row0 + k) * 512 + c0;
            float a[8], b2[8], sg[8], p1[8], p2[8];
            unpack8(ra_[k], a); unpack8(rb_[k], b2); unpack8(rs_[k], sg); unpack8(r1_[k], p1); unpack8(r2_[k], p2);
            float ssa = 0.f, ssb = 0.f;
#pragma unroll
            for (int j = 0; j < 8; ++j) { a[j] += b2[j]; ssa += a[j] * a[j]; p1[j] -= lam * p2[j]; ssb += p1[j] * p1[j]; }
#pragma unroll
            for (int m = 8; m >= 1; m >>= 1) { ssa += __shfl_xor(ssa, m); ssb += __shfl_xor(ssb, m); }
            const float ra = rsqrtf(ssa * (1.f / 128.f) + LN_EPS), rb = rsqrtf(ssb * (1.f / 128.f) + LN_EPS);
            f32x4 v0, v1, w0, w1;
#pragma unroll
            for (int j = 0; j < 4; ++j) { v0[j] = a[j] * ra * hgv[j] * siluf_(sg[j]); v1[j] = a[4 + j] * ra * hgv[4 + j] * siluf_(sg[4 + j]); w0[j] = p1[j] * rb * dav[j]; w1[j] = p1[4 + j] * rb * dav[4 + j]; }
            st8bf(Aa + off, v0, v1); st8bf(Bb + off, w0, w1); }
    }
}

__device__ __forceinline__ void adaln_phase(const Frame& F) {
    if (F.blk >= 192) return;
    LAS float* sT = (LAS float*)F.lds; LAS float* red = (LAS float*)(F.lds + 81920);
    const float* c = GIN(F, 1); const float* cc = GIN(F, 3); const float* wada = GIN(F, 4); const float* bada = GIN(F, 5);
    float* mod = (float*)(F.ws + WS_MOD);
    for (int idx = F.tid; idx < 17 * 1024; idx += 512) { const int j = idx >> 10, k = idx & 1023; const float v = j < 16 ? c[idx] : cc[k]; sT[k * 20 + j] = v / (1.f + __expf(-v)); }
    __syncthreads();
    for (int u = F.blk; u < 192; u += F.G) {
        const int l = u / 96, n0 = (u % 96) * 64;
        float acc[17];
#pragma unroll
        for (int j = 0; j < 17; ++j) acc[j] = 0.f;
        const float* wp = wada + (size_t)l * 1024 * 6144 + n0 + F.lane;
        for (int k0 = F.wave * 128; k0 < F.wave * 128 + 128; k0 += 16) {
            float wv16[16];
#pragma unroll
            for (int i = 0; i < 16; ++i) wv16[i] = __builtin_nontemporal_load(wp + (size_t)(k0 + i) * 6144);
#pragma unroll
            for (int i = 0; i < 16; ++i) { const int k = k0 + i; const float wv = wv16[i];
                const f32x4 a0 = *(const LAS f32x4*)(sT + k * 20), a1 = *(const LAS f32x4*)(sT + k * 20 + 4), a2 = *(const LAS f32x4*)(sT + k * 20 + 8), a3 = *(const LAS f32x4*)(sT + k * 20 + 12);
                const float a4 = sT[k * 20 + 16];
#pragma unroll
                for (int j = 0; j < 4; ++j) { acc[j] += a0[j] * wv; acc[4 + j] += a1[j] * wv; acc[8 + j] += a2[j] * wv; acc[12 + j] += a3[j] * wv; }
                acc[16] += a4 * wv; }
        }
#pragma unroll
        for (int j = 0; j < 17; ++j) red[(F.wave * 17 + j) * 64 + F.lane] = acc[j];
        __syncthreads();
        for (int idx = F.tid; idx < 17 * 64; idx += 512) { const int j = idx >> 6, ln = idx & 63; float s = bada[l * 6144 + n0 + ln];
#pragma unroll
            for (int w = 0; w < 8; ++w) s += red[(w * 17 + j) * 64 + ln];
            mod[(size_t)(l * 17 + j) * 6144 + n0 + ln] = s; }
        __syncthreads();
    }
}

__device__ __forceinline__ void fold_phase(const Frame& F) {
    u16* U = (u16*)(F.ws + WS_P8) + (size_t)TC * 512; float* ucm = (float*)(F.ws + WS_UCM);
    for (int it = F.blk * 8 + F.wave; it < NB * 512; it += F.G * 8) {
        const int b = it >> 9, l = (it & 511) + 1;
        u16* r0p = U + ((size_t)b * SEQ + l) * 512 + F.lane * 8; u16* r1p = U + ((size_t)b * SEQ + (SEQ - l)) * 512 + F.lane * 8;
        u16* r2p = U + ((size_t)b * SEQ + (1024 - l)) * 512 + F.lane * 8; u16* r3p = U + ((size_t)b * SEQ + (1024 + l)) * 512 + F.lane * 8;
        float a[8], bq[8], c2[8], d[8];
        unpack8(*(const u32x4*)r0p, a); unpack8(*(const u32x4*)r1p, bq);
        if (l < 512) { unpack8(*(const u32x4*)r2p, c2); unpack8(*(const u32x4*)r3p, d); }
        f32x4 e0, e1, o0, o1;
#pragma unroll
        for (int j = 0; j < 4; ++j) { e0[j] = a[j] + bq[j]; e1[j] = a[4 + j] + bq[4 + j]; o0[j] = a[j] - bq[j]; o1[j] = a[4 + j] - bq[4 + j]; }
        if (l < 512) {
            f32x4 f0, f1, p0, p1;
#pragma unroll
            for (int j = 0; j < 4; ++j) { f0[j] = c2[j] + d[j]; f1[j] = c2[4 + j] + d[4 + j]; p0[j] = c2[j] - d[j]; p1[j] = c2[4 + j] - d[4 + j]; }
            st8bf(r0p, e0, e1); st8bf(r2p, f0, f1); st8bf(r3p, o0, o1); st8bf(r1p, p0, p1);
        } else { st8bf(r0p, e0, e1); st8bf(r1p, o0, o1); }
    }
    LAS float* ct = (LAS float*)F.lds;
    if (F.tid < 128) ct[F.tid] = cospif((float)F.tid * (1.f / 64.f));
    __syncthreads();
    for (int i = F.blk * 64 + F.tid; F.tid < 64 && i < 8192; i += F.G * 64) { const int b = i >> 9, g = (i >> 7) & 3, n = i & 127;
        const u16* up = U + ((size_t)b * SEQ + 1024) * 512 + g * 128; float acc = 0.f;
        u32x4 w[16];
#pragma unroll
        for (int k8 = 0; k8 < 16; ++k8) w[k8] = *(const u32x4*)(up + 8 * k8);
#pragma unroll
        for (int k8 = 0; k8 < 16; ++k8) { float f[8]; unpack8(w[k8], f);
#pragma unroll
            for (int j = 0; j < 8; ++j) acc += f[j] * ct[(n * (8 * k8 + j)) & 127]; }
        ucm[i] = acc; }
    __syncthreads();
}
__device__ __forceinline__ void tables_phase(const Frame& F) {
    const int gid = F.blk * 512 + F.tid, stride = F.G * 512;
    float* lbt = (float*)(F.ws + WS_LBT); float* rope = (float*)(F.ws + WS_ROPE);
    u16* w2t = (u16*)(F.ws + WS_W2T); u16* w2tl = (u16*)(F.ws + WS_W2TL); u16* dftc = (u16*)(F.ws + WS_DFTC); u16* dft = (u16*)(F.ws + WS_DFT);
    const float* lbl = GIN(F, 7);
    for (int i = gid; i < 2048; i += stride) { const int l = i >> 10, rem = i & 1023; const float a0 = lbl[rem], a1 = lbl[1024 + rem], mx = fmaxf(a0, a1);
        const float e0 = expf(a0 - mx), e1 = expf(a1 - mx); const float lb = l == 0 ? 0.f : e1 / (e0 + e1);
        lbt[i * 2] = fmaxf(lb, 1e-30f); lbt[i * 2 + 1] = 1.f - lb; }
    for (int i = gid; i < 65536; i += stride) { const int t = i >> 5, p = i & 31; const float pos = (float)(p < 16 ? (t >> 6) : (t & 63));
        const float inv = powf(10000.f, -(float)(p & 15) / 16.f); const float ang = pos * inv; rope[i] = cosf(ang); rope[65536 + i] = sinf(ang); }
    for (int i = gid; i < 65536; i += stride) { const int np = i >> 8, k = i & 255; float v = 0.f;
        if (k < 128) { const int idx = ((np & 127) * k) & 127; const float x = (float)idx * (1.f / 64.f); v = np < 128 ? cospif(x) : sinpif(x); }
        w2t[i] = f2bf(v);
        float vl = 0.f; if (np < 128 && k < 128) vl = cospif((float)((np * k) & 127) * (1.f / 64.f)); if (np >= 128 && k >= 128) vl = sinpif((float)(((np - 128) * (k - 128)) & 127) * (1.f / 64.f));
        w2tl[i] = f2bf(vl); }
    LAS float* ct = (LAS float*)F.lds;
    for (int j = F.tid; j < 2048; j += 512) ct[j] = cospif((float)j * (1.f / 1024.f));
    __syncthreads();
    for (int i = gid; i < 131072; i += stride) { const int m = i >> 9, ci = i & 511, lq = ci & 255, idx = ((m * lq) & 255) * 8;
        dftc[(size_t)m * 2048 + ci] = f2bf(ci < 256 ? ct[idx] : -ct[(idx - 512) & 2047]); }
    for (int i8 = gid; i8 < 2048 * 2048 / 8; i8 += stride) { const int i = i8 * 8, m = i >> 11, ci0 = i & 2047; float v[8];
#pragma unroll
        for (int j = 0; j < 8; ++j) { const int ci = ci0 + j, lq = ci & 1023, idx = (m * lq) & 2047; v[j] = ci < 1024 ? ct[idx] : -ct[(idx - 512) & 2047]; }
        st8bf(dft + i, (f32x4){v[0], v[1], v[2], v[3]}, (f32x4){v[4], v[5], v[6], v[7]}); }
    __syncthreads();
}

__device__ __forceinline__ int rowmap(int map, int n) {
    if (map == 1) { const int sec = n >> 9; if (sec == 5 || sec == 6) { const int dd = n & 63; n = (n & ~63) + (dd < 32 ? 2 * dd : 2 * (dd - 32) + 1); } return n; }
    if (map == 2) return (n >> 7) * 256 + (n & 127);
    if (map == 3) return (n >> 7) * 256 + 128 + (n & 127);
    return n;
}
__device__ __forceinline__ void cvt_job(const Frame& F, const float* src, const float* src_last, size_t src_stride, int nmat, int K, int N, u16* dst, size_t dst_stride, int ldd, int map, float scl = 1.f) {
    LAS float* tile = (LAS float*)F.lds;
    const int ntn = N / 64, per = (K / 64) * ntn, total = per * nmat;
    const int kk = F.tid >> 3, c8 = (F.tid & 7) * 8;
    constexpr int NTL = 4;
    for (int i4 = F.blk * NTL; i4 < total; i4 += F.G * NTL) {
        f32x4 a[NTL], b[NTL];
#pragma unroll
        for (int q = 0; q < NTL; ++q) { const int idx = i4 + q; if (idx < total) {
            const int e = idx / per, t = idx - e * per, kt = t / ntn, tn = t - kt * ntn;
            const float* sp = (src_last && e == nmat - 1) ? src_last : src + (size_t)e * src_stride;
            a[q] = *(const f32x4*)(sp + (size_t)(kt * 64 + kk) * N + tn * 64 + c8); b[q] = *(const f32x4*)(sp + (size_t)(kt * 64 + kk) * N + tn * 64 + c8 + 4); } }
#pragma unroll
        for (int q = 0; q < NTL; ++q) if (i4 + q < total) {
#pragma unroll
            for (int j = 0; j < 4; ++j) { tile[q * 4160 + kk * 65 + c8 + j] = a[q][j]; tile[q * 4160 + kk * 65 + c8 + 4 + j] = b[q][j]; } }
        __syncthreads();
#pragma unroll
        for (int q = 0; q < NTL; ++q) { const int idx = i4 + q; if (idx < total) {
            const int e = idx / per, t = idx - e * per, kt = t / ntn, tn = t - kt * ntn;
            f32x4 v0, v1;
#pragma unroll
            for (int j = 0; j < 4; ++j) { v0[j] = tile[q * 4160 + (c8 + j) * 65 + kk]; v1[j] = tile[q * 4160 + (c8 + 4 + j) * 65 + kk]; }
            const int drow = rowmap(map, tn * 64 + kk);
            st8bf(dst + (size_t)e * dst_stride + (size_t)drow * ldd + kt * 64 + c8, v0 * scl, v1 * scl); } }
        __syncthreads();
    }
}
__device__ __forceinline__ void cvt_layer_weights(const Frame& F, int l) {
    u16* wl = (u16*)(F.ws + WS_WL);
    cvt_job(F, GIN(F, 6) + (size_t)l * 1024 * INW, nullptr, 0, 1, 1024, INW, wl + WL_WIN / 2, 0, 1024, 1);
    cvt_job(F, GIN(F, 11) + (size_t)l * 524288, nullptr, 0, 1, 512, 1024, wl + WL_WPA / 2, 0, 512, 0);
    cvt_job(F, GIN(F, 12) + (size_t)l * 524288, nullptr, 0, 1, 512, 1024, wl + WL_WPB / 2, 0, 512, 0);
    cvt_job(F, GIN(F, 13) + (size_t)l * 524288, nullptr, 0, 1, 512, 1024, wl + WL_WPC / 2, 0, 512, 0);
    cvt_job(F, GIN(F, 14) + (size_t)l * 1048576, nullptr, 0, 1, 1024, 1024, wl + WL_WO / 2, 0, 1024, 0);
    cvt_job(F, GIN(F, 19) + (size_t)l * 65536, nullptr, 0, 1, 1024, 64, wl + WL_WR / 2, 0, 1024, 0);
    unsigned* z = (unsigned*)(F.ws + WS_WL + WL_WR + 64 * 2048);
    for (int i = F.blk * 512 + F.tid; i < 192 * 512; i += F.G * 512) z[i] = 0u;
}
__device__ __forceinline__ void cvt_expert_weights(const Frame& F, int l, int part = 0) {
    if (part != 2) cvt_job(F, GIN(F, 21) + (size_t)l * 64 * 262144, GIN(F, 24) + (size_t)l * 262144, 262144, NEXP1, 1024, 256, (u16*)(F.ws + WS_WGU), 524288, 1024, 2);
    if (part != 2) cvt_job(F, GIN(F, 22) + (size_t)l * 64 * 262144, GIN(F, 25) + (size_t)l * 262144, 262144, NEXP1, 1024, 256, (u16*)(F.ws + WS_WGU), 524288, 1024, 3);
    if (part != 1) cvt_job(F, GIN(F, 23) + (size_t)l * 64 * 262144, GIN(F, 26) + (size_t)l * 262144, 262144, NEXP1, 256, 1024, (u16*)(F.ws + WS_WD), 262144, 256, 0, 16.f);
}

__device__ __forceinline__ void route1_phase(const Frame& F, int l, int r0) {
    LAS int* lcnt = (LAS int*)F.lds;
    unsigned* ctl = (unsigned*)(F.ws + WS_CTL);
    const float* logits = (const float*)(F.ws + WS_LOGIT); int* eidx = (int*)(F.ws + WS_EIDX); float* wgt = (float*)(F.ws + WS_WGT);
    int* rtok = (int*)(F.ws + WS_RTOK); int* blkb = (int*)(F.ws + WS_BLKB);
    const float* bias = GIN(F, 20) + l * 64;
    const int t1 = pass_tile0(l, 1) * 256, t2 = pass_tile0(l, 2) * 256;
    if (F.tid < NPASS * 64) lcnt[F.tid] = 0;
    __syncthreads();
    for (int i = F.blk * 512 + F.tid; i < NPASS * MAXROWS; i += F.G * 512) rtok[i] = -1;
    for (int tl = F.blk; tl * 256 + r0 < TT; tl += F.G) {
        if (F.tid >= 256) break;
        const int tok = r0 + tl * 256 + F.tid;
        const int ps = (tok >= t1) + (tok >= t2);
        float s[64];
#pragma unroll
        for (int j = 0; j < 16; ++j) { const f32x4 v = __builtin_nontemporal_load((const f32x4*)(logits + (size_t)tok * 64 + j * 4));
#pragma unroll
            for (int k = 0; k < 4; ++k) s[4 * j + k] = 1.f / (1.f + expf(-v[k])); }
        float gs[8];
#pragma unroll
        for (int g = 0; g < 8; ++g) { float m1 = -3.0e38f, m2 = -3.0e38f;
#pragma unroll
            for (int j = 0; j < 8; ++j) { const float v = s[8 * g + j] + bias[8 * g + j]; if (v > m1) { m2 = m1; m1 = v; } else if (v > m2) m2 = v; }
            gs[g] = m1 + m2; }
        unsigned gmask = 0u;
#pragma unroll
        for (int it = 0; it < 4; ++it) { float best = -3.0e38f; int bi = 0;
#pragma unroll
            for (int g = 0; g < 8; ++g) { const bool ok = !((gmask >> g) & 1u) && gs[g] > best; best = ok ? gs[g] : best; bi = ok ? g : bi; }
            gmask |= 1u << bi; }
        unsigned long long chosen = 0ull; float tot = 0.f; int eid[8]; float ew[8];
#pragma unroll
        for (int it = 0; it < 8; ++it) { float best = -3.0e38f, bs = 0.f; int bi = 0;
#pragma unroll
            for (int e = 0; e < 64; ++e) { const float v = s[e] + bias[e]; const bool ok = ((gmask >> (e >> 3)) & 1u) && !((chosen >> e) & 1ull) && v > best;
                best = ok ? v : best; bi = ok ? e : bi; bs = ok ? s[e] : bs; }
            chosen |= 1ull << bi; eid[it] = bi; ew[it] = bs; tot += bs; }
        const float rs = 2.5f / tot;
#pragma unroll
        for (int it = 0; it < 8; ++it) { eidx[(size_t)tok * 8 + it] = eid[it]; wgt[(size_t)tok * 8 + it] = ew[it] * rs; __hip_atomic_fetch_add(&lcnt[ps * 64 + eid[it]], 1, __ATOMIC_RELAXED, __HIP_MEMORY_SCOPE_WORKGROUP); }
    }
    __syncthreads();
    if (F.tid < NPASS * 64) { const int cnt = lcnt[F.tid]; int base = 0; if (cnt) base = (int)atomicAdd(&ctl[CW_GCNT + l * NPASS * 64 + F.tid], (unsigned)cnt); blkb[F.blk * (NPASS * 64) + F.tid] = base; }
}
__device__ __forceinline__ void route2_phase(const Frame& F, int l, int r0) {
    LAS int* lcnt = (LAS int*)F.lds; LAS int* base = lcnt + NPASS * 64;
    unsigned* ctl = (unsigned*)(F.ws + WS_CTL);
    const int* eidx = (const int*)(F.ws + WS_EIDX); int* srow = (int*)(F.ws + WS_SROW);
    int* rtok = (int*)(F.ws + WS_RTOK); const int* blkb = (const int*)(F.ws + WS_BLKB); int* tile_e = (int*)(F.ws + WS_TILEE);
    const int t1 = pass_tile0(l, 1) * 256, t2 = pass_tile0(l, 2) * 256;
    LAS int* gcn = base + NPASS * 66;
    if (F.tid < NPASS * 64) { lcnt[F.tid] = 0; gcn[F.tid] = (int)__hip_atomic_load(&ctl[CW_GCNT + l * NPASS * 64 + F.tid], __ATOMIC_RELAXED, __HIP_MEMORY_SCOPE_AGENT); }
    __syncthreads();
    if (F.tid < NPASS) { const int ps = F.tid; int acc = 0;
        for (int e = 0; e < 64; ++e) { const int cnt = gcn[ps * 64 + e]; base[ps * 66 + e] = acc; acc += (cnt + 255) & ~255; }
        base[ps * 66 + 64] = acc; acc += (pass_tile0(l, ps + 1) - pass_tile0(l, ps)) * 256; base[ps * 66 + 65] = acc; }
    __syncthreads();
    if (F.blk < NPASS) { const int ps = F.blk; const int ntl = base[ps * 66 + 65] >> 8;
        for (int ti = F.tid; ti < ntl; ti += 512) { int e = 0; for (int k = 1; k <= 64; ++k) if (ti * 256 >= base[ps * 66 + k]) e = k; tile_e[ps * 1024 + ti] = e; }
        if (F.tid == 0) __hip_atomic_store(&ctl[CW_NTILES + l * NPASS + ps], (unsigned)ntl, __ATOMIC_RELAXED, __HIP_MEMORY_SCOPE_AGENT);
    }
    for (int tl = F.blk; tl * 256 + r0 < TT; tl += F.G) {
        if (F.tid >= 256) break;
        const int tok = r0 + tl * 256 + F.tid;
        const int ps = (tok >= t1) + (tok >= t2);
        int* rt = rtok + (size_t)ps * MAXROWS;
#pragma unroll
        for (int j = 0; j < 8; ++j) { const int e = eidx[(size_t)tok * 8 + j]; const int rank = __hip_atomic_fetch_add(&lcnt[ps * 64 + e], 1, __ATOMIC_RELAXED, __HIP_MEMORY_SCOPE_WORKGROUP);
            const int row = base[ps * 66 + e] + blkb[F.blk * (NPASS * 64) + ps * 64 + e] + rank;
            rt[row] = tok; srow[(size_t)tok * 9 + j] = row; }
        const int row = base[ps * 66 + 64] + (tok - pass_tile0(l, ps) * 256); rt[row] = tok; srow[(size_t)tok * 9 + 8] = row;
    }
    __syncthreads();
}
__device__ __forceinline__ void comb_ln2_phase(const Frame& F, int tok0, int tok1, float* dst_c, float* dst_l, const float* modl, const float* lng1, const float* lnb1, const float* lng, const float* lnb, bool do_mod, const float* modn) {
    const int* srow = (const int*)(F.ws + WS_SROW); const float* wgt = (const float*)(F.ws + WS_WGT); const unsigned char* so = F.ws + WS_SO;
    u16* H = (u16*)(F.ws + WS_H);
    const int co = F.lane * 16;
    for (int tok = tok0 + F.blk * 8 + F.wave; tok < tok1; tok += F.G * 8) {
        const int myrow = F.lane < 9 ? srow[(size_t)tok * 9 + F.lane] : 0; const float myw = (F.lane < 8 ? wgt[(size_t)tok * 8 + F.lane] : 1.f) * (1.f / 16.f);
        u32x4 sv[9];
#pragma unroll
        for (int j = 0; j < 9; ++j) { const int row = __shfl(myrow, j); sv[j] = __builtin_nontemporal_load((const u32x4*)(so + (size_t)row * 1024 + co)); }
        const int mi = tok < TC ? 16 : ((tok - TC) >> 11);
        float* xp = (tok < TC ? dst_c + (size_t)tok * 1024 : dst_l + (size_t)(tok - TC) * 1024) + co;
        f32x4 x[4];
        { const u16* xb = (const u16*)(F.ws + WS_XB) + (size_t)tok * 1024 + co; float f0[8], f1[8]; unpack8(__builtin_nontemporal_load((const u32x4*)xb), f0); unpack8(__builtin_nontemporal_load((const u32x4*)(xb + 8)), f1);
          x[0] = (f32x4){f0[0], f0[1], f0[2], f0[3]}; x[1] = (f32x4){f0[4], f0[5], f0[6], f0[7]}; x[2] = (f32x4){f1[0], f1[1], f1[2], f1[3]}; x[3] = (f32x4){f1[4], f1[5], f1[6], f1[7]};
          float mu1, rs1; ln_stats(x, mu1, rs1);
#pragma unroll
          for (int k = 0; k < 4; ++k) x[k] = (x[k] - mu1) * rs1 * *(const f32x4*)(lng1 + co + 4 * k) + *(const f32x4*)(lnb1 + co + 4 * k); }
        f32x4 y[4];
#pragma unroll
        for (int k = 0; k < 4; ++k) y[k] = (f32x4){0.f, 0.f, 0.f, 0.f};
#pragma unroll
        for (int j = 0; j < 9; ++j) { const float w = __shfl(myw, j);
#pragma unroll
            for (int k = 0; k < 4; ++k) { const f32x2_ lo = __builtin_amdgcn_cvt_pk_f32_fp8((int)sv[j][k], false), hi = __builtin_amdgcn_cvt_pk_f32_fp8((int)sv[j][k], true);
                y[k][0] += w * lo[0]; y[k][1] += w * lo[1]; y[k][2] += w * hi[0]; y[k][3] += w * hi[1]; } }
#pragma unroll
        for (int k = 0; k < 4; ++k) { const f32x4 g2 = *(const f32x4*)(modl + (size_t)mi * 6144 + 5 * 1024 + co + 4 * k); x[k] = x[k] * ALPHA + g2 * y[k]; }
        float mu, rstd;
        ln_stats(x, mu, rstd);
#pragma unroll
        for (int k = 0; k < 4; ++k) { const f32x4 gg = *(const f32x4*)(lng + co + 4 * k), bb = *(const f32x4*)(lnb + co + 4 * k);
            x[k] = (x[k] - mu) * rstd * gg + bb; *(f32x4*)(xp + 4 * k) = x[k]; }
        if (do_mod) {
            ln_stats(x, mu, rstd);
            const float* mp = modn + (size_t)mi * 6144 + co;
            f32x4 hv[4];
#pragma unroll
            for (int k = 0; k < 4; ++k) { const f32x4 sh = *(const f32x4*)(mp + 4 * k), sc = *(const f32x4*)(mp + 1024 + 4 * k); hv[k] = (x[k] - mu) * rstd * (sc + 1.f) + sh; }
            st8bf(H + (size_t)tok * 1024 + co, hv[0], hv[1]); st8bf(H + (size_t)tok * 1024 + co + 8, hv[2], hv[3]);
        }
    }
}
__device__ __forceinline__ int opaque_int(int v) { asm volatile("" : "+s"(v)); return v; }
__device__ __forceinline__ const void* launder_ptr(const void* p) {
    unsigned lo = (unsigned)(uintptr_t)p, hi = (unsigned)((uintptr_t)p >> 32);
    asm volatile("" : "+v"(lo), "+v"(hi));
    lo = __builtin_amdgcn_readfirstlane(lo); hi = __builtin_amdgcn_readfirstlane(hi);
    return (const void*)(((uintptr_t)hi << 32) | (uintptr_t)lo);
}
constexpr int NPL = 16;
constexpr int NINT = 2 + (10 + 2 * npass_of(0)) + (10 + 2 * npass_of(1));
__global__ void __launch_bounds__(512, 2) mk_fwd(Args args) {
    extern __shared__ __attribute__((aligned(16))) unsigned char lds_raw[];
    Frame F0;
    F0.in = nullptr; F0.out = args.out; F0.ws = args.ws; F0.lds = (LAS unsigned char*)lds_raw;
    F0.tid = threadIdx.x; F0.lane = F0.tid & 63; F0.wave = __builtin_amdgcn_readfirstlane(F0.tid >> 6); F0.G = gridDim.x; F0.blk = blockIdx.x;
    const int lo = args.ph_lo, hi = args.ph_hi;
    unsigned* ctl = (unsigned*)(args.ws + WS_CTL);
    volatile LAS unsigned* misc = (volatile LAS unsigned*)(F0.lds + LDS_MISC);
    if (F0.tid < 16) misc[F0.tid] = 0u;
    __syncthreads();
    XcdBarrier bar; bar.bar = ctl + CW_BAR; bar.x = 0; bar.st = misc;
    if (hi - lo > 1) bar = xcd_barrier_post(ctl + CW_BAR, misc);
#define IN(k) (lo <= (k) && (k) < hi)
#ifndef DBL_BAR
#define DBL_BAR 0
#endif
#define SEAM(k) do { if (IN(k) && IN((k) + 1)) { xcd_barrier(bar); if (DBL_BAR) xcd_barrier(bar); } } while (0)
    const float* const* in0 = (const float* const*)__builtin_amdgcn_kernarg_segment_ptr(); float* out0 = args.out; unsigned char* ws0 = args.ws;
#define PH_BEGIN Frame F = F0; { const unsigned _z = (unsigned)opaque_int(0); F.in = in0 + _z; F.out = out0 + _z; F.ws = ws0 + _z; } F.G = opaque_int(F0.G); F.blk = opaque_int(F0.blk); F.vcu = (F.G % 8 == 0) ? (F.blk % 8) * (F.G / 8) + F.blk / 8 : F.blk; { int _t = F0.tid; asm volatile("" : "+v"(_t)); F.tid = _t; F.lane = _t & 63; F.wave = __builtin_amdgcn_readfirstlane(_t >> 6); } \
    unsigned char* ws = F.ws; float* xc = (float*)(ws + WS_XC); const float* modall = (const float*)(ws + WS_MOD); (void)xc; (void)modall;
#define PH_BEGIN_L PH_BEGIN const int l = opaque_int(lyr); const int r0 = l == 0 ? 0 : TC, rt0 = r0 / 256, nM = (TT - r0) / 256; (void)rt0; (void)nM;

    if (EN(0) && IN(0)) for (int rp = 0; rp < NREP(0); ++rp) { PH_BEGIN adaln_phase(F); __syncthreads(); tables_phase(F); cvt_layer_weights(F, 0); }
    SEAM(0);
    if (EN(1) && IN(1)) for (int rp = 0; rp < NREP(1); ++rp) { PH_BEGIN ln_phase<false>(F, 0, GIN(F, 2), GIN(F, 0), nullptr, nullptr, nullptr, nullptr, true, modall, 0, 1); }
    SEAM(1);

    for (int lyr = 0; lyr < DEPTH; ++lyr) {
        const int NP = npass_of(lyr), base = 2 + (lyr == 0 ? 0 : 10 + 2 * npass_of(0));
        if (hi <= base || lo >= base + 10 + 2 * NP) continue;

        if (EN(2) && IN(base + 0)) for (int rp = 0; rp < NREP(2); ++rp) {
            PH_BEGIN_L
            PIn p; p.A = (const char*)(ws + WS_H); p.B = (const char*)(ws + WS_WL + WL_WIN); p.nt = opaque_int(16); p.G = F.G; p.c = F.blk; p.nM = l == 0 ? TT / 256 : TL / 256; p.nN = 18; p.rt0 = l == 0 ? 0 : TC / 256; p.pn0 = 0; p.nctx = l == 0 ? 0 : 16 * 12;
            if (XG_ON && XG_ON != 4 && l == 0) { p.xr0 = 0; p.xnr = XG_ROWS; p.xg = (u16*)((unsigned char*)F.out + XG_OFF); }
            p.ws = ws; p.lbt = (const float*)(ws + WS_LBT) + (size_t)l * 2048; p.rope = (const float*)(ws + WS_ROPE);
            pg8::gemm_phase(F.lds, p);
        }
        SEAM(base + 0);
        if (IN(base + 1)) {
            if (EN(5)) { PH_BEGIN_L fold_phase(F); }
            if (EN(3)) for (int rp = 0; rp < NREP(3); ++rp) { PH_BEGIN_L for (int u = F.blk; u < 256; u += F.G) { if (rp == 0) hg::hgrn_unit<0>(ws, F.lds, l, u >> 4, (u >> 2) & 3, (u >> 1) & 1, u & 1); else hg::hgrn_unit<HG_DRY>(ws, F.lds, l, u >> 4, (u >> 2) & 3, (u >> 1) & 1, u & 1); } }
            if (EN(4)) for (int rp = 0; rp < NREP(4); ++rp) {
                PH_BEGIN_L
                const int nlat = NB * 4 * 8 * 2, nctx = l == 0 ? NB * 4 * 2 : 0;
                for (int u = F.vcu; u < nlat + nctx; u += F.G) {
                    int map, b, h, qrow0, NT;
                    if (u < nlat) { map = u & 1; const int qb = (u >> 1) & 7; h = (u >> 4) & 3; b = u >> 6; qrow0 = TC + b * SEQ + qb * 256; NT = 36; }
                    else { const int v = u - nlat; map = v & 1; h = (v >> 1) & 3; b = v >> 3; qrow0 = b * LC; NT = 4; }
                    if (rp == 0 && ATT_SGB == 2) att::attn_unit_sgb((const u16*)(ws + WS_P5), (const u16*)(ws + WS_P6), (const u16*)(ws + WS_P7), (u16*)(ws + (map ? WS_ON2 : WS_ON1)), qrow0, b, h, map, NT, (LAS char*)F.lds);
                    else if (ATT_SGB == 2) att::attn_unit_sgb((const u16*)(ws + WS_P5), (const u16*)(ws + WS_P6), (const u16*)(ws + WS_P7), (u16*)(ws + WS_TT), qrow0, b, h, map, NT, (LAS char*)F.lds);
                    else if (rp == 0) att::attn_unit_dma<0>((const u16*)(ws + WS_P5), (const u16*)(ws + WS_P6), (const u16*)(ws + WS_P7), (u16*)(ws + (map ? WS_ON2 : WS_ON1)), qrow0, b, h, map, NT, (LAS char*)F.lds);
                    else att::attn_unit_dma<AT_DRY>((const u16*)(ws + WS_P5), (const u16*)(ws + WS_P6), (const u16*)(ws + WS_P7), (u16*)(ws + WS_TT), qrow0, b, h, map, NT, (LAS char*)F.lds);
                }
            }
        }
        SEAM(base + 1);
        if (IN(base + 2)) {
            if (EN(5)) for (int rp = 0; rp < NREP(5); ++rp) {
                PH_BEGIN_L
                PF1 p; p.nt = opaque_int(4); p.Alat = (const char*)(ws + WS_W2TL); p.Actx = (const char*)(ws + WS_W2T); p.B = (const char*)(ws + WS_P8); p.G = F.G; p.c = F.blk; p.nunits = l == 0 ? 320 : 256;
                p.Olat = (u16*)(ws + WS_TT); p.Octx = (u16*)F.out;
                pg8::gemm_phase(F.lds, p);
            }
            if (EN(6)) for (int rp = 0; rp < NREP(19); ++rp) { PH_BEGIN_L readout_phase(F, l, r0); }
        }
        SEAM(base + 2);
        if (IN(base + 3)) {
            if (EN(6)) for (int rp = 0; rp < NREP(6); ++rp) {
                PH_BEGIN_L
                PF2 p; p.ucm = (const float*)(ws + WS_UCM); p.nt_lat = opaque_int(32); p.nt_ctx = opaque_int(8); p.Alat = (const char*)(ws + WS_DFT); p.Blat = (const char*)(ws + WS_TT); p.Actx = (const char*)(ws + WS_DFTC); p.Bctx = (const char*)F.out; p.G = F.G; p.c = F.blk;
                p.nunits = l == 0 ? 288 : 256; p.O = (u16*)(ws + WS_P3);
                pg8::gemm_phase(F.lds, p);
            }
            if (EN(7)) for (int rp = 0; rp < NREP(7); ++rp) {
                PH_BEGIN_L
                PIn p; p.A = (const char*)(ws + WS_H); p.B = (const char*)(ws + WS_WL + WL_WIN); p.nt = opaque_int(16); p.G = F.G; p.c = F.G - 1 - F.blk; p.nM = nM; p.nN = 12; p.rt0 = rt0; p.pn0 = 18; p.nctx = 0; p.dry = rp ? DRY_MODE : 0;
                if (XG_ON == 4 && l == 0) p.xg = (u16*)((unsigned char*)F.out + XG_OFF);
                if (XG_ON == 1 && l == 0) { p.nN = 10; p.xr0 = XG_ROWS; p.xnr = 144 - XG_ROWS; p.xg = (u16*)((unsigned char*)F.out + XG_OFF); }
                p.ws = ws; p.lbt = nullptr; p.rope = nullptr;
                pg8::gemm_phase(F.lds, p);
            }
        }
        SEAM(base + 3);
        if (EN(8) && IN(base + 4)) for (int rp = 0; rp < NREP(8); ++rp) { PH_BEGIN_L PMerge p; p.dry = rp ? DRY_MODE : 0; p.ws = ws; if ((XG_ON == 1 || XG_ON == 3 || XG_ON == 4) && l == 0) p.xg = (const u16*)((unsigned char*)F.out + XG_OFF); p.nt = opaque_int(24); p.G = F.G; p.c = F.blk; p.nM = nM; p.rt0 = rt0; pg8::gemm_phase(F.lds, p); }
        SEAM(base + 4);
        if (EN(9) && IN(base + 5)) for (int rp = 0; rp < NREP(9); ++rp) {
            PH_BEGIN_L
            POut p; p.A = (const char*)(ws + WS_H); p.B = (const char*)(ws + WS_WL + WL_WO); p.nt = opaque_int(16); p.G = F.G; p.c = F.blk; p.nM = nM; p.rt0 = rt0;
            p.src_c = l == 0 ? GIN(F, 2) : xc; p.src_l = l == 0 ? GIN(F, 0) : F.out; p.xb = (u16*)(ws + WS_XB); p.mod = modall + (size_t)l * 17 * 6144;
            pg8::gemm_phase(F.lds, p);
        }
        SEAM(base + 5);
        if (!LNR && EN(10) && IN(base + 6)) {
            for (int rp = 0; rp < NREP(10); ++rp) { PH_BEGIN_L ln1_phase(F, r0, GIN(F, 15) + l * 1024, GIN(F, 16) + l * 1024, modall + (size_t)l * 17 * 6144); }
            for (int rp = 0; rp < NREP(18); ++rp) { PH_BEGIN_L cvt_expert_weights(F, l); }
        }
        if (!LNR) SEAM(base + 6);
        if (IN(base + 7)) {
            if (LNR && EN(10)) {
                PH_BEGIN_L
                for (long L = F.blk; L < nM; L += F.G) { Frame Fc = F; Fc.blk = 0; Fc.G = 1; const int rb = (rt0 + (int)L) * 256;
                    ln1_phase<LNR_NR>(Fc, rb, GIN(F, 15) + l * 1024, GIN(F, 16) + l * 1024, modall + (size_t)l * 17 * 6144, rb + 256); }
                if (F.G > nM && F.blk >= nM) { Frame Fc = F; Fc.blk = F.blk - nM; Fc.G = F.G - nM; cvt_expert_weights(Fc, l, 1); }
                asm volatile("s_waitcnt vmcnt(0)" ::: "memory"); __syncthreads();
            }
            if (EN(11)) for (int rp = 0; rp < NREP(11); ++rp) {
                PH_BEGIN_L
                PRouter p; p.A = (const char*)(ws + WS_H); p.B = (const char*)(ws + WS_WL + WL_WR); p.nt = opaque_int(16); p.G = F.G; p.c = F.blk; p.nM = nM; p.rt0 = rt0; p.logits = (float*)(ws + WS_LOGIT);
                pg8::gemm_phase(F.lds, p);
            }
            asm volatile("s_waitcnt vmcnt(0)" ::: "memory"); __syncthreads();
            if (EN(12)) { { PH_BEGIN_L route1_phase(F, l, r0); }
                if (LNR) { PH_BEGIN_L __syncthreads(); cvt_expert_weights(F, l, (F.G > nM) ? 2 : 0); }
                if (lyr + 1 < DEPTH) { PH_BEGIN_L __syncthreads(); cvt_layer_weights(F, l + 1); } }
        }
        SEAM(base + 7);
        if (EN(13) && IN(base + 8)) { PH_BEGIN_L route2_phase(F, l, r0); }
        SEAM(base + 8);
        for (int ps = 0; ps < NP; ++ps) {
            if (EN(14) && IN(base + 9 + 2 * ps)) for (int rp = 0; rp < NREP(14); ++rp) {
                PH_BEGIN_L
                PUpGate p; p.A = (const char*)(ws + WS_H); p.B = (const char*)(ws + WS_WGU); p.nt = opaque_int(16); p.G = F.G; p.c = F.vcu;
                p.ntiles = (int)__builtin_amdgcn_readfirstlane(__hip_atomic_load((unsigned*)(ws + WS_CTL) + CW_NTILES + l * NPASS + ps, __ATOMIC_RELAXED, __HIP_MEMORY_SCOPE_AGENT));
                p.hb = (u16*)(ws + WS_HB);
                {
                    LAS int* lte = (LAS int*)(F.lds + 131072); LAS int* lrt = (LAS int*)(F.lds + 131072 + 8192);
                    const int* te = (const int*)(ws + WS_TILEE) + ps * 1024; const int* rt = (const int*)(ws + WS_RTOK) + (size_t)ps * MAXROWS;
                    for (int i = F.tid; i < p.ntiles; i += 512) lte[i] = te[i];
                    for (int i = 0; i < 11; ++i) { const long L = (long)i * F.G + F.vcu; if (L >= 2L * p.ntiles) break; if (F.tid < 256) lrt[i * 256 + F.tid] = rt[(size_t)(L >> 1) * 256 + F.tid]; }
                    __syncthreads();
                    p.lte = lte; p.lrt = lrt;
                }
                pg8::gemm_phase(F.lds, p);
            }
            if (EN(16) && ps > 0 && IN(base + 9 + 2 * ps)) for (int rp = 0; rp < NREP(16); ++rp) {
                PH_BEGIN_L
                const bool more = l + 1 < DEPTH;
                comb_ln2_phase(F, pass_tile0(l, ps - 1) * 256, pass_tile0(l, ps) * 256, xc, F.out, modall + (size_t)l * 17 * 6144, GIN(F, 15) + l * 1024, GIN(F, 16) + l * 1024, GIN(F, 17) + l * 1024, GIN(F, 18) + l * 1024, more, modall + (size_t)(more ? l + 1 : l) * 17 * 6144);
            }
            SEAM(base + 9 + 2 * ps);
            if (EN(15) && IN(base + 10 + 2 * ps)) for (int rp = 0; rp < NREP(15); ++rp) {
                PH_BEGIN_L
                PDown p; p.A = (const char*)(ws + WS_HB); p.B = (const char*)(ws + WS_WD); p.nt = opaque_int(4); p.G = F.G; p.c = F.vcu;
                p.ntiles = (int)__builtin_amdgcn_readfirstlane(__hip_atomic_load((unsigned*)(ws + WS_CTL) + CW_NTILES + l * NPASS + ps, __ATOMIC_RELAXED, __HIP_MEMORY_SCOPE_AGENT));
                p.so = ws + WS_SO;
                { LAS int* lte = (LAS int*)(F.lds + 131072); const int* te = (const int*)(ws + WS_TILEE) + ps * 1024; for (int i = F.tid; i < p.ntiles; i += 512) lte[i] = te[i]; __syncthreads(); p.lte = lte; }
                pg8::gemm_phase(F.lds, p);
            }
            SEAM(base + 10 + 2 * ps);
        }
        if (EN(16) && IN(base + 9 + 2 * NP)) for (int rp = 0; rp < NREP(16); ++rp) {
            PH_BEGIN_L
            const bool more = l + 1 < DEPTH;
            comb_ln2_phase(F, pass_tile0(l, NP - 1) * 256, pass_tile0(l, NP) * 256, xc, F.out, modall + (size_t)l * 17 * 6144, GIN(F, 15) + l * 1024, GIN(F, 16) + l * 1024, GIN(F, 17) + l * 1024, GIN(F, 18) + l * 1024, more, modall + (size_t)(more ? l + 1 : l) * 17 * 6144);
        }
        SEAM(base + 9 + 2 * NP);
    }
}


#ifndef DBG_STOP
#define DBG_STOP -1
#endif
struct DbgRegs { unsigned long long off[8]; unsigned long long len[8]; int n; int keep_out; };
__global__ void dbg_dump(unsigned char* ws, float* out, DbgRegs r) {
    const size_t OUT_N = (size_t)TL * DM;
    for (size_t i = (size_t)blockIdx.x * blockDim.x + threadIdx.x; i < OUT_N; i += (size_t)gridDim.x * blockDim.x) {
        unsigned h = 0;
        for (int k = 0; k < r.n; ++k) { const unsigned* p = (const unsigned*)(ws + r.off[k]); const size_t words = r.len[k] / 4;
            for (size_t w = i; w < words; w += OUT_N) { const unsigned v = p[w]; h = h * 31u + (v ^ (v >> 15)); } }
        const float b = r.keep_out ? out[i] : 0.f;
        out[i] = b + (float)(h & 0xffffu) * (1.f / 65536.f);
    }
}
extern "C" void kernel_launch(void* const* d_in, const int* in_sizes, int n_in, void* d_out, int out_size, void* d_ws, size_t ws_size, hipStream_t stream) {
    static int grid = 0;
    if (grid == 0) {
        if (n_in != 27 || out_size != TL * DM || ws_size < WS_END) { fprintf(stderr, "kernel_launch: unexpected shapes (n_in %d, out %d, ws %zu < %zu)\n", n_in, out_size, ws_size, (size_t)WS_END); grid = -1; return; }
        int dev = 0, cus = 0, per_cu = 0;
        if (hipGetDevice(&dev) != hipSuccess || hipDeviceGetAttribute(&cus, hipDeviceAttributeMultiprocessorCount, dev) != hipSuccess) { grid = -1; return; }
        if (hipFuncSetAttribute((const void*)mk_fwd, hipFuncAttributeMaxDynamicSharedMemorySize, LDS_BYTES) != hipSuccess) { fprintf(stderr, "kernel_launch: hipFuncSetAttribute failed\n"); grid = -1; return; }
        if (hipOccupancyMaxActiveBlocksPerMultiprocessor(&per_cu, (const void*)mk_fwd, 512, LDS_BYTES) != hipSuccess || per_cu < 1) { fprintf(stderr, "kernel_launch: occupancy query says %d\n", per_cu); }
        (void)hipGetLastError();
        grid = cus;
    }
    if (grid < 0) return;
    (void)hipMemsetAsync((char*)d_ws + WS_CTL, 0, 65536, stream);
    Args a{};
    for (int i = 0; i < 27; ++i) a.in[i] = (const float*)d_in[i];
    a.out = (float*)d_out; a.ws = (unsigned char*)d_ws;
#if DBG_STOP >= 0
    for (int k = 0; k <= DBG_STOP; ++k) { a.ph_lo = k; a.ph_hi = k + 1; hipLaunchKernelGGL(mk_fwd, dim3(grid), dim3(512), LDS_BYTES, stream, a); }
    { DbgRegs r{}; DBG_REGS; hipLaunchKernelGGL(dbg_dump, dim3(2048), dim3(256), 0, stream, (unsigned char*)d_ws, (float*)d_out, r); }
#elif MK_ONE_LAUNCH
    a.ph_lo = 0; a.ph_hi = NINT;
    hipLaunchKernelGGL(mk_fwd, dim3(grid), dim3(512), LDS_BYTES, stream, a);
#else
    for (int k = 0; k < NINT; ++k) { a.ph_lo = k; a.ph_hi = k + 1; hipLaunchKernelGGL(mk_fwd, dim3(grid), dim3(512), LDS_BYTES, stream, a); }
#endif
}
```
